# Optimizing an MI355X kernel written in HIP

```python
import math
import jax
import jax.numpy as jnp
from jax import lax
import numpy as np

D_MODEL = 1024
BATCH = 8
SEQ = 2048
DEPTH = 2

MEM_LEN = 256
ROPE_THETA = 500000.0
ROPE_FRAC = 4
LN_EPS = 1e-5
NEG_INF = -1e30
DEEPNORM_ALPHA = (2 * DEPTH) ** 0.25
DEEPNORM_BETA = (8 * DEPTH) ** -0.25

A_HEADS = 4
A_QK_DIM = D_MODEL // 32
A_V_DIM = 2 * A_QK_DIM
A_QBLK = 128
B_HEADS = 6
B_HEAD_DIM = D_MODEL // 16
B_GROUPS = ((128, 1), (512, 4), (2048, 16))
C_HEADS = 4
C_K_DIM = 3 * D_MODEL // 64
C_V_DIM = 3 * D_MODEL // 32
C_GATE_RANK = 16
C_GATE_TAU = 16.0
C_CHUNK = 16

IN_SPLITS = (
    A_HEADS * 2 * A_QK_DIM, A_HEADS * 2 * A_QK_DIM, A_HEADS * A_V_DIM,
    B_HEADS * B_HEAD_DIM, B_HEADS * B_HEAD_DIM, B_HEADS * B_HEAD_DIM,
    C_HEADS * C_K_DIM, C_HEADS * C_K_DIM, C_HEADS * C_V_DIM, C_HEADS * C_V_DIM,
    C_GATE_RANK,
)
IN_BOUNDS = tuple(int(c) for c in np.cumsum((0,) + IN_SPLITS))
IN_COLS = IN_BOUNDS[-1]
VALUE_SLOTS = (2, 5, 8)

XA_HEADS = 4
XA_HEAD_DIM = D_MODEL // XA_HEADS
F_DENSE = ((8 * D_MODEL // 3 + 127) // 128) * 128
N_EXPERTS = 8
TOP_K = 2
F_MOE = 7 * D_MODEL // 2
N_DENSE = (DEPTH + 1) // 2
N_MOE = DEPTH // 2

kernel_name = 'hybrid_diff_dilated_gla_deepnorm_moe'


def layer_norm(x, g, b):
    xf = x.astype(jnp.float32)
    mu = xf.mean(-1, keepdims=True)
    var = jnp.square(xf - mu).mean(-1, keepdims=True)
    return ((xf - mu) * lax.rsqrt(var + LN_EPS) * g + b).astype(x.dtype)


def rms_norm(x, g):
    xf = x.astype(jnp.float32)
    return (xf * lax.rsqrt(jnp.mean(xf * xf, -1, keepdims=True) + LN_EPS) * g).astype(x.dtype)


def apply_partial_rope(x, positions):
    rot = x.shape[-1] // ROPE_FRAC
    inv_freq = ROPE_THETA ** (-jnp.arange(0, rot, 2, dtype=jnp.float32) / rot)
    ang = positions.astype(jnp.float32)[..., None] * inv_freq
    bshape = ang.shape[:2] + (1,) * (x.ndim - 3) + ang.shape[-1:]
    cos = jnp.cos(ang).reshape(bshape).astype(x.dtype)
    sin = jnp.sin(ang).reshape(bshape).astype(x.dtype)
    x1, x2, xp = x[..., :rot // 2], x[..., rot // 2:rot], x[..., rot:]
    return jnp.concatenate([x1 * cos - x2 * sin, x2 * cos + x1 * sin, xp], axis=-1)


def diff_attention(q, k, v, lam, lam_init, norm_g):
    bsz, seq, heads, _, dqk = q.shape
    nqb = seq // A_QBLK
    scale = dqk ** -0.5
    q_blocks = q.reshape(bsz, nqb, A_QBLK, heads, 2, dqk).transpose(1, 0, 2, 3, 4, 5)
    starts = jnp.arange(nqb, dtype=jnp.int32) * A_QBLK
    kpos = jnp.arange(seq, dtype=jnp.int32)

    def one_block(args):
        qb, start = args
        s = jnp.einsum('bqhmd,bkhmd->bhmqk', qb, k, preferred_element_type=jnp.float32) * scale
        qpos = start + jnp.arange(A_QBLK, dtype=jnp.int32)
        causal = kpos[None, :] <= qpos[:, None]
        p = jax.nn.softmax(jnp.where(causal, s, NEG_INF), axis=-1)
        a = p[:, :, 0] - lam * p[:, :, 1]
        return jnp.einsum('bhqk,bkhd->bqhd', a.astype(v.dtype), v)

    o = lax.map(one_block, (q_blocks, starts))
    o = o.transpose(1, 0, 2, 3, 4).reshape(bsz, seq, heads, v.shape[-1])
    return rms_norm(o, norm_g) * (1.0 - lam_init)


def dilated_group(q, k, v, window, dilation):
    bsz, seq, heads, dh = q.shape
    span = window // dilation
    sub_len = seq // dilation
    nb = -(-sub_len // span)
    pad = nb * span - sub_len

    def to_blocks(t):
        t = t.reshape(bsz, sub_len, dilation, heads, dh).transpose(0, 2, 3, 1, 4)
        t = jnp.pad(t, ((0, 0), (0, 0), (0, 0), (0, pad), (0, 0)))
        return t.reshape(bsz, dilation, heads, nb, span, dh)

    def with_prev(t):
        prev = jnp.pad(t, ((0, 0), (0, 0), (0, 0), (1, 0), (0, 0), (0, 0)))[:, :, :, :-1]
        return jnp.concatenate([prev, t], axis=4)

    qb = to_blocks(q)
    kk = with_prev(to_blocks(k))
    vv = with_prev(to_blocks(v))
    s = jnp.einsum('brhnqd,brhnkd->brhnqk', qb, kk, preferred_element_type=jnp.float32) * dh ** -0.5
    qi = jnp.arange(span)[:, None]
    ki = jnp.arange(2 * span)[None, :]
    dist = qi + span - ki
    band = (dist >= 0) & (dist <= span)
    has_prev = (jnp.arange(nb) > 0)[:, None, None] | (ki >= span)[None]
    valid = band[None] & has_prev
    s = jnp.where(valid, s, NEG_INF)
    m = s.max(-1, keepdims=True)
    p = jnp.exp(s - m)
    l = p.sum(-1, keepdims=True)
    o = jnp.einsum('brhnqk,brhnkd->brhnqd', (p / l).astype(v.dtype), vv)
    lse = (m + jnp.log(l))[..., 0]

    def from_blocks(t):
        t = t.reshape((bsz, dilation, heads, nb * span) + t.shape[5:])[:, :, :, :sub_len]
        t = jnp.moveaxis(t, 3, 1)
        return t.reshape((bsz, seq, heads) + t.shape[4:])

    return from_blocks(o), from_blocks(lse)


def dilated_attention(q, k, v):
    outs, lses = zip(*[dilated_group(q, k, v, w, r) for (w, r) in B_GROUPS])
    wts = jax.nn.softmax(jnp.stack(lses, axis=0), axis=0)
    return jnp.einsum('gbsh,gbshd->bshd', wts.astype(q.dtype), jnp.stack(outs, axis=0))


def gla_chunked(q, k, v, log_a):
    bsz, seq, heads, dk = q.shape
    dv = v.shape[-1]
    n = seq // C_CHUNK

    def to_chunks(t):
        return t.astype(jnp.float32).reshape(bsz, n, C_CHUNK, heads, t.shape[-1]).transpose(0, 3, 1, 2, 4)

    q, k, v, log_a = map(to_chunks, (q, k, v, log_a))
    q = q * dk ** -0.5
    b = jnp.cumsum(log_a, axis=3)
    causal = jnp.tril(jnp.ones((C_CHUNK, C_CHUNK), dtype=bool))
    diff = b[:, :, :, :, None, :] - b[:, :, :, None, :, :]
    decay = jnp.exp(jnp.where(causal[:, :, None], diff, NEG_INF))
    scores = jnp.einsum('bhnid,bhnjd,bhnijd->bhnij', q, k, decay)
    o_intra = jnp.einsum('bhnij,bhnjv->bhniv', scores, v)
    b_last = b[:, :, :, -1]
    u = jnp.einsum('bhncd,bhncv->bhndv', k * jnp.exp(b_last[:, :, :, None] - b), v)

    def step(state, inp):
        g, u_n = inp
        return jnp.exp(g)[..., None] * state + u_n, state

    init = jnp.zeros((bsz, heads, dk, dv), jnp.float32)
    _, s_prev = lax.scan(step, init, (jnp.moveaxis(b_last, 2, 0), jnp.moveaxis(u, 2, 0)))
    s_prev = jnp.moveaxis(s_prev, 0, 2)
    o_inter = jnp.einsum('bhncd,bhndv->bhncv', q * jnp.exp(b), s_prev)
    return (o_intra + o_inter).transpose(0, 2, 3, 1, 4).reshape(bsz, seq, heads, dv)


def hybrid_mixer(x, positions, w_in, lam_q1, lam_k1, lam_q2, lam_k2, lam_init,
                 diff_g, gla_wa2, gla_ba, gla_g, w_out):
    bsz, seq, _ = x.shape
    h = x @ w_in
    qa, ka, va, qb, kb, vb, qc, kc, vc, gc, rc = jnp.split(h, IN_BOUNDS[1:-1], axis=-1)
    qa = apply_partial_rope(qa.reshape(bsz, seq, A_HEADS, 2, A_QK_DIM), positions)
    ka = apply_partial_rope(ka.reshape(bsz, seq, A_HEADS, 2, A_QK_DIM), positions)
    va = va.reshape(bsz, seq, A_HEADS, A_V_DIM)
    f32 = jnp.float32
    lam = (jnp.exp(jnp.sum(lam_q1.astype(f32) * lam_k1.astype(f32)))
           - jnp.exp(jnp.sum(lam_q2.astype(f32) * lam_k2.astype(f32))) + lam_init)
    oa = diff_attention(qa, ka, va, lam, lam_init, diff_g)
    qb = apply_partial_rope(qb.reshape(bsz, seq, B_HEADS, B_HEAD_DIM), positions)
    kb = apply_partial_rope(kb.reshape(bsz, seq, B_HEADS, B_HEAD_DIM), positions)
    vb = vb.reshape(bsz, seq, B_HEADS, B_HEAD_DIM)
    ob = dilated_attention(qb, kb, vb)
    log_a = jax.nn.log_sigmoid((rc @ gla_wa2 + gla_ba).astype(f32)) / C_GATE_TAU
    oc = gla_chunked(qc.reshape(bsz, seq, C_HEADS, C_K_DIM), kc.reshape(bsz, seq, C_HEADS, C_K_DIM),
                     vc.reshape(bsz, seq, C_HEADS, C_V_DIM), log_a.reshape(bsz, seq, C_HEADS, C_K_DIM))
    oc = rms_norm(oc, gla_g).astype(x.dtype) * jax.nn.silu(gc.reshape(bsz, seq, C_HEADS, C_V_DIM))
    o = jnp.concatenate([oa.reshape(bsz, seq, -1), ob.reshape(bsz, seq, -1),
                         oc.reshape(bsz, seq, -1)], axis=-1)
    return o @ w_out


def memory_cross_attention(x, mem, wq, wkv, wo):
    bsz, seq, _ = x.shape
    q = (x @ wq).reshape(bsz, seq, XA_HEADS, XA_HEAD_DIM)
    k, v = jnp.split(mem @ wkv, 2, axis=-1)
    k = k.reshape(bsz, mem.shape[1], XA_HEADS, XA_HEAD_DIM)
    v = v.reshape(bsz, mem.shape[1], XA_HEADS, XA_HEAD_DIM)
    s = jnp.einsum('bqhd,bkhd->bhqk', q, k, preferred_element_type=jnp.float32) * XA_HEAD_DIM ** -0.5
    p = jax.nn.softmax(s, axis=-1)
    o = jnp.einsum('bhqk,bkhd->bqhd', p.astype(v.dtype), v).reshape(bsz, seq, D_MODEL)
    return o @ wo


def swiglu(x, w13, w2):
    gate, up = jnp.split(x @ w13, 2, axis=-1)
    return (jax.nn.silu(gate) * up) @ w2


def moe_swiglu(x, router, w13, w2):
    logits = (x @ router).astype(jnp.float32)
    top_vals, top_idx = lax.top_k(logits, TOP_K)
    top_w = jax.nn.softmax(top_vals, axis=-1)
    gates = jnp.einsum('bsk,bske->bse', top_w, jax.nn.one_hot(top_idx, N_EXPERTS, dtype=jnp.float32))
    out = jnp.zeros_like(x)
    for e in range(N_EXPERTS):
        out = out + gates[..., e:e + 1].astype(x.dtype) * swiglu(x, w13[e], w2[e])
    return out


def setup_inputs(seed: int = 0) -> dict:
    key = jax.random.key(seed)
    ks = jax.random.split(key, 28)

    def nrm(k, shape, scale):
        return jax.random.normal(k, shape, jnp.float32) * scale

    def gain(k, shape):
        return 1.0 + 0.02 * jax.random.normal(k, shape, jnp.float32)

    def bias(k, shape):
        return 0.02 * jax.random.normal(k, shape, jnp.float32)

    col_scale = np.ones((IN_COLS,), np.float32)
    for slot in VALUE_SLOTS:
        col_scale[IN_BOUNDS[slot]:IN_BOUNDS[slot + 1]] = DEEPNORM_BETA
    offset = jax.random.randint(ks[2], (BATCH, 1), 0, 4096, dtype=jnp.int32)
    positions = (offset + jnp.arange(SEQ, dtype=jnp.int32)[None, :]).astype(jnp.int32)
    ds = D_MODEL ** -0.5
    return {
        'x': nrm(ks[0], (BATCH, SEQ, D_MODEL), 1.0),
        'mem': nrm(ks[1], (BATCH, MEM_LEN, D_MODEL), 1.0),
        'positions': positions,
        'w_in': nrm(ks[3], (DEPTH, D_MODEL, IN_COLS), ds) * jnp.asarray(col_scale),
        'lam_q1': nrm(ks[4], (DEPTH, A_QK_DIM), 0.1),
        'lam_k1': nrm(ks[5], (DEPTH, A_QK_DIM), 0.1),
        'lam_q2': nrm(ks[6], (DEPTH, A_QK_DIM), 0.1),
        'lam_k2': nrm(ks[7], (DEPTH, A_QK_DIM), 0.1),
        'diff_norm_g': gain(ks[8], (DEPTH, A_V_DIM)),
        'gla_wa2': nrm(ks[9], (DEPTH, C_GATE_RANK, C_HEADS * C_K_DIM), C_GATE_RANK ** -0.5),
        'gla_ba': nrm(ks[10], (DEPTH, C_HEADS * C_K_DIM), 0.1),
        'gla_norm_g': gain(ks[11], (DEPTH, C_V_DIM)),
        'w_out': nrm(ks[12], (DEPTH, D_MODEL, D_MODEL), ds * DEEPNORM_BETA),
        'ln_mix_g': gain(ks[13], (DEPTH, D_MODEL)),
        'ln_mix_b': bias(ks[14], (DEPTH, D_MODEL)),
        'xa_wq': nrm(ks[15], (DEPTH, D_MODEL, D_MODEL), ds),
        'xa_wkv': jnp.concatenate([nrm(ks[16], (DEPTH, D_MODEL, D_MODEL), ds),
                                   nrm(ks[17], (DEPTH, D_MODEL, D_MODEL), ds * DEEPNORM_BETA)], axis=-1),
        'xa_wo': nrm(ks[18], (DEPTH, D_MODEL, D_MODEL), ds * DEEPNORM_BETA),
        'ln_xa_g': gain(ks[19], (DEPTH, D_MODEL)),
        'ln_xa_b': bias(ks[20], (DEPTH, D_MODEL)),
        'ffd_w13': nrm(ks[21], (N_DENSE, D_MODEL, 2 * F_DENSE), ds * DEEPNORM_BETA),
        'ffd_w2': nrm(ks[22], (N_DENSE, F_DENSE, D_MODEL), F_DENSE ** -0.5 * DEEPNORM_BETA),
        'moe_router': nrm(ks[23], (N_MOE, D_MODEL, N_EXPERTS), ds),
        'moe_w13': nrm(ks[24], (N_MOE, N_EXPERTS, D_MODEL, 2 * F_MOE), ds * DEEPNORM_BETA),
        'moe_w2': nrm(ks[25], (N_MOE, N_EXPERTS, F_MOE, D_MODEL), F_MOE ** -0.5 * DEEPNORM_BETA),
        'ln_ffn_g': gain(ks[26], (DEPTH, D_MODEL)),
        'ln_ffn_b': bias(ks[27], (DEPTH, D_MODEL)),
    }


def reference(x, mem, positions, w_in, lam_q1, lam_k1, lam_q2, lam_k2, diff_norm_g, gla_wa2, gla_ba,
              gla_norm_g, w_out, ln_mix_g, ln_mix_b, xa_wq, xa_wkv, xa_wo, ln_xa_g, ln_xa_b,
              ffd_w13, ffd_w2, moe_router, moe_w13, moe_w2, ln_ffn_g, ln_ffn_b):
    for l in range(DEPTH):
        lam_init = 0.8 - 0.6 * math.exp(-0.3 * l)
        mix = hybrid_mixer(x, positions, w_in[l], lam_q1[l], lam_k1[l], lam_q2[l], lam_k2[l], lam_init,
                           diff_norm_g[l], gla_wa2[l], gla_ba[l], gla_norm_g[l], w_out[l])
        x = layer_norm(DEEPNORM_ALPHA * x + mix, ln_mix_g[l], ln_mix_b[l])
        xa = memory_cross_attention(x, mem, xa_wq[l], xa_wkv[l], xa_wo[l])
        x = layer_norm(DEEPNORM_ALPHA * x + xa, ln_xa_g[l], ln_xa_b[l])
        if l % 2 == 0:
            f = swiglu(x, ffd_w13[l // 2], ffd_w2[l // 2])
        else:
            f = moe_swiglu(x, moe_router[l // 2], moe_w13[l // 2], moe_w2[l // 2])
        x = layer_norm(DEEPNORM_ALPHA * x + f, ln_ffn_g[l], ln_ffn_b[l])
    return x
```

```cpp
#include <hip/hip_runtime.h>
#include <hip/hip_cooperative_groups.h>
#include <cstdio>
#include <cmath>
#include <cstring>
namespace cg = cooperative_groups;

#define DI __device__ __forceinline__
typedef unsigned short u16;
typedef __attribute__((ext_vector_type(8))) short bf16x8;
typedef __attribute__((ext_vector_type(4))) short s16x4;
typedef __attribute__((ext_vector_type(16))) float f32x16;
typedef __attribute__((ext_vector_type(2))) float f32x2;
typedef __attribute__((ext_vector_type(2))) __bf16 bf16x2_t;
typedef __attribute__((ext_vector_type(4))) unsigned u32x4;
typedef __attribute__((ext_vector_type(2))) unsigned u32x2;
#define PH_IDS const int tid = ltid(); const int lane = tid & 63, w = tid >> 6; const int gwave = blockIdx.x * 4 + w; (void)lane; (void)gwave; \
  char* ws = lws(p); char* u = ws + OFF_UNION; u16* xbf = (u16*)(ws + OFF_XBF); float* xf = (float*)(ws + OFF_XF); float* y = (float*)(ws + OFF_Y); int* ctr = (int*)(ws + OFF_CTR); float* lnstats = (float*)(ws + OFF_STATS); (void)lnstats; (void)u; (void)xbf; (void)xf; (void)y; (void)ctr;
#ifndef PROBE_PHASE
#define PROBE_PHASE -1
#endif
#define REP(k) ((PROBE_PHASE == (k)) ? 2 : 1)
#define MFMA32(a, b, c) __builtin_amdgcn_mfma_f32_32x32x16_bf16((a), (b), (c), 0, 0, 0)

constexpr int NTHR = 256;
constexpr int MTOK = 16384, SEQ = 2048, DM = 1024;
constexpr int INP = 3200;
constexpr int FD = 2816, FM = 3584;
constexpr float ALPHA = 1.41421356237309515f;
constexpr float LOG2E = 1.44269504088896341f;
constexpr float LN2 = 0.69314718055994531f;
constexpr float LN_EPS = 1e-5f;

constexpr size_t al256(size_t x) { return (x + 255) & ~(size_t)255; }
constexpr size_t OFF_WT_IN = 0;
constexpr size_t OFF_WT_OUT = OFF_WT_IN + al256((size_t)2 * INP * 1024 * 2);
constexpr size_t OFF_WT_Q = OFF_WT_OUT + al256((size_t)2 * 1024 * 1024 * 2);
constexpr size_t OFF_WT_KV = OFF_WT_Q + al256((size_t)2 * 1024 * 1024 * 2);
constexpr size_t OFF_WT_O = OFF_WT_KV + al256((size_t)2 * 2048 * 1024 * 2);
constexpr size_t OFF_WT_F13 = OFF_WT_O + al256((size_t)2 * 1024 * 1024 * 2);
constexpr size_t OFF_WT_F2 = OFF_WT_F13 + al256((size_t)2 * FD * 1024 * 2);
constexpr size_t OFF_WT_M13 = OFF_WT_F2 + al256((size_t)1024 * FD * 2);
constexpr size_t OFF_WT_M2 = OFF_WT_M13 + al256((size_t)8 * 2 * FM * 1024 * 2);
constexpr size_t OFF_XBF = OFF_WT_M2 + al256((size_t)8 * 1024 * FM * 2);
constexpr size_t OFF_XF = OFF_XBF + al256((size_t)MTOK * 1024 * 2);
constexpr size_t OFF_Y = OFF_XF + al256((size_t)MTOK * 1024 * 4);
constexpr size_t OFF_MEMBF = OFF_Y + al256((size_t)MTOK * 1024 * 4);
constexpr size_t OFF_ROPE = OFF_MEMBF + al256((size_t)2048 * 1024 * 2);
constexpr size_t OFF_KXA = OFF_ROPE + al256((size_t)MTOK * 24 * 4);
constexpr size_t OFF_VXAT = OFF_KXA + al256((size_t)2 * 2048 * 1024 * 2);
constexpr size_t OFF_RC = OFF_VXAT + al256((size_t)2 * 2048 * 1024 * 2);
constexpr size_t OFF_LSE = OFF_RC + al256((size_t)MTOK * 16 * 4);
constexpr size_t OFF_MOEOUT = OFF_LSE + al256((size_t)3 * MTOK * 8 * 4);
constexpr size_t OFF_LIST = OFF_MOEOUT + al256((size_t)2 * MTOK * 1024 * 2);
constexpr size_t OFF_GLIST = OFF_LIST + al256((size_t)8 * MTOK * 4);
constexpr size_t OFF_CTR = OFF_GLIST + al256((size_t)8 * MTOK * 4);
constexpr size_t OFF_BAR = OFF_CTR + 256;
constexpr size_t OFF_STATS = OFF_BAR + 8192;
constexpr size_t OFF_UNION = OFF_STATS + al256((size_t)MTOK * 2 * 4);
constexpr size_t U_QA = 0;
constexpr size_t U_KA = U_QA + (size_t)MTOK * 256 * 2;
constexpr size_t U_VAT = U_KA + (size_t)MTOK * 256 * 2;
constexpr size_t U_QB = U_VAT + (size_t)MTOK * 256 * 2;
constexpr size_t U_KB = U_QB + (size_t)MTOK * 384 * 2;
constexpr size_t U_VBT = U_KB + (size_t)MTOK * 384 * 2;
constexpr size_t U_HC = U_VBT + (size_t)3 * MTOK * 384 * 2;
constexpr size_t U_PBO = U_HC + (size_t)MTOK * 1152 * 2;
constexpr size_t U_GLAO = U_PBO + (size_t)3 * MTOK * 384 * 2;
constexpr size_t U_OMIX = U_GLAO + (size_t)MTOK * 384 * 4;
constexpr size_t U_QXA = U_OMIX + (size_t)MTOK * 1024 * 2;
constexpr size_t U_MIX_END = U_QXA + (size_t)MTOK * 1024 * 2;
constexpr size_t HID_ROWS_MOE = 2 * MTOK + 8 * 128;
constexpr size_t U_HID_END = HID_ROWS_MOE * FM * 2;
constexpr size_t UNION_SIZE = al256(U_MIX_END > U_HID_END ? U_MIX_END : U_HID_END);
constexpr size_t WS_NEED = OFF_UNION + UNION_SIZE;

struct Job { const float* src; u16* dst; int K, N, Npad, mode; };

struct Params {
  const float* x; const float* mem; const int* pos;
  const float *w_in, *lam_q1, *lam_k1, *lam_q2, *lam_k2, *diff_g, *gla_wa2, *gla_ba, *gla_g, *w_out, *ln_mix_g, *ln_mix_b;
  const float *xa_wq, *xa_wkv, *xa_wo, *ln_xa_g, *ln_xa_b, *ffd_w13, *ffd_w2, *moe_router, *moe_w13, *moe_w2, *ln_ffn_g, *ln_ffn_b;
  float* out; char* ws;
  float invfA[4]; float invfB[8]; float lam_init[2];
};

DI int ltid() { int t = threadIdx.x; asm volatile("" : "+v"(t)); return t; }
typedef __attribute__((address_space(1))) char gchar_t;
template <class P_> DI char* lws(const P_& p) {
  unsigned long long a_ = (unsigned long long)p.ws; unsigned lo_ = (unsigned)a_, hi_ = (unsigned)(a_ >> 32);
  asm volatile("" : "+v"(lo_), "+v"(hi_));
  lo_ = __builtin_amdgcn_readfirstlane(lo_); hi_ = __builtin_amdgcn_readfirstlane(hi_);
  gchar_t* g_ = (gchar_t*)(((unsigned long long)hi_ << 32) | lo_);
  return (char*)g_;
}
DI float bf2f(u16 v) { return __uint_as_float(((unsigned)v) << 16); }
DI unsigned pack2(float a, float b) { f32x2 v = {a, b}; return __builtin_bit_cast(unsigned, __builtin_convertvector(v, bf16x2_t)); }
DI u16 f2bf(float a) { return (u16)(pack2(a, 0.f) & 0xffffu); }
DI int crow(int i, int hh) { return (i & 3) + 8 * (i >> 2) + 4 * hh; }
DI float wave_sum(float v) { for (int o = 32; o > 0; o >>= 1) v += __shfl_xor(v, o); return v; }
DI float ex2(float x) { return __builtin_amdgcn_exp2f(x); }
DI bf16x8 pack8(float a0, float a1, float a2, float a3, float a4, float a5, float a6, float a7) {
  u32x4 u = {pack2(a0, a1), pack2(a2, a3), pack2(a4, a5), pack2(a6, a7)};
  return __builtin_bit_cast(bf16x8, u);
}
DI void store4bf(u16* dst, float a, float b, float c, float d) { u32x2 u = {pack2(a, b), pack2(c, d)}; *(u32x2*)dst = u; }
DI bf16x8 ld8(const u16* p) { return *(const bf16x8*)p; }
DI bf16x8 ld44(const u16* p) {
  s16x4 lo = *(const s16x4*)p; s16x4 hi = *(const s16x4*)(p + 8);
  return __builtin_shufflevector(lo, hi, 0, 1, 2, 3, 4, 5, 6, 7);
}
DI float row16_allsum(float v) {
  v += __int_as_float(__builtin_amdgcn_update_dpp(0, __float_as_int(v), 0x128, 0xf, 0xf, false));
  v += __int_as_float(__builtin_amdgcn_update_dpp(0, __float_as_int(v), 0x124, 0xf, 0xf, false));
  v += __int_as_float(__builtin_amdgcn_update_dpp(0, __float_as_int(v), 0x122, 0xf, 0xf, false));
  v += __int_as_float(__builtin_amdgcn_update_dpp(0, __float_as_int(v), 0x121, 0xf, 0xf, false));
  return v;
}

constexpr int BK = 64, LDP = BK + 8;
constexpr int BK2 = 32, LDP2 = BK2 + 8;
constexpr int SMEM_BYTES = 2 * 2 * 128 * LDP * 2;

struct RowPlain { const u16* base; int ld; DI unsigned off(int r) const { return (unsigned)(r * ld) * 2u; } };
struct RowGather {
  const u16* base; const int* list; int cnt;
  DI unsigned off(int r) const { int rr = r < cnt ? r : cnt - 1; return (unsigned)(list[rr] >> 1) * 2048u; }
};

template <bool SWAP, class RowA, class Epi>
DI void gemm_tile_t(const RowA& rowA, const u16* __restrict__ Bt, int ldb, int K, int m0, int n0, u16* sm, const Epi& epi) {
  const int tid = ltid(), lane = tid & 63, w = tid >> 6, wm = w >> 1, wn = w & 1;
  const int lr = tid >> 3, lc = tid & 7;
  u16* sa = sm; u16* sb = sm + 2 * 128 * LDP;
  const char* abase = (const char*)rowA.base; const char* bbase = (const char*)Bt;
  unsigned ao[4], bo[4];
#pragma unroll
  for (int i = 0; i < 4; ++i) { ao[i] = rowA.off(m0 + lr + 32 * i) + lc * 16; bo[i] = (unsigned)((n0 + lr + 32 * i) * ldb + lc * 8) * 2u; }
  f32x16 acc[2][2];
#pragma unroll
  for (int a = 0; a < 2; ++a)
#pragma unroll
    for (int b = 0; b < 2; ++b)
#pragma unroll
      for (int i = 0; i < 16; ++i) acc[a][b][i] = 0.f;
  u32x4 ra0[4], rb0[4], ra1[4], rb1[4];
  const int KT = K / BK;
#define G_LOAD(RA, RB, k0) { _Pragma("unroll") for (int i = 0; i < 4; ++i) { RA[i] = *(const u32x4*)(abase + (ao[i] + (unsigned)(k0) * 2u)); RB[i] = *(const u32x4*)(bbase + (bo[i] + (unsigned)(k0) * 2u)); } }
#define S_WRITE(RA, RB, buf) { u16* sa2 = sa + (buf) * 128 * LDP; u16* sb2 = sb + (buf) * 128 * LDP; _Pragma("unroll") for (int i = 0; i < 4; ++i) { *(u32x4*)(sa2 + (lr + 32 * i) * LDP + lc * 8) = RA[i]; *(u32x4*)(sb2 + (lr + 32 * i) * LDP + lc * 8) = RB[i]; } }
#define COMPUTE(buf) { const u16* A_ = sa + (buf) * 128 * LDP + (wm * 64 + (lane & 31)) * LDP + (lane >> 5) * 8; const u16* B_ = sb + (buf) * 128 * LDP + (wn * 64 + (lane & 31)) * LDP + (lane >> 5) * 8; \
    _Pragma("unroll") for (int s = 0; s < BK / 16; ++s) { bf16x8 a0 = ld8(A_ + s * 16), a1 = ld8(A_ + 32 * LDP + s * 16); bf16x8 b0 = ld8(B_ + s * 16), b1 = ld8(B_ + 32 * LDP + s * 16); \
      if (SWAP) { acc[0][0] = MFMA32(b0, a0, acc[0][0]); acc[0][1] = MFMA32(b0, a1, acc[0][1]); acc[1][0] = MFMA32(b1, a0, acc[1][0]); acc[1][1] = MFMA32(b1, a1, acc[1][1]); } \
      else { acc[0][0] = MFMA32(a0, b0, acc[0][0]); acc[0][1] = MFMA32(a0, b1, acc[0][1]); acc[1][0] = MFMA32(a1, b0, acc[1][0]); acc[1][1] = MFMA32(a1, b1, acc[1][1]); } } }
  G_LOAD(ra0, rb0, 0);
  S_WRITE(ra0, rb0, 0);
  if (KT > 1) G_LOAD(ra1, rb1, BK);
  __syncthreads();
  for (int kt = 0; kt < KT; kt += 2) {
    if (kt + 2 < KT) G_LOAD(ra0, rb0, (kt + 2) * BK);
    __builtin_amdgcn_sched_barrier(0);
    __builtin_amdgcn_s_setprio(1);
    COMPUTE(0);
    __builtin_amdgcn_s_setprio(0);
    if (kt + 1 < KT) S_WRITE(ra1, rb1, 1);
    __syncthreads();
    if (kt + 1 >= KT) break;
    if (kt + 3 < KT) G_LOAD(ra1, rb1, (kt + 3) * BK);
    __builtin_amdgcn_sched_barrier(0);
    __builtin_amdgcn_s_setprio(1);
    COMPUTE(1);
    __builtin_amdgcn_s_setprio(0);
    if (kt + 2 < KT) S_WRITE(ra0, rb0, 0);
    __syncthreads();
  }
#undef G_LOAD
#undef S_WRITE
#undef COMPUTE
  epi(acc, m0 + wm * 64, n0 + wn * 64, lane);
}

template <class RowA, class Epi>
DI void gemm_tile(const RowA& rowA, const u16* __restrict__ Bt, int ldb, int K, int m0, int n0, u16* sm, const Epi& epi) { gemm_tile_t<false>(rowA, Bt, ldb, K, m0, n0, sm, epi); }
template <class RowA, class Epi>
DI void gemm_tile_sw(const RowA& rowA, const u16* __restrict__ Bt, int ldb, int K, int m0, int n0, u16* sm, const Epi& epi) { gemm_tile_t<true>(rowA, Bt, ldb, K, m0, n0, sm, epi); }

template <class RowA, class Epi>
DI void gemm_tile256(const RowA& rowA, const u16* __restrict__ Bt, int ldb, int K, int m0, int n0, u16* sm, const Epi& epi) {
  const int tid = ltid(), lane = tid & 63, w = tid >> 6, wm = w >> 1, wn = w & 1;
  const int lr = tid >> 2, lc = tid & 3;
  u16* sa = sm; u16* sb = sm + 2 * 128 * LDP2;
  const char* abase = (const char*)rowA.base; const char* bbase = (const char*)Bt;
  unsigned ao[2], bo[4];
#pragma unroll
  for (int i = 0; i < 2; ++i) ao[i] = rowA.off(m0 + lr + 64 * i) + lc * 16;
#pragma unroll
  for (int i = 0; i < 4; ++i) bo[i] = (unsigned)((n0 + lr + 64 * i) * ldb + lc * 8) * 2u;
  f32x16 acc[2][4];
#pragma unroll
  for (int a = 0; a < 2; ++a)
#pragma unroll
    for (int b = 0; b < 4; ++b)
#pragma unroll
      for (int i = 0; i < 16; ++i) acc[a][b][i] = 0.f;
  u32x4 ra0[2], rb0[4], ra1[2], rb1[4];
  const int KT = K / BK2;
#define G_LOAD(RA, RB, k0) { _Pragma("unroll") for (int i = 0; i < 2; ++i) RA[i] = *(const u32x4*)(abase + (ao[i] + (unsigned)(k0) * 2u)); \
    _Pragma("unroll") for (int i = 0; i < 4; ++i) RB[i] = *(const u32x4*)(bbase + (bo[i] + (unsigned)(k0) * 2u)); }
#define S_WRITE(RA, RB, buf) { u16* sa2 = sa + (buf) * 128 * LDP2; u16* sb2 = sb + (buf) * 256 * LDP2; \
    _Pragma("unroll") for (int i = 0; i < 2; ++i) *(u32x4*)(sa2 + (lr + 64 * i) * LDP2 + lc * 8) = RA[i]; \
    _Pragma("unroll") for (int i = 0; i < 4; ++i) *(u32x4*)(sb2 + (lr + 64 * i) * LDP2 + lc * 8) = RB[i]; }
#define COMPUTE(buf) { const u16* A_ = sa + (buf) * 128 * LDP2 + (wm * 64 + (lane & 31)) * LDP2 + (lane >> 5) * 8; const u16* B_ = sb + (buf) * 256 * LDP2 + (wn * 128 + (lane & 31)) * LDP2 + (lane >> 5) * 8; \
    _Pragma("unroll") for (int s = 0; s < BK2 / 16; ++s) { bf16x8 a0 = ld8(A_ + s * 16), a1 = ld8(A_ + 32 * LDP2 + s * 16); \
      _Pragma("unroll") for (int nt = 0; nt < 4; ++nt) { bf16x8 bq = ld8(B_ + nt * 32 * LDP2 + s * 16); acc[0][nt] = MFMA32(a0, bq, acc[0][nt]); acc[1][nt] = MFMA32(a1, bq, acc[1][nt]); } } }
  G_LOAD(ra0, rb0, 0);
  S_WRITE(ra0, rb0, 0);
  if (KT > 1) G_LOAD(ra1, rb1, BK2);
  __syncthreads();
  for (int kt = 0; kt < KT; kt += 2) {
    if (kt + 2 < KT) G_LOAD(ra0, rb0, (kt + 2) * BK2);
    __builtin_amdgcn_sched_barrier(0);
    __builtin_amdgcn_s_setprio(1);
    COMPUTE(0);
    __builtin_amdgcn_s_setprio(0);
    if (kt + 1 < KT) S_WRITE(ra1, rb1, 1);
    __syncthreads();
    if (kt + 1 >= KT) break;
    if (kt + 3 < KT) G_LOAD(ra1, rb1, (kt + 3) * BK2);
    __builtin_amdgcn_sched_barrier(0);
    __builtin_amdgcn_s_setprio(1);
    COMPUTE(1);
    __builtin_amdgcn_s_setprio(0);
    if (kt + 2 < KT) S_WRITE(ra0, rb0, 0);
    __syncthreads();
  }
#undef G_LOAD
#undef S_WRITE
#undef COMPUTE
#pragma unroll
  for (int hf = 0; hf < 2; ++hf) {
    f32x16 sub[2][2];
#pragma unroll
    for (int a = 0; a < 2; ++a)
#pragma unroll
      for (int b = 0; b < 2; ++b) sub[a][b] = acc[a][2 * hf + b];
    epi(sub, m0 + wm * 64, n0 + wn * 128 + hf * 64, lane);
  }
}

struct EpiIn {
  char* u; const float* rope; float* rc;
  DI void operator()(f32x16 (&acc)[2][2], int mbase, int nbase, int lane) const {
    const int cgp = nbase >> 6, l32 = lane & 31, hh = lane >> 5;
    if (cgp < 8) {
      u16* dst = (u16*)(u + (cgp < 4 ? U_QA : U_KA)); const int c0 = (cgp & 3) * 64;
#pragma unroll
      for (int mt = 0; mt < 2; ++mt)
#pragma unroll
        for (int nt = 0; nt < 2; ++nt)
#pragma unroll
          for (int i = 0; i < 16; ++i) {
            const int row = mbase + mt * 32 + crow(i, hh);
            float v = acc[mt][nt][i]; float pv = __shfl_xor(v, 4);
            if (l32 < 8) { const int fi = l32 & 3; float c = rope[row * 24 + fi], s = rope[row * 24 + 4 + fi]; v = (l32 < 4) ? v * c - pv * s : v * c + pv * s; }
            dst[(size_t)row * 256 + c0 + nt * 32 + l32] = f2bf(v);
          }
    } else if (cgp < 12) {
      u16* dst = (u16*)(u + U_VAT); const int head = cgp - 8;
#pragma unroll
      for (int mt = 0; mt < 2; ++mt)
#pragma unroll
        for (int nt = 0; nt < 2; ++nt)
#pragma unroll
          for (int g = 0; g < 4; ++g) {
            const int row = mbase + mt * 32 + 8 * g + 4 * hh; const int b = row >> 11, t = row & 2047; const int dv = nt * 32 + l32;
            store4bf(dst + ((size_t)((b * 4 + head) * 64 + dv)) * SEQ + t, acc[mt][nt][4 * g], acc[mt][nt][4 * g + 1], acc[mt][nt][4 * g + 2], acc[mt][nt][4 * g + 3]);
          }
    } else if (cgp < 24) {
      const bool isq = cgp < 18;
      u16* dst = (u16*)(u + (isq ? U_QB : U_KB)); const int c0 = (cgp - (isq ? 12 : 18)) * 64;
#pragma unroll
      for (int mt = 0; mt < 2; ++mt)
#pragma unroll
        for (int nt = 0; nt < 2; ++nt)
#pragma unroll
          for (int i = 0; i < 16; ++i) {
            const int row = mbase + mt * 32 + crow(i, hh);
            float v = acc[mt][nt][i];
            if (nt == 0) {
              float pv = __shfl_xor(v, 8);
              if (l32 < 16) { const int fi = l32 & 7; float c = rope[row * 24 + 8 + fi], s = rope[row * 24 + 16 + fi]; v = (l32 < 8) ? v * c - pv * s : v * c + pv * s; }
            }
            dst[(size_t)row * 384 + c0 + nt * 32 + l32] = f2bf(v);
          }
    } else if (cgp < 30) {
      u16* d0 = (u16*)(u + U_VBT); u16* d1 = d0 + (size_t)MTOK * 384; u16* d2 = d1 + (size_t)MTOK * 384; const int head = cgp - 24;
#pragma unroll
      for (int mt = 0; mt < 2; ++mt)
#pragma unroll
        for (int nt = 0; nt < 2; ++nt)
#pragma unroll
          for (int g = 0; g < 4; ++g) {
            const int row = mbase + mt * 32 + 8 * g + 4 * hh; const int b = row >> 11, t = row & 2047; const int dv = nt * 32 + l32;
            const size_t rb_ = ((size_t)((b * 6 + head) * 64 + dv)) * SEQ;
            store4bf(d0 + rb_ + t, acc[mt][nt][4 * g], acc[mt][nt][4 * g + 1], acc[mt][nt][4 * g + 2], acc[mt][nt][4 * g + 3]);
#pragma unroll
            for (int j = 0; j < 4; ++j) {
              const int tt = t + j; const u16 bv = f2bf(acc[mt][nt][4 * g + j]);
              d1[rb_ + (tt & 3) * 512 + (tt >> 2)] = bv;
              d2[rb_ + (tt & 15) * 128 + (tt >> 4)] = bv;
            }
          }
    } else if (cgp < 48) {
      u16* dst = (u16*)(u + U_HC); const int c0 = (cgp - 30) * 64;
#pragma unroll
      for (int mt = 0; mt < 2; ++mt)
#pragma unroll
        for (int nt = 0; nt < 2; ++nt)
#pragma unroll
          for (int i = 0; i < 16; ++i) {
            const int row = mbase + mt * 32 + crow(i, hh);
            dst[(size_t)row * 1152 + c0 + nt * 32 + l32] = f2bf(acc[mt][nt][i]);
          }
    } else if (cgp == 48) {
      if (l32 < 16) {
#pragma unroll
        for (int mt = 0; mt < 2; ++mt)
#pragma unroll
          for (int i = 0; i < 16; ++i) { const int row = mbase + mt * 32 + crow(i, hh); rc[(size_t)row * 16 + l32] = acc[mt][0][i]; }
      }
    }
  }
};

struct EpiKV {
  u16* kx; u16* vt;
  DI void operator()(f32x16 (&acc)[2][2], int mbase, int nbase, int lane) const {
    const int l32 = lane & 31, hh = lane >> 5;
    if (nbase < 1024) {
#pragma unroll
      for (int mt = 0; mt < 2; ++mt)
#pragma unroll
        for (int nt = 0; nt < 2; ++nt)
#pragma unroll
          for (int i = 0; i < 16; ++i) { const int row = mbase + mt * 32 + crow(i, hh); kx[(size_t)row * 1024 + nbase + nt * 32 + l32] = f2bf(acc[mt][nt][i]); }
    } else {
#pragma unroll
      for (int mt = 0; mt < 2; ++mt)
#pragma unroll
        for (int nt = 0; nt < 2; ++nt)
#pragma unroll
          for (int g = 0; g < 4; ++g) {
            const int row = mbase + mt * 32 + 8 * g + 4 * hh; const int b = row >> 8, key = row & 255; const int c = nbase - 1024 + nt * 32 + l32;
            store4bf(vt + ((size_t)(b * 1024 + c)) * 256 + key, acc[mt][nt][4 * g], acc[mt][nt][4 * g + 1], acc[mt][nt][4 * g + 2], acc[mt][nt][4 * g + 3]);
          }
    }
  }
};

struct EpiResid {
  const float* src; const float* stats; const float* g; const float* b; float* y; int mode;
  DI void operator()(f32x16 (&acc)[2][2], int mbase, int nbase, int lane) const {
    const int l32 = lane & 31, hh = lane >> 5;
    float gg[2] = {1.f, 1.f}, bb[2] = {0.f, 0.f};
    if (mode) { gg[0] = g[nbase + l32]; gg[1] = g[nbase + 32 + l32]; bb[0] = b[nbase + l32]; bb[1] = b[nbase + 32 + l32]; }
#pragma unroll
    for (int mt = 0; mt < 2; ++mt)
#pragma unroll
      for (int i = 0; i < 16; ++i) {
        const int row = mbase + mt * 32 + crow(i, hh);
        float mean = 0.f, rstd = 1.f;
        if (mode) { const float2 st = *(const float2*)(stats + (size_t)row * 2); mean = st.x; rstd = st.y; }
#pragma unroll
        for (int nt = 0; nt < 2; ++nt) {
          const size_t o = (size_t)row * 1024 + nbase + nt * 32 + l32;
          const float r = (src[o] - mean) * rstd * gg[nt] + bb[nt];
          y[o] = ALPHA * r + acc[mt][nt][i];
        }
      }
  }
};

struct EpiResidT {
  const float* src; const float* stats; const float* g; const float* b; float* y; int mode;
  DI void operator()(f32x16 (&acc)[2][2], int mbase, int nbase, int lane) const {
    const int l32 = lane & 31, hh = lane >> 5;
#pragma unroll
    for (int mt = 0; mt < 2; ++mt) {
      const int row = mbase + mt * 32 + l32;
      float mean = 0.f, rstd = 1.f;
      if (mode) { const float2 st = *(const float2*)(stats + (size_t)row * 2); mean = st.x; rstd = st.y; }
#pragma unroll
      for (int nt = 0; nt < 2; ++nt)
#pragma unroll
        for (int gq = 0; gq < 4; ++gq) {
          const int c0 = nbase + nt * 32 + 8 * gq + 4 * hh;
          const size_t o = (size_t)row * 1024 + c0;
          float4 r = *(const float4*)(src + o);
          if (mode) {
            const float4 gv = *(const float4*)(g + c0), bv = *(const float4*)(b + c0);
            r.x = (r.x - mean) * rstd * gv.x + bv.x; r.y = (r.y - mean) * rstd * gv.y + bv.y; r.z = (r.z - mean) * rstd * gv.z + bv.z; r.w = (r.w - mean) * rstd * gv.w + bv.w;
          }
          float4 ov;
          ov.x = ALPHA * r.x + acc[nt][mt][4 * gq]; ov.y = ALPHA * r.y + acc[nt][mt][4 * gq + 1]; ov.z = ALPHA * r.z + acc[nt][mt][4 * gq + 2]; ov.w = ALPHA * r.w + acc[nt][mt][4 * gq + 3];
          *(float4*)(y + o) = ov;
        }
    }
  }
};

struct EpiBfT {
  u16* dst; int ld;
  DI void operator()(f32x16 (&acc)[2][2], int mbase, int nbase, int lane) const {
    const int l32 = lane & 31, hh = lane >> 5;
#pragma unroll
    for (int mt = 0; mt < 2; ++mt)
#pragma unroll
      for (int nt = 0; nt < 2; ++nt)
#pragma unroll
        for (int gq = 0; gq < 4; ++gq)
          store4bf(dst + (size_t)(mbase + mt * 32 + l32) * ld + nbase + nt * 32 + 8 * gq + 4 * hh, acc[nt][mt][4 * gq], acc[nt][mt][4 * gq + 1], acc[nt][mt][4 * gq + 2], acc[nt][mt][4 * gq + 3]);
  }
};

struct EpiMoe2T {
  u16* mo; const int* list; const float* gl; int cnt;
  DI void operator()(f32x16 (&acc)[2][2], int mbase, int nbase, int lane) const {
    const int l32 = lane & 31, hh = lane >> 5;
#pragma unroll
    for (int mt = 0; mt < 2; ++mt) {
      const int r = mbase + mt * 32 + l32;
      if (r < cnt) {
        const int tk = list[r]; const float gw = gl[r];
#pragma unroll
        for (int nt = 0; nt < 2; ++nt)
#pragma unroll
          for (int gq = 0; gq < 4; ++gq)
            store4bf(mo + (size_t)tk * 1024 + nbase + nt * 32 + 8 * gq + 4 * hh, gw * acc[nt][mt][4 * gq], gw * acc[nt][mt][4 * gq + 1], gw * acc[nt][mt][4 * gq + 2], gw * acc[nt][mt][4 * gq + 3]);
      }
    }
  }
};

struct EpiBf {
  u16* dst; int ld;
  DI void operator()(f32x16 (&acc)[2][2], int mbase, int nbase, int lane) const {
    const int l32 = lane & 31, hh = lane >> 5;
#pragma unroll
    for (int mt = 0; mt < 2; ++mt)
#pragma unroll
      for (int nt = 0; nt < 2; ++nt)
#pragma unroll
        for (int i = 0; i < 16; ++i) dst[(size_t)(mbase + mt * 32 + crow(i, hh)) * ld + nbase + nt * 32 + l32] = f2bf(acc[mt][nt][i]);
  }
};

struct EpiSwiglu {
  u16* hid; int ld; int rowoff;
  DI void operator()(f32x16 (&acc)[2][2], int mbase, int nbase, int lane) const {
    const int l32 = lane & 31, hh = lane >> 5; const int hc = (nbase >> 6) * 32 + l32;
#pragma unroll
    for (int mt = 0; mt < 2; ++mt)
#pragma unroll
      for (int i = 0; i < 16; ++i) {
        const float g = acc[mt][0][i], up = acc[mt][1][i];
        const float h = g * __builtin_amdgcn_rcpf(1.f + __expf(-g)) * up;
        hid[(size_t)(rowoff + mbase + mt * 32 + crow(i, hh)) * ld + hc] = f2bf(h);
      }
  }
};

struct EpiMoe2 {
  u16* mo; const int* list; const float* gl; int cnt;
  DI void operator()(f32x16 (&acc)[2][2], int mbase, int nbase, int lane) const {
    const int l32 = lane & 31, hh = lane >> 5;
#pragma unroll
    for (int mt = 0; mt < 2; ++mt)
#pragma unroll
      for (int i = 0; i < 16; ++i) {
        const int r = mbase + mt * 32 + crow(i, hh);
        if (r < cnt) {
          const int tk = list[r]; const float gw = gl[r];
#pragma unroll
          for (int nt = 0; nt < 2; ++nt) mo[(size_t)tk * 1024 + nbase + nt * 32 + l32] = f2bf(gw * acc[mt][nt][i]);
        }
      }
  }
};

DI int dst_row(int n, int mode, int N) {
  if (mode == 0) return n;
  const int F = N >> 1;
  return n < F ? ((n >> 5) * 64 + (n & 31)) : (((n - F) >> 5) * 64 + 32 + ((n - F) & 31));
}
constexpr int TR_TILES = 2 * 2080 + 1408 + 704 + 8 * 1792 + 8 * 896;
DI void get_job(const Params& p, int t, Job& jb, int& lt) {
  char* ws = lws(p);
  if (t < 4160) {
    const int l = t / 2080, r = t % 2080;
    if (r < 800) { jb.src = p.w_in + (size_t)l * 1024 * 3088; jb.dst = (u16*)(ws + OFF_WT_IN) + (size_t)l * INP * 1024; jb.K = 1024; jb.N = 3088; jb.Npad = INP; jb.mode = 0; lt = r; }
    else if (r < 1056) { jb.src = p.w_out + (size_t)l * 1024 * 1024; jb.dst = (u16*)(ws + OFF_WT_OUT) + (size_t)l * 1024 * 1024; jb.K = 1024; jb.N = 1024; jb.Npad = 1024; jb.mode = 0; lt = r - 800; }
    else if (r < 1312) { jb.src = p.xa_wq + (size_t)l * 1024 * 1024; jb.dst = (u16*)(ws + OFF_WT_Q) + (size_t)l * 1024 * 1024; jb.K = 1024; jb.N = 1024; jb.Npad = 1024; jb.mode = 0; lt = r - 1056; }
    else if (r < 1824) { jb.src = p.xa_wkv + (size_t)l * 1024 * 2048; jb.dst = (u16*)(ws + OFF_WT_KV) + (size_t)l * 2048 * 1024; jb.K = 1024; jb.N = 2048; jb.Npad = 2048; jb.mode = 0; lt = r - 1312; }
    else { jb.src = p.xa_wo + (size_t)l * 1024 * 1024; jb.dst = (u16*)(ws + OFF_WT_O) + (size_t)l * 1024 * 1024; jb.K = 1024; jb.N = 1024; jb.Npad = 1024; jb.mode = 0; lt = r - 1824; }
  } else if (t < 5568) { jb.src = p.ffd_w13; jb.dst = (u16*)(ws + OFF_WT_F13); jb.K = 1024; jb.N = 2 * FD; jb.Npad = 2 * FD; jb.mode = 1; lt = t - 4160; }
  else if (t < 6272) { jb.src = p.ffd_w2; jb.dst = (u16*)(ws + OFF_WT_F2); jb.K = FD; jb.N = 1024; jb.Npad = 1024; jb.mode = 0; lt = t - 5568; }
  else if (t < 20608) { const int e = (t - 6272) / 1792; jb.src = p.moe_w13 + (size_t)e * 1024 * 2 * FM; jb.dst = (u16*)(ws + OFF_WT_M13) + (size_t)e * 2 * FM * 1024; jb.K = 1024; jb.N = 2 * FM; jb.Npad = 2 * FM; jb.mode = 1; lt = (t - 6272) % 1792; }
  else { const int e = (t - 20608) / 896; jb.src = p.moe_w2 + (size_t)e * FM * 1024; jb.dst = (u16*)(ws + OFF_WT_M2) + (size_t)e * 1024 * FM; jb.K = FM; jb.N = 1024; jb.Npad = 1024; jb.mode = 0; lt = (t - 20608) % 896; }
}
DI void tr_load(const Job& jb, int lt, float (&v)[16]) {
  const int tid = ltid(); const int tn = jb.Npad >> 6; const int tk = lt / tn, tnn = lt % tn; const int k0 = tk * 64, n0 = tnn * 64;
  const int j = tid & 63;
#pragma unroll
  for (int i = 0; i < 16; ++i) {
    const int k = i * 4 + (tid >> 6);
    v[i] = (n0 + j < jb.N) ? jb.src[(size_t)(k0 + k) * jb.N + n0 + j] : 0.f;
  }
}
DI void tr_store(const Job& jb, int lt, const float (&v)[16], float* ts) {
  const int tid = ltid(); const int tn = jb.Npad >> 6; const int tk = lt / tn, tnn = lt % tn; const int k0 = tk * 64, n0 = tnn * 64;
  const int j = tid & 63;
#pragma unroll
  for (int i = 0; i < 16; ++i) ts[(i * 4 + (tid >> 6)) * 65 + j] = v[i];
  __syncthreads();
  const int nr = tid >> 2; const int drow = (n0 + nr < jb.N) ? dst_row(n0 + nr, jb.mode, jb.N) : (n0 + nr);
#pragma unroll
  for (int cc = 0; cc < 2; ++cc) {
    const int c = (tid & 3) + 4 * cc; const float* t0 = ts + (c * 8) * 65 + nr;
    u32x4 u = {pack2(t0[0], t0[65]), pack2(t0[130], t0[195]), pack2(t0[260], t0[325]), pack2(t0[390], t0[455])};
    *(u32x4*)(jb.dst + (size_t)drow * jb.K + k0 + c * 8) = u;
  }
  __syncthreads();
}
DI void sincos_acc(float ang, float& c, float& s) {
  const double x = (double)ang;
  const double n = rint(x * 0.63661977236758134308);
  double r = fma(-n, 1.57079632679489655800e+00, x);
  r = fma(-n, 6.12323399573676603587e-17, r);
  const double r2 = r * r;
  double sp = -7.6471637318198164759e-13; sp = fma(sp, r2, 1.6059043836821614599e-10); sp = fma(sp, r2, -2.5052108385441718775e-8);
  sp = fma(sp, r2, 2.7557319223985890653e-6); sp = fma(sp, r2, -1.9841269841269841270e-4); sp = fma(sp, r2, 8.3333333333333333333e-3);
  sp = fma(sp, r2, -1.6666666666666666667e-1); const double sv = fma(sp * r2, r, r);
  double cp = 4.7794773323873852974e-14; cp = fma(cp, r2, -1.1470745597729724714e-11); cp = fma(cp, r2, 2.0876756987868098979e-9);
  cp = fma(cp, r2, -2.7557319223985890653e-7); cp = fma(cp, r2, 2.4801587301587301587e-5); cp = fma(cp, r2, -1.3888888888888888889e-3);
  cp = fma(cp, r2, 4.1666666666666666667e-2); cp = fma(cp, r2, -0.5); const double cv = fma(cp, r2, 1.0);
  const int q = ((int)n) & 3;
  const double so = (q == 0) ? sv : (q == 1) ? cv : (q == 2) ? -sv : -cv;
  const double co = (q == 0) ? cv : (q == 1) ? -sv : (q == 2) ? -cv : sv;
  c = (float)co; s = (float)so;
}

DI void softmax_tile(f32x16& S, float sc, float& mrun, float& lrun, float& corr, bf16x8& p0, bf16x8& p1) {
  float tmax = S[0];
#pragma unroll
  for (int i = 1; i < 16; ++i) tmax = fmaxf(tmax, S[i]);
  tmax = fmaxf(tmax, __shfl_xor(tmax, 32));
  const float mnew = fmaxf(mrun, tmax * sc);
  corr = ex2(mrun - mnew);
  float ps = 0.f;
#pragma unroll
  for (int i = 0; i < 16; ++i) { S[i] = ex2(__builtin_fmaf(S[i], sc, -mnew)); ps += S[i]; }
  lrun = lrun * corr + ps; mrun = mnew;
  p0 = pack8(S[0], S[1], S[2], S[3], S[4], S[5], S[6], S[7]);
  p1 = pack8(S[8], S[9], S[10], S[11], S[12], S[13], S[14], S[15]);
}

DI void vperm_store(u16* row, int ch, u32x4 v) {
  const int s = ch >> 1, c = ch & 1;
  u32x2 lo = {v[0], v[1]}, hi = {v[2], v[3]};
  *(u32x2*)(row + 16 * s + 4 * c) = lo;
  *(u32x2*)(row + 16 * s + 8 + 4 * c) = hi;
}

DI void mixA_block(const Params& p, int L, int b, int h, int qblk, float lam, float lam_init, char* smem) {
  const int tid = ltid(), lane = tid & 63, w = tid >> 6, l32 = lane & 31, hh = lane >> 5;
  char* wsl_ = lws(p);
  char* u = wsl_ + OFF_UNION;
  const int q0 = qblk * 128 + w * 32;
  const u16* Q = (const u16*)(u + U_QA) + (size_t)(b * SEQ) * 256 + h * 64;
  const u16* Kg = (const u16*)(u + U_KA) + (size_t)(b * SEQ) * 256 + h * 64;
  const u16* Vg = (const u16*)(u + U_VAT) + (size_t)((b * 4 + h) * 64) * SEQ;
  u16* Ks = (u16*)smem; u16* Vs = Ks + 2 * 64 * 72;
  bf16x8 qf[2][2];
#pragma unroll
  for (int mp = 0; mp < 2; ++mp)
#pragma unroll
    for (int s = 0; s < 2; ++s) qf[mp][s] = ld8(Q + (size_t)(q0 + l32) * 256 + mp * 32 + s * 16 + hh * 8);
  f32x16 O[2][2];
#pragma unroll
  for (int a = 0; a < 2; ++a)
#pragma unroll
    for (int c = 0; c < 2; ++c)
#pragma unroll
      for (int i = 0; i < 16; ++i) O[a][c][i] = 0.f;
  float mrun[2] = {-1e30f, -1e30f}, lrun[2] = {0.f, 0.f};
  const float sc = 0.17677669529663687f * LOG2E;
  const int nkt = 2 * (qblk + 1);
  const int r0 = tid >> 3, ch = tid & 7;
  u32x4 rk[2], rv[2];
#pragma unroll
  for (int i = 0; i < 2; ++i) {
    rk[i] = *(const u32x4*)(Kg + (size_t)(r0 + 32 * i) * 256 + ch * 8);
    rv[i] = *(const u32x4*)(Vg + (size_t)(r0 + 32 * i) * SEQ + ch * 8);
  }
#pragma unroll
  for (int i = 0; i < 2; ++i) { *(u32x4*)(Ks + (r0 + 32 * i) * 72 + ch * 8) = rk[i]; vperm_store(Vs + (r0 + 32 * i) * 72, ch, rv[i]); }
  __syncthreads();
  for (int kt = 0; kt < nkt; ++kt) {
    const int buf = kt & 1;
    if (kt + 1 < nkt) {
      const int k1 = (kt + 1) * 64;
#pragma unroll
      for (int i = 0; i < 2; ++i) {
        rk[i] = *(const u32x4*)(Kg + (size_t)(k1 + r0 + 32 * i) * 256 + ch * 8);
        rv[i] = *(const u32x4*)(Vg + (size_t)(r0 + 32 * i) * SEQ + k1 + ch * 8);
      }
    }
    __builtin_amdgcn_sched_barrier(0);
    const u16* Kb = Ks + buf * 64 * 72; const u16* Vb = Vs + buf * 64 * 72;
#pragma unroll
    for (int ks = 0; ks < 2; ++ks) {
      const int kb = kt * 64 + ks * 32;
      if (kb <= q0) {
        const bool diag = (kb == q0);
        bf16x8 vf[2][2];
#pragma unroll
        for (int mt = 0; mt < 2; ++mt)
#pragma unroll
          for (int s2 = 0; s2 < 2; ++s2) vf[mt][s2] = ld8(Vb + (mt * 32 + l32) * 72 + (ks * 2 + s2) * 16 + hh * 8);
#pragma unroll
        for (int mp = 0; mp < 2; ++mp) {
          f32x16 S;
#pragma unroll
          for (int i = 0; i < 16; ++i) S[i] = 0.f;
          S = MFMA32(ld8(Kb + (ks * 32 + l32) * 72 + mp * 32 + hh * 8), qf[mp][0], S);
          S = MFMA32(ld8(Kb + (ks * 32 + l32) * 72 + mp * 32 + 16 + hh * 8), qf[mp][1], S);
#pragma unroll
          for (int i = 0; i < 16; ++i) S[i] = (diag && crow(i, hh) > l32) ? -1e30f : S[i];
          float corr; bf16x8 pf0, pf1;
          softmax_tile(S, sc, mrun[mp], lrun[mp], corr, pf0, pf1);
#pragma unroll
          for (int mt = 0; mt < 2; ++mt) {
#pragma unroll
            for (int i = 0; i < 16; ++i) O[mp][mt][i] *= corr;
            O[mp][mt] = MFMA32(vf[mt][0], pf0, O[mp][mt]);
            O[mp][mt] = MFMA32(vf[mt][1], pf1, O[mp][mt]);
          }
        }
      }
    }
    if (kt + 1 < nkt) {
      u16* Kn = Ks + (buf ^ 1) * 64 * 72; u16* Vn = Vs + (buf ^ 1) * 64 * 72;
#pragma unroll
      for (int i = 0; i < 2; ++i) { *(u32x4*)(Kn + (r0 + 32 * i) * 72 + ch * 8) = rk[i]; vperm_store(Vn + (r0 + 32 * i) * 72, ch, rv[i]); }
    }
    __syncthreads();
  }
  const float l0 = lrun[0] + __shfl_xor(lrun[0], 32), l1 = lrun[1] + __shfl_xor(lrun[1], 32);
  const float i0 = 1.f / l0, i1 = lam / l1;
  float ssq = 0.f;
#pragma unroll
  for (int mt = 0; mt < 2; ++mt)
#pragma unroll
    for (int i = 0; i < 16; ++i) { const float o = O[0][mt][i] * i0 - O[1][mt][i] * i1; O[0][mt][i] = o; ssq += o * o; }
  ssq += __shfl_xor(ssq, 32);
  const float rs = rsqrtf(ssq * (1.f / 64.f) + LN_EPS) * (1.f - lam_init);
  const float* gg = p.diff_g + L * 64;
  u16* om = (u16*)(u + U_OMIX) + (size_t)(b * SEQ + q0 + l32) * 1024 + h * 64;
#pragma unroll
  for (int mt = 0; mt < 2; ++mt)
#pragma unroll
    for (int g = 0; g < 4; ++g) {
      const int dv = mt * 32 + 8 * g + 4 * hh;
      store4bf(om + dv, O[0][mt][4 * g] * rs * gg[dv], O[0][mt][4 * g + 1] * rs * gg[dv + 1], O[0][mt][4 * g + 2] * rs * gg[dv + 2], O[0][mt][4 * g + 3] * rs * gg[dv + 3]);
    }
}

DI void mixB_block(const Params& p, int b, int h, int g, int sb, char* smem) {
  const int tid = ltid(), lane = tid & 63, w = tid >> 6, l32 = lane & 31, hh = lane >> 5;
  char* wsl_ = lws(p);
  char* u = wsl_ + OFF_UNION;
  const int rsh = 2 * g; const int r = 1 << rsh; const int sub_len = SEQ >> rsh; const int tpr = sub_len >> 5;
  const int rho = (sb * 4) / tpr, it0 = (sb * 4) % tpr; const int i0 = it0 * 32;
  const u16* Q = (const u16*)(u + U_QB) + (size_t)(b * SEQ) * 384 + h * 64;
  const u16* Kg = (const u16*)(u + U_KB) + (size_t)(b * SEQ) * 384 + h * 64;
  const u16* Vg = (const u16*)(u + U_VBT) + (size_t)g * MTOK * 384 + (size_t)((b * 6 + h) * 64) * SEQ + rho * sub_len;
  u16* Ks = (u16*)smem; u16* Vs = Ks + 256 * 72;
  const int kbase = i0 - 128;
#pragma unroll
  for (int i = 0; i < 8; ++i) {
    const int c = tid + 256 * i;
    { const int row = c >> 3, ch = c & 7; const int ki = kbase + row;
      if (ki >= 0) *(u32x4*)(Ks + row * 72 + ch * 8) = *(const u32x4*)(Kg + (size_t)(ki * r + rho) * 384 + ch * 8); }
    { const int dv = c >> 5, ch = c & 31; const int ki = kbase + ch * 8;
      if (ki >= 0) vperm_store(Vs + dv * 264, ch, *(const u32x4*)(Vg + (size_t)dv * SEQ + ki)); }
  }
  const int iq = i0 + w * 32;
  const int tq = (iq + l32) * r + rho;
  bf16x8 qf[4];
#pragma unroll
  for (int s = 0; s < 4; ++s) qf[s] = ld8(Q + (size_t)tq * 384 + s * 16 + hh * 8);
  __syncthreads();
  f32x16 O[2];
#pragma unroll
  for (int a = 0; a < 2; ++a)
#pragma unroll
    for (int i = 0; i < 16; ++i) O[a][i] = 0.f;
  float mrun = -1e30f, lrun = 0.f;
  const float sc = 0.125f * LOG2E;
  for (int kt = 0; kt < 5; ++kt) {
    const int lb = 32 * w + 32 * kt;
    if (kbase + lb < 0) continue;
    f32x16 S;
#pragma unroll
    for (int i = 0; i < 16; ++i) S[i] = 0.f;
#pragma unroll
    for (int s = 0; s < 4; ++s) S = MFMA32(ld8(Ks + (lb + l32) * 72 + s * 16 + hh * 8), qf[s], S);
#pragma unroll
    for (int i = 0; i < 16; ++i) {
      const int kk = crow(i, hh);
      const bool bad = (kt == 0 && kk < l32) || (kt == 4 && kk > l32);
      S[i] = bad ? -1e30f : S[i];
    }
    float corr; bf16x8 pf0, pf1;
    softmax_tile(S, sc, mrun, lrun, corr, pf0, pf1);
#pragma unroll
    for (int mt = 0; mt < 2; ++mt) {
#pragma unroll
      for (int i = 0; i < 16; ++i) O[mt][i] *= corr;
      O[mt] = MFMA32(ld8(Vs + (mt * 32 + l32) * 264 + lb + hh * 8), pf0, O[mt]);
      O[mt] = MFMA32(ld8(Vs + (mt * 32 + l32) * 264 + lb + 16 + hh * 8), pf1, O[mt]);
    }
  }
  const float lt = lrun + __shfl_xor(lrun, 32);
  const float inv = 1.f / lt;
  const size_t tok = (size_t)b * SEQ + tq;
  u16* po = (u16*)(u + U_PBO) + (size_t)g * MTOK * 384 + tok * 384 + h * 64;
#pragma unroll
  for (int mt = 0; mt < 2; ++mt)
#pragma unroll
    for (int gq = 0; gq < 4; ++gq) {
      const int dv = mt * 32 + 8 * gq + 4 * hh;
      store4bf(po + dv, O[mt][4 * gq] * inv, O[mt][4 * gq + 1] * inv, O[mt][4 * gq + 2] * inv, O[mt][4 * gq + 3] * inv);
    }
  if (hh == 0) {
    float* lse = (float*)(wsl_ + OFF_LSE) + (size_t)g * MTOK * 8;
    lse[tok * 8 + h] = (mrun + __builtin_amdgcn_logf(lt)) * LN2;
  }
  __syncthreads();
}

DI void gla_item(const Params& p, int L, int b, int h, int vg, char* smem) {
  const int tid = ltid(), lane = tid & 63, w = tid >> 6;
  char* wsl_ = lws(p);
  const int kg = lane & 15, vl = lane >> 4;
  char* u = wsl_ + OFF_UNION;
  const u16* hc = (const u16*)(u + U_HC);
  const float* rc = (const float*)(wsl_ + OFF_RC);
  float* go = (float*)(u + U_GLAO);
  float* a_s = (float*)smem;
  float* k_s = a_s + 64 * 48;
  float* q_s = k_s + 64 * 48;
  float* vs = q_s + 64 * 48;
  float* os = vs + 64 * 16;
  float* rcs = os + 64 * 16;
  float wcol[16]; float ba = 0.f;
  const int sd = tid % 48, stg = tid / 48;
  if (tid < 192) {
#pragma unroll
    for (int j = 0; j < 16; ++j) wcol[j] = p.gla_wa2[(size_t)L * 16 * 192 + j * 192 + h * 48 + sd];
    ba = p.gla_ba[L * 192 + h * 48 + sd];
  } else {
#pragma unroll
    for (int j = 0; j < 16; ++j) wcol[j] = 0.f;
  }
  float S0 = 0.f, S1 = 0.f, S2 = 0.f;
  const float qsc = 0.14433756729740643f;
  float4 rcv; u32x2 qv[3], kv[3], vv;
  const int t4 = tid >> 2, p4 = tid & 3;
  {
    const size_t rowb = (size_t)b * SEQ;
    rcv = *(const float4*)(rc + (rowb + t4) * 16 + p4 * 4);
#pragma unroll
    for (int i = 0; i < 3; ++i) { const int c = tid + 256 * i; const int tk = c / 12, pt = c % 12; qv[i] = *(const u32x2*)(hc + (rowb + tk) * 1152 + h * 48 + pt * 4); kv[i] = *(const u32x2*)(hc + (rowb + tk) * 1152 + 192 + h * 48 + pt * 4); }
    vv = *(const u32x2*)(hc + (rowb + t4) * 1152 + 384 + h * 96 + vg * 16 + p4 * 4);
  }
  for (int seg = 0; seg < SEQ / 64; ++seg) {
    const size_t rowb = (size_t)b * SEQ + seg * 64;
    *(float4*)(rcs + t4 * 16 + p4 * 4) = rcv;
#pragma unroll
    for (int i = 0; i < 3; ++i) {
      const int c = tid + 256 * i; const int tk = c / 12, pt = c % 12; const int o = tk * 48 + pt * 4;
      *(float4*)(k_s + o) = make_float4(__uint_as_float(kv[i][0] << 16), __uint_as_float(kv[i][0] & 0xffff0000u), __uint_as_float(kv[i][1] << 16), __uint_as_float(kv[i][1] & 0xffff0000u));
      *(float4*)(q_s + o) = make_float4(__uint_as_float(qv[i][0] << 16) * qsc, __uint_as_float(qv[i][0] & 0xffff0000u) * qsc, __uint_as_float(qv[i][1] << 16) * qsc, __uint_as_float(qv[i][1] & 0xffff0000u) * qsc);
    }
    {
      float4 vf4 = make_float4(__uint_as_float(vv[0] << 16), __uint_as_float(vv[0] & 0xffff0000u), __uint_as_float(vv[1] << 16), __uint_as_float(vv[1] & 0xffff0000u));
      *(float4*)(vs + t4 * 16 + p4 * 4) = vf4;
    }
    __syncthreads();
    if (seg + 1 < SEQ / 64) {
      const size_t rn = rowb + 64;
      rcv = *(const float4*)(rc + (rn + t4) * 16 + p4 * 4);
#pragma unroll
      for (int i = 0; i < 3; ++i) { const int c = tid + 256 * i; const int tk = c / 12, pt = c % 12; qv[i] = *(const u32x2*)(hc + (rn + tk) * 1152 + h * 48 + pt * 4); kv[i] = *(const u32x2*)(hc + (rn + tk) * 1152 + 192 + h * 48 + pt * 4); }
      vv = *(const u32x2*)(hc + (rn + t4) * 1152 + 384 + h * 96 + vg * 16 + p4 * 4);
    }
    __builtin_amdgcn_sched_barrier(0);
    if (tid < 192) {
#pragma unroll 4
      for (int tt = 0; tt < 16; ++tt) {
        const int tl = stg * 16 + tt;
        const float4* r4 = (const float4*)(rcs + tl * 16);
        float z = ba;
#pragma unroll
        for (int j4 = 0; j4 < 4; ++j4) { const float4 rv = r4[j4]; z += rv.x * wcol[4 * j4] + rv.y * wcol[4 * j4 + 1] + rv.z * wcol[4 * j4 + 2] + rv.w * wcol[4 * j4 + 3]; }
        const float a = ex2(-0.0625f * __builtin_amdgcn_logf(1.f + ex2(-z * LOG2E)));
        a_s[tl * 48 + sd] = a;
      }
    }
    __syncthreads();
#pragma unroll 1
    for (int tb = 0; tb < 64; tb += 16) {
      float okeep = 0.f;
#pragma unroll
      for (int tt = 0; tt < 16; ++tt) {
        const int tl = tb + tt;
        const int o3 = tl * 48 + kg * 3;
        const float a0 = a_s[o3], a1 = a_s[o3 + 1], a2 = a_s[o3 + 2];
        const float k0_ = k_s[o3], k1_ = k_s[o3 + 1], k2_ = k_s[o3 + 2];
        const float q0_ = q_s[o3], q1_ = q_s[o3 + 1], q2_ = q_s[o3 + 2];
        const float v = vs[tl * 16 + w * 4 + vl];
        S0 = a0 * S0 + k0_ * v; S1 = a1 * S1 + k1_ * v; S2 = a2 * S2 + k2_ * v;
        float o = q0_ * S0 + q1_ * S1 + q2_ * S2;
        o = row16_allsum(o);
        okeep = (kg == tt) ? o : okeep;
      }
      os[(tb + kg) * 16 + w * 4 + vl] = okeep;
    }
    __syncthreads();
    {
      const float4 ov = *(const float4*)(os + t4 * 16 + p4 * 4);
      *(float4*)(go + (rowb + t4) * 384 + h * 96 + vg * 16 + p4 * 4) = ov;
    }
  }
  __syncthreads();
}

DI int perm16(int t) { return (t & ~12) | ((t & 4) << 1) | ((t & 8) >> 1); }
DI void gla_mfma_item(const Params& p, int L, int b, int h, char* smem) {
  const int tid = ltid(), lane = tid & 63, w = tid >> 6, l32 = lane & 31, hh = lane >> 5;
  char* wsl_ = lws(p);
  char* u = wsl_ + OFF_UNION;
  const u16* hc = (const u16*)(u + U_HC);
  const float* rc = (const float*)(wsl_ + OFF_RC);
  float* go = (float*)(u + U_GLAO);
  u16* Qb = (u16*)smem;
  u16* QbP = Qb + 32 * 56;
  u16* Kb = QbP + 32 * 56;
  u16* KlT = Kb + 32 * 56;
  u16* Vt = KlT + 64 * 40;
  float* ebl = (float*)(Vt + 96 * 40);
  float* tot = ebl + 64;
  float* rcs = tot + 4 * 48;
  const int sd = tid % 48, stg = tid / 48;
  float wcol[16]; float ba = 0.f;
#pragma unroll
  for (int j = 0; j < 16; ++j) wcol[j] = (tid < 192) ? p.gla_wa2[(size_t)L * 16 * 192 + j * 192 + h * 48 + sd] : 0.f;
  if (tid < 192) ba = p.gla_ba[L * 192 + h * 48 + sd];
  for (int i = tid; i < 16 * 40; i += NTHR) KlT[48 * 40 + i] = 0;
  if (tid < 64) ebl[tid] = 0.f;
  f32x16 S0, S1;
#pragma unroll
  for (int i = 0; i < 16; ++i) { S0[i] = 0.f; S1[i] = 0.f; }
  const float qsc = 0.14433756729740643f;
  const int sdc = sd < 48 ? sd : 0;
  u16 rq[8], rk[8], rvv[12]; float rr[2];
  const size_t row00 = (size_t)b * SEQ;
  const unsigned oqk = (unsigned)((stg & 3) * 8) * 1152u + (unsigned)(h * 48 + sdc);
#define GL_LOAD(rowb) { const u16* hcb_ = hc + (rowb) * 1152; const float* rcb_ = rc + (rowb) * 16; \
    _Pragma("unroll") for (int tt = 0; tt < 8; ++tt) { rq[tt] = hcb_[oqk + (unsigned)tt * 1152u]; rk[tt] = hcb_[oqk + (unsigned)tt * 1152u + 192u]; } \
    _Pragma("unroll") for (int i = 0; i < 12; ++i) { const unsigned e_ = (unsigned)(tid + 256 * i); rvv[i] = hcb_[(e_ / 96u) * 1152u + 384u + (unsigned)(h * 96) + e_ % 96u]; } \
    _Pragma("unroll") for (int i = 0; i < 2; ++i) rr[i] = rcb_[tid + 256 * i]; }
  GL_LOAD(row00)
  for (int ch = 0; ch < SEQ / 32; ++ch) {
    const size_t rowb = row00 + ch * 32;
    rcs[tid] = rr[0]; rcs[tid + 256] = rr[1];
#pragma unroll
    for (int i = 0; i < 12; ++i) { const int e_ = tid + 256 * i; Vt[(e_ % 96) * 40 + perm16(e_ / 96)] = rvv[i]; }
    __syncthreads();
    float c2[8]; float run = 0.f;
    if (tid < 192) {
#pragma unroll
      for (int tt = 0; tt < 8; ++tt) {
        const float4* r4 = (const float4*)(rcs + (stg * 8 + tt) * 16);
        float z = ba;
#pragma unroll
        for (int j4 = 0; j4 < 4; ++j4) { const float4 rv = r4[j4]; z += rv.x * wcol[4 * j4] + rv.y * wcol[4 * j4 + 1] + rv.z * wcol[4 * j4 + 2] + rv.w * wcol[4 * j4 + 3]; }
        run += -0.0625f * __builtin_amdgcn_logf(1.f + ex2(-z * LOG2E));
        c2[tt] = run;
      }
      tot[stg * 48 + sd] = run;
    } else {
#pragma unroll
      for (int tt = 0; tt < 8; ++tt) c2[tt] = 0.f;
    }
    __syncthreads();
    if (tid < 192) {
      const float t0 = tot[sd], t1 = tot[48 + sd], t2 = tot[96 + sd], t3 = tot[144 + sd];
      const float pre = (stg > 0 ? t0 : 0.f) + (stg > 1 ? t1 : 0.f) + (stg > 2 ? t2 : 0.f);
      const float blast = (t0 + t1) + (t2 + t3);
      if (stg == 0) ebl[sd] = ex2(blast);
#pragma unroll
      for (int tt = 0; tt < 8; ++tt) {
        const int t = stg * 8 + tt; const float b2 = pre + c2[tt];
        const float q = bf2f(rq[tt]) * qsc, k = bf2f(rk[tt]);
        const u16 qb = f2bf(q * ex2(b2));
        Qb[t * 56 + sd] = qb; QbP[t * 56 + perm16(sd)] = qb;
        Kb[t * 56 + sd] = f2bf(k * ex2(-b2));
        KlT[sd * 40 + perm16(t)] = f2bf(k * ex2(blast - b2));
      }
    }
    __syncthreads();
    {
      const size_t rn = row00 + (ch + 1 < SEQ / 32 ? ch + 1 : ch) * 32;
      GL_LOAD(rn)
    }
    __builtin_amdgcn_sched_barrier(0);
    if (w < 3) {
      f32x16 AT;
#pragma unroll
      for (int i = 0; i < 16; ++i) AT[i] = 0.f;
#pragma unroll
      for (int s3 = 0; s3 < 3; ++s3) AT = MFMA32(ld8(Kb + l32 * 56 + s3 * 16 + hh * 8), ld8(Qb + l32 * 56 + s3 * 16 + hh * 8), AT);
#pragma unroll
      for (int i = 0; i < 16; ++i) AT[i] = (crow(i, hh) <= l32) ? AT[i] : 0.f;
      const bf16x8 pA0 = pack8(AT[0], AT[1], AT[2], AT[3], AT[4], AT[5], AT[6], AT[7]);
      const bf16x8 pA1 = pack8(AT[8], AT[9], AT[10], AT[11], AT[12], AT[13], AT[14], AT[15]);
      const bf16x8 vf0 = ld8(Vt + (32 * w + l32) * 40 + hh * 8), vf1 = ld8(Vt + (32 * w + l32) * 40 + 16 + hh * 8);
      f32x16 OT;
#pragma unroll
      for (int i = 0; i < 16; ++i) OT[i] = 0.f;
      OT = MFMA32(vf0, pA0, OT);
      OT = MFMA32(vf1, pA1, OT);
      const bf16x8 sa0 = pack8(S0[0], S0[1], S0[2], S0[3], S0[4], S0[5], S0[6], S0[7]);
      const bf16x8 sa1 = pack8(S0[8], S0[9], S0[10], S0[11], S0[12], S0[13], S0[14], S0[15]);
      const bf16x8 sa2 = pack8(S1[0], S1[1], S1[2], S1[3], S1[4], S1[5], S1[6], S1[7]);
      OT = MFMA32(sa0, ld8(QbP + l32 * 56 + hh * 8), OT);
      OT = MFMA32(sa1, ld8(QbP + l32 * 56 + 16 + hh * 8), OT);
      OT = MFMA32(sa2, ld8(QbP + l32 * 56 + 32 + hh * 8), OT);
      float* od = go + (rowb + l32) * 384 + h * 96 + 32 * w + 4 * hh;
#pragma unroll
      for (int g = 0; g < 4; ++g) *(float4*)(od + 8 * g) = make_float4(OT[4 * g], OT[4 * g + 1], OT[4 * g + 2], OT[4 * g + 3]);
#pragma unroll
      for (int i = 0; i < 16; ++i) { S0[i] *= ebl[crow(i, hh)]; S1[i] *= ebl[32 + crow(i, hh)]; }
      S0 = MFMA32(ld8(KlT + l32 * 40 + hh * 8), vf0, S0);
      S0 = MFMA32(ld8(KlT + l32 * 40 + 16 + hh * 8), vf1, S0);
      S1 = MFMA32(ld8(KlT + (32 + l32) * 40 + hh * 8), vf0, S1);
      S1 = MFMA32(ld8(KlT + (32 + l32) * 40 + 16 + hh * 8), vf1, S1);
    }
    __syncthreads();
  }
#undef GL_LOAD
}

DI void xattn_block(const Params& p, int L, int b, int h, int qb64, char* smem) {
  const int tid = ltid(), lane = tid & 63, w = tid >> 6, l32 = lane & 31, hh = lane >> 5;
  char* wsl_ = lws(p);
  const int qt2 = w >> 1, dvh = w & 1;
  char* u = wsl_ + OFF_UNION;
  const u16* Qg = (const u16*)(u + U_QXA) + (size_t)(b * SEQ + qb64 * 64) * 1024 + h * 256;
  const u16* Kg = (const u16*)(wsl_ + OFF_KXA) + (size_t)L * 2048 * 1024 + (size_t)(b * 256) * 1024 + h * 256;
  const u16* Vg = (const u16*)(wsl_ + OFF_VXAT) + (size_t)L * 2048 * 1024 + (size_t)(b * 1024 + h * 256) * 256;
  u16* Qs = (u16*)smem; u16* Ks = Qs + 64 * 264; u16* Vs = Ks + 32 * 264;
  {
    u32x4 t8[8];
#pragma unroll
    for (int i = 0; i < 8; ++i) { const int c = tid + 256 * i; t8[i] = *(const u32x4*)(Qg + (size_t)(c >> 5) * 1024 + (c & 31) * 8); }
#pragma unroll
    for (int i = 0; i < 8; ++i) { const int c = tid + 256 * i; *(u32x4*)(Qs + (c >> 5) * 264 + (c & 31) * 8) = t8[i]; }
  }
  u32x4 rk[4], rk2[4], rv[4];
#pragma unroll
  for (int i = 0; i < 4; ++i) {
    const int c = tid + 256 * i;
    rk[i] = *(const u32x4*)(Kg + (size_t)(c >> 5) * 1024 + (c & 31) * 8);
    rv[i] = *(const u32x4*)(Vg + (size_t)(c >> 2) * 256 + (c & 3) * 8);
    rk2[i] = *(const u32x4*)(Kg + (size_t)(32 + (c >> 5)) * 1024 + (c & 31) * 8);
  }
  f32x16 O[4];
#pragma unroll
  for (int a = 0; a < 4; ++a)
#pragma unroll
    for (int i = 0; i < 16; ++i) O[a][i] = 0.f;
  float mrun = -1e30f, lrun = 0.f;
  const float sc = 0.0625f * LOG2E;
#pragma unroll 1
  for (int kt = 0; kt < 8; ++kt) {
#pragma unroll
    for (int i = 0; i < 4; ++i) {
      const int c = tid + 256 * i;
      *(u32x4*)(Ks + (c >> 5) * 264 + (c & 31) * 8) = rk[i];
      vperm_store(Vs + (c >> 2) * 40, c & 3, rv[i]);
    }
    __syncthreads();
    {
      const int k1 = (kt < 7 ? kt + 1 : 7) * 32, k2 = (kt < 6 ? kt + 2 : 7) * 32;
#pragma unroll
      for (int i = 0; i < 4; ++i) {
        const int c = tid + 256 * i;
        rk[i] = rk2[i];
        rk2[i] = *(const u32x4*)(Kg + (size_t)(k2 + (c >> 5)) * 1024 + (c & 31) * 8);
        rv[i] = *(const u32x4*)(Vg + (size_t)(c >> 2) * 256 + k1 + (c & 3) * 8);
      }
    }
    __builtin_amdgcn_sched_barrier(0);
    f32x16 S;
#pragma unroll
    for (int i = 0; i < 16; ++i) S[i] = 0.f;
#pragma unroll
    for (int s = 0; s < 16; ++s) S = MFMA32(ld8(Ks + l32 * 264 + s * 16 + hh * 8), ld8(Qs + (qt2 * 32 + l32) * 264 + s * 16 + hh * 8), S);
    float corr; bf16x8 pf0, pf1;
    softmax_tile(S, sc, mrun, lrun, corr, pf0, pf1);
#pragma unroll
    for (int mt = 0; mt < 4; ++mt) {
#pragma unroll
      for (int i = 0; i < 16; ++i) O[mt][i] *= corr;
      O[mt] = MFMA32(ld8(Vs + (dvh * 128 + mt * 32 + l32) * 40 + hh * 8), pf0, O[mt]);
      O[mt] = MFMA32(ld8(Vs + (dvh * 128 + mt * 32 + l32) * 40 + 16 + hh * 8), pf1, O[mt]);
    }
    __syncthreads();
  }
  const float lt = lrun + __shfl_xor(lrun, 32);
  const float inv = 1.f / lt;
  u16* od = (u16*)(u + U_OMIX) + (size_t)(b * SEQ + qb64 * 64 + qt2 * 32 + l32) * 1024 + h * 256 + dvh * 128;
#pragma unroll
  for (int mt = 0; mt < 4; ++mt)
#pragma unroll
    for (int g = 0; g < 4; ++g) store4bf(od + mt * 32 + 8 * g + 4 * hh, O[mt][4 * g] * inv, O[mt][4 * g + 1] * inv, O[mt][4 * g + 2] * inv, O[mt][4 * g + 3] * inv);
}

DI void ln_row(float4 (&v)[4], const float4 (&gv)[4], const float4 (&bv)[4], float& mean_o, float& rstd_o) {
  float s = 0.f, q = 0.f;
#pragma unroll
  for (int j = 0; j < 4; ++j) { s += v[j].x + v[j].y + v[j].z + v[j].w; q += v[j].x * v[j].x + v[j].y * v[j].y + v[j].z * v[j].z + v[j].w * v[j].w; }
#pragma unroll
  for (int o = 32; o > 0; o >>= 1) { s += __shfl_xor(s, o); q += __shfl_xor(q, o); }
  const float mean = s * (1.f / 1024.f);
  const float var = fmaxf(q * (1.f / 1024.f) - mean * mean, 0.f);
  const float rstd = rsqrtf(var + LN_EPS);
  mean_o = mean; rstd_o = rstd;
#pragma unroll
  for (int j = 0; j < 4; ++j) {
    v[j].x = (v[j].x - mean) * rstd * gv[j].x + bv[j].x; v[j].y = (v[j].y - mean) * rstd * gv[j].y + bv[j].y;
    v[j].z = (v[j].z - mean) * rstd * gv[j].z + bv[j].z; v[j].w = (v[j].w - mean) * rstd * gv[j].w + bv[j].w;
  }
}
#define LN_LOAD_GB(g, bb) float4 gv[4], bv[4]; _Pragma("unroll") for (int j = 0; j < 4; ++j) { gv[j] = *(const float4*)((g) + j * 256 + lane * 4); bv[j] = *(const float4*)((bb) + j * 256 + lane * 4); }
#define LN_LOAD_ROW(dst, row) { _Pragma("unroll") for (int j = 0; j < 4; ++j) dst[j] = *(const float4*)(y + (size_t)(row) * 1024 + j * 256 + lane * 4); }
#define LN_STORE_ROW(v, row) { _Pragma("unroll") for (int j = 0; j < 4; ++j) { \
    u32x2 o_ = {pack2(v[j].x, v[j].y), pack2(v[j].z, v[j].w)}; *(u32x2*)(xbf + (size_t)(row) * 1024 + j * 256 + lane * 4) = o_; } \
    if (lane == 0) *(float2*)(lnstats + (size_t)(row) * 2) = make_float2(mean_, rstd_); }

DI unsigned bar_ld(unsigned* q) { return __hip_atomic_load(q, __ATOMIC_RELAXED, __HIP_MEMORY_SCOPE_AGENT); }
DI unsigned bar_add(unsigned* q, unsigned v) { return __hip_atomic_fetch_add(q, v, __ATOMIC_RELAXED, __HIP_MEMORY_SCOPE_AGENT); }
template <class P_> DI void gbar(const P_& p, unsigned round) {
  asm volatile("s_waitcnt vmcnt(0)" ::: "memory");
  __syncthreads();
  if (threadIdx.x == 0) {
    unsigned* bar = (unsigned*)(lws(p) + OFF_BAR);
    __builtin_amdgcn_fence(__ATOMIC_RELEASE, "agent");
    asm volatile("s_waitcnt vmcnt(0)" ::: "memory");
    const unsigned g = blockIdx.x & 7u, nloc = gridDim.x >> 3;
    const unsigned old = bar_add(bar + 64 * g, 1u);
    if (old + 1u == round * nloc) {
      const unsigned o2 = bar_add(bar + 64 * 8, 1u);
      if (o2 + 1u == round * 8u) {
#pragma unroll
        for (int j = 0; j < 8; ++j) bar_add(bar + 64 * (9 + j), 1u);
      }
    }
    while (bar_ld(bar + 64 * (9 + g)) < round) __builtin_amdgcn_s_sleep(1);
    __builtin_amdgcn_fence(__ATOMIC_ACQUIRE, "agent");
    asm volatile("s_waitcnt vmcnt(0)" ::: "memory");
  }
  __syncthreads();
}

DI bool st_tile(int i, int xcd, int nM, int nN, int NB, int& mt, int& nt) {
  const int T = 8 * NB; const int sl = i / T, within = i % T; const int st = sl * 8 + xcd;
  const int SM = nM >> 3; const int S = SM * (nN / NB);
  if (st >= S) return false;
  const int sm = st % SM, sn = st / SM;
  mt = sm * 8 + (within & 7); nt = sn * NB + (within >> 3);
  return true;
}

__global__ void __launch_bounds__(NTHR, 2) mega(Params p) {
  cg::grid_group grid = cg::this_grid();
  __shared__ __attribute__((aligned(16))) char smem[SMEM_BYTES];
  __shared__ int s_item;
  __shared__ int s_cnt[8];
  __shared__ int s_base[8];
  const int nblk = gridDim.x, blk = blockIdx.x;
  const int nwave = nblk * 4;

#ifdef PROBE_SYNCS
  for (int q_ = 0; q_ < PROBE_SYNCS; ++q_) grid.sync();
#endif
  for (int rep_ = 0; rep_ < REP(0); ++rep_) {
    PH_IDS
    {
      Job jb; int lt; float v[16];
      int t = blk;
      get_job(p, t < TR_TILES ? t : TR_TILES - 1, jb, lt);
      tr_load(jb, lt, v);
      while (t < TR_TILES) {
        const int t2 = t + nblk;
        Job jb2; int lt2; float v2[16];
        get_job(p, t2 < TR_TILES ? t2 : TR_TILES - 1, jb2, lt2);
        tr_load(jb2, lt2, v2);
        __builtin_amdgcn_sched_barrier(0);
        tr_store(jb, lt, v, (float*)smem);
        jb = jb2; lt = lt2;
#pragma unroll
        for (int i = 0; i < 16; ++i) v[i] = v2[i];
        t = t2;
      }
    }
    const size_t gt = (size_t)blk * NTHR + tid, gn = (size_t)nblk * NTHR;
    for (size_t i = gt; i < (size_t)MTOK * 1024 / 4; i += gn) {
      const float4 v = ((const float4*)p.x)[i]; u32x2 o = {pack2(v.x, v.y), pack2(v.z, v.w)}; ((u32x2*)xbf)[i] = o;
    }
    u16* membf = (u16*)(ws + OFF_MEMBF);
    for (size_t i = gt; i < (size_t)2048 * 1024 / 4; i += gn) {
      const float4 v = ((const float4*)p.mem)[i]; u32x2 o = {pack2(v.x, v.y), pack2(v.z, v.w)}; ((u32x2*)membf)[i] = o;
    }
    float* rope = (float*)(ws + OFF_ROPE);
    for (size_t i = gt; i < (size_t)MTOK * 12; i += gn) {
      const int tok = (int)(i / 12), f = (int)(i % 12);
      const float ps = (float)p.pos[tok];
      const float ang = ps * (f < 4 ? p.invfA[f] : p.invfB[f - 4]);
      float c, s; sincos_acc(ang, c, s);
      if (f < 4) { rope[tok * 24 + f] = c; rope[tok * 24 + 4 + f] = s; }
      else { rope[tok * 24 + 8 + (f - 4)] = c; rope[tok * 24 + 16 + (f - 4)] = s; }
    }
    if (blk == 0 && tid < 64) ctr[tid] = 0;
    if (blk == 0) { unsigned* bw = (unsigned*)(ws + OFF_BAR); for (int i = tid; i < 2048; i += NTHR) bw[i] = 0u; }
    if (rep_ + 1 < REP(0)) grid.sync();
  }
  grid.sync();
  unsigned bar_round = 0;
#ifdef PROBE_GBAR
  for (int q_ = 0; q_ < PROBE_GBAR; ++q_) gbar(p, ++bar_round);
#endif

  for (int L = 0; L < 2; ++L) {
    for (int rep_ = 0; rep_ < REP(1); ++rep_) {
      PH_IDS
      const int nin = 128 * 25; const int ntot = nin + (L == 0 ? 512 : 0);
      EpiIn ein{u, (const float*)(ws + OFF_ROPE), (float*)(ws + OFF_RC)};
      (void)nin; (void)ntot;
      const int xcd = blk & 7, jb = blk >> 3, nb8 = nblk >> 3;
      for (int i = jb; ; i += nb8) {
        int mt, nt;
        if (i < 400) {
          if (!st_tile(i, xcd, 128, 25, 5, mt, nt)) break;
          gemm_tile(RowPlain{xbf, 1024}, (const u16*)(ws + OFF_WT_IN) + (size_t)L * INP * 1024, 1024, 1024, mt * 128, nt * 128, (u16*)smem, ein);
        } else {
          if (L != 0 || i >= 432) break;
          const int l2 = (i - 400) >> 4;
          if (!st_tile((i - 400) & 15, xcd, 16, 8, 1, mt, nt)) break;
          EpiKV ekv{(u16*)(ws + OFF_KXA) + (size_t)l2 * 2048 * 1024, (u16*)(ws + OFF_VXAT) + (size_t)l2 * 2048 * 1024};
          gemm_tile256(RowPlain{(const u16*)(ws + OFF_MEMBF), 1024}, (const u16*)(ws + OFF_WT_KV) + (size_t)l2 * 2048 * 1024, 1024, 1024, mt * 128, nt * 256, (u16*)smem, ekv);
        }
      }
      if (rep_ + 1 < REP(1)) gbar(p, ++bar_round);
    }
    gbar(p, ++bar_round);
    for (int rep_ = 0; rep_ < REP(2); ++rep_) {
      PH_IDS
      float lam;
      {
        float a1 = 0.f, a2 = 0.f;
        for (int i = 0; i < 32; ++i) { a1 += p.lam_q1[L * 32 + i] * p.lam_k1[L * 32 + i]; a2 += p.lam_q2[L * 32 + i] * p.lam_k2[L * 32 + i]; }
        lam = expf(a1) - expf(a2) + p.lam_init[L];
      }
      const int total = 32 + 512 + 2304;
      while (true) {
        if (tid == 0) s_item = atomicAdd(&ctr[L + 2 * rep_], 1);
        __syncthreads();
        const int item = s_item;
        __syncthreads();
        if (item >= total) break;
#ifdef PROBE_SUB
        if (rep_ == 1) { const int kind = item < 32 ? 1 : (item < 544 ? 2 : 3); if (kind != PROBE_SUB) continue; }
#endif
        if (item < 32) {
          __builtin_amdgcn_s_setprio(3);
          gla_mfma_item(p, L, item >> 2, item & 3, smem);
          __builtin_amdgcn_s_setprio(0);
        } else if (item < 544) {
          const int a = item - 32; const int qblk = 15 - (a >> 5), bh = a & 31;
          mixA_block(p, L, bh >> 2, bh & 3, qblk, lam, p.lam_init[L], smem);
        } else {
          const int bi = item - 544; const int g = bi / 768, rem = bi % 768; const int bh = rem >> 4, sb = rem & 15;
          mixB_block(p, bh / 6, bh % 6, g, sb, smem);
        }
      }
      if (rep_ + 1 < REP(2)) gbar(p, ++bar_round);
    }
    gbar(p, ++bar_round);
    for (int rep_ = 0; rep_ < REP(3); ++rep_) {
      PH_IDS
      const float* lse = (const float*)(ws + OFF_LSE);
      const u16* pbo = (const u16*)(u + U_PBO); const float* go = (const float*)(u + U_GLAO); const u16* hc = (const u16*)(u + U_HC);
      u16* om = (u16*)(u + U_OMIX);
      const float* gg = p.gla_g + L * 96;
      for (int tok0 = gwave; tok0 < MTOK; tok0 += nwave) {
        int tok = tok0; asm volatile("" : "+v"(tok));
#pragma unroll
        for (int hd = 0; hd < 6; ++hd) {
          const float l0 = lse[(size_t)tok * 8 + hd], l1 = lse[(size_t)MTOK * 8 + (size_t)tok * 8 + hd], l2 = lse[(size_t)2 * MTOK * 8 + (size_t)tok * 8 + hd];
          const float mx = fmaxf(l0, fmaxf(l1, l2));
          const float w0 = __expf(l0 - mx), w1 = __expf(l1 - mx), w2 = __expf(l2 - mx);
          const float inv = 1.f / (w0 + w1 + w2);
          const size_t o = (size_t)tok * 384 + hd * 64 + lane;
          const float v = (w0 * bf2f(pbo[o]) + w1 * bf2f(pbo[(size_t)MTOK * 384 + o]) + w2 * bf2f(pbo[(size_t)2 * MTOK * 384 + o])) * inv;
          om[(size_t)tok * 1024 + 256 + hd * 64 + lane] = f2bf(v);
        }
#pragma unroll
        for (int hd = 0; hd < 4; ++hd) {
          const float o0 = go[(size_t)tok * 384 + hd * 96 + lane];
          const float o1 = lane < 32 ? go[(size_t)tok * 384 + hd * 96 + 64 + lane] : 0.f;
          const float ssq = wave_sum(o0 * o0 + o1 * o1);
          const float rs = rsqrtf(ssq * (1.f / 96.f) + LN_EPS);
          const float g0 = bf2f(hc[(size_t)tok * 1152 + 768 + hd * 96 + lane]);
          om[(size_t)tok * 1024 + 640 + hd * 96 + lane] = f2bf(o0 * rs * gg[lane] * (g0 / (1.f + __expf(-g0))));
          if (lane < 32) {
            const float g1 = bf2f(hc[(size_t)tok * 1152 + 768 + hd * 96 + 64 + lane]);
            om[(size_t)tok * 1024 + 640 + hd * 96 + 64 + lane] = f2bf(o1 * rs * gg[64 + lane] * (g1 / (1.f + __expf(-g1))));
          }
        }
      }
      if (rep_ + 1 < REP(3)) gbar(p, ++bar_round);
    }
    gbar(p, ++bar_round);
    for (int rep_ = 0; rep_ < REP(4); ++rep_) {
      PH_IDS
      EpiResidT er{L == 0 ? p.x : (const float*)y, lnstats, p.ln_ffn_g, p.ln_ffn_b, y, L};
      for (int i = blk >> 3; ; i += nblk >> 3) {
        int mt, nt; if (!st_tile(i, blk & 7, 128, 8, 8, mt, nt)) break;
        gemm_tile_sw(RowPlain{(const u16*)(u + U_OMIX), 1024}, (const u16*)(ws + OFF_WT_OUT) + (size_t)L * 1024 * 1024, 1024, 1024, mt * 128, nt * 128, (u16*)smem, er);
      }
      if (rep_ + 1 < REP(4)) gbar(p, ++bar_round);
    }
    gbar(p, ++bar_round);
    for (int rep_ = 0; rep_ < REP(5); ++rep_) {
      PH_IDS
      const float* g = p.ln_mix_g + L * 1024; const float* bb = p.ln_mix_b + L * 1024;
      LN_LOAD_GB(g, bb)
      float4 v[4], nx[4];
      int row = gwave;
      LN_LOAD_ROW(v, (row < MTOK ? row : MTOK - 1))
      while (row < MTOK) {
        const int r2 = row + nwave;
        LN_LOAD_ROW(nx, (r2 < MTOK ? r2 : MTOK - 1))
        __builtin_amdgcn_sched_barrier(0);
        float mean_, rstd_; ln_row(v, gv, bv, mean_, rstd_);
        LN_STORE_ROW(v, row)
#pragma unroll
        for (int j = 0; j < 4; ++j) v[j] = nx[j];
        row = r2;
      }
      if (rep_ + 1 < REP(5)) gbar(p, ++bar_round);
    }
    gbar(p, ++bar_round);
    for (int rep_ = 0; rep_ < REP(6); ++rep_) {
      PH_IDS
      EpiBfT eq{(u16*)(u + U_QXA), 1024};
      for (int i = blk >> 3; ; i += nblk >> 3) {
        int mt, nt; if (!st_tile(i, blk & 7, 128, 8, 8, mt, nt)) break;
        gemm_tile_sw(RowPlain{xbf, 1024}, (const u16*)(ws + OFF_WT_Q) + (size_t)L * 1024 * 1024, 1024, 1024, mt * 128, nt * 128, (u16*)smem, eq);
      }
      if (rep_ + 1 < REP(6)) gbar(p, ++bar_round);
    }
    gbar(p, ++bar_round);
    for (int rep_ = 0; rep_ < REP(7); ++rep_) {
      PH_IDS
      for (int it = blockIdx.x; it < 1024; it += nblk) {
        const int qb = it & 31, bh = it >> 5;
        xattn_block(p, L, bh >> 2, bh & 3, qb, smem);
      }
      if (rep_ + 1 < REP(7)) gbar(p, ++bar_round);
    }
    gbar(p, ++bar_round);
    for (int rep_ = 0; rep_ < REP(8); ++rep_) {
      PH_IDS
      EpiResidT er{y, lnstats, p.ln_mix_g + L * 1024, p.ln_mix_b + L * 1024, y, 1};
      for (int i = blk >> 3; ; i += nblk >> 3) {
        int mt, nt; if (!st_tile(i, blk & 7, 128, 8, 8, mt, nt)) break;
        gemm_tile_sw(RowPlain{(const u16*)(u + U_OMIX), 1024}, (const u16*)(ws + OFF_WT_O) + (size_t)L * 1024 * 1024, 1024, 1024, mt * 128, nt * 128, (u16*)smem, er);
      }
      if (rep_ + 1 < REP(8)) gbar(p, ++bar_round);
    }
    gbar(p, ++bar_round);
    for (int rep_ = 0; rep_ < REP(9); ++rep_) {
      PH_IDS
      const float* g = p.ln_xa_g + L * 1024; const float* bb = p.ln_xa_b + L * 1024;
      const int rpb = (MTOK + nblk - 1) / nblk;
      const int r0 = blk * rpb, r1 = (r0 + rpb < MTOK) ? r0 + rpb : MTOK;
      float* rt = (float*)smem;
      int* ent = (int*)(smem + 32768);
      if (L == 1) {
        for (int i = tid; i < 8192; i += NTHR) { const int e = i & 7, c = i >> 3; rt[e * 1024 + c] = p.moe_router[i]; }
        if (tid < 8) s_cnt[tid] = 0;
        __syncthreads();
      }
      LN_LOAD_GB(g, bb)
      float4 v[4], nx[4];
      int row = r0 + w;
      LN_LOAD_ROW(v, (row < MTOK ? row : MTOK - 1))
      for (; row < r1; row += 4) {
        LN_LOAD_ROW(nx, (row + 4 < MTOK ? row + 4 : MTOK - 1))
        __builtin_amdgcn_sched_barrier(0);
        float mean_, rstd_; ln_row(v, gv, bv, mean_, rstd_);
        LN_STORE_ROW(v, row)
        if (L == 1) {
          float lg[8];
#pragma unroll
          for (int e = 0; e < 8; ++e) {
            float a = 0.f;
#pragma unroll
            for (int j = 0; j < 4; ++j) { const float4 rv = *(const float4*)(rt + e * 1024 + j * 256 + lane * 4); a += v[j].x * rv.x + v[j].y * rv.y + v[j].z * rv.z + v[j].w * rv.w; }
            lg[e] = wave_sum(a);
          }
          if (lane == 0) {
            int e1 = 0; float v1 = lg[0];
#pragma unroll
            for (int e = 1; e < 8; ++e) if (lg[e] > v1) { v1 = lg[e]; e1 = e; }
            int e2 = -1; float v2 = -3.0e38f;
#pragma unroll
            for (int e = 0; e < 8; ++e) if (e != e1 && lg[e] > v2) { v2 = lg[e]; e2 = e; }
            const float ee = expf(v2 - v1); const float w1 = 1.f / (1.f + ee), w2 = ee / (1.f + ee);
            const int li = (row - r0) * 2;
            const int s1 = atomicAdd(&s_cnt[e1], 1); const int s2 = atomicAdd(&s_cnt[e2], 1);
            ent[li * 4 + 0] = row * 2; ent[li * 4 + 1] = e1; ent[li * 4 + 2] = s1; ent[li * 4 + 3] = __float_as_int(w1);
            ent[li * 4 + 4] = row * 2 + 1; ent[li * 4 + 5] = e2; ent[li * 4 + 6] = s2; ent[li * 4 + 7] = __float_as_int(w2);
          }
        }
#pragma unroll
        for (int j = 0; j < 4; ++j) v[j] = nx[j];
      }
      if (L == 1) {
        __syncthreads();
        if (tid < 8) s_base[tid] = atomicAdd(&ctr[8 + tid], s_cnt[tid]);
        __syncthreads();
        int* list = (int*)(ws + OFF_LIST); float* gl = (float*)(ws + OFF_GLIST);
        const int ne = (r1 - r0) * 2;
        for (int i = tid; i < ne; i += NTHR) {
          const int e = ent[i * 4 + 1]; const int pos = s_base[e] + ent[i * 4 + 2];
          list[e * MTOK + pos] = ent[i * 4 + 0]; gl[e * MTOK + pos] = __int_as_float(ent[i * 4 + 3]);
        }
        __syncthreads();
      }
      if (rep_ + 1 < REP(9)) gbar(p, ++bar_round);
    }
    gbar(p, ++bar_round);
    if (L == 0) {
      for (int rep_ = 0; rep_ < REP(10); ++rep_) {
        PH_IDS
        EpiSwiglu es{(u16*)u, FD, 0};
        for (int i = blk >> 3; ; i += nblk >> 3) {
          int mt, nt; if (!st_tile(i, blk & 7, 128, 22, 2, mt, nt)) break;
          gemm_tile256(RowPlain{xbf, 1024}, (const u16*)(ws + OFF_WT_F13), 1024, 1024, mt * 128, nt * 256, (u16*)smem, es);
        }
        if (rep_ + 1 < REP(10)) gbar(p, ++bar_round);
      }
      gbar(p, ++bar_round);
      for (int rep_ = 0; rep_ < REP(11); ++rep_) {
        PH_IDS
        EpiResidT er{y, lnstats, p.ln_xa_g, p.ln_xa_b, y, 1};
        for (int i = blk >> 3; ; i += nblk >> 3) {
          int mt, nt; if (!st_tile(i, blk & 7, 128, 8, 8, mt, nt)) break;
          gemm_tile_sw(RowPlain{(const u16*)u, FD}, (const u16*)(ws + OFF_WT_F2), FD, FD, mt * 128, nt * 128, (u16*)smem, er);
        }
        if (rep_ + 1 < REP(11)) gbar(p, ++bar_round);
      }
      gbar(p, ++bar_round);
      for (int rep_ = 0; rep_ < REP(12); ++rep_) {
        PH_IDS
        const float* g = p.ln_ffn_g; const float* bb = p.ln_ffn_b;
        LN_LOAD_GB(g, bb)
        float4 v[4], nx[4];
        int row = gwave;
        LN_LOAD_ROW(v, (row < MTOK ? row : MTOK - 1))
        while (row < MTOK) {
          const int r2 = row + nwave;
          LN_LOAD_ROW(nx, (r2 < MTOK ? r2 : MTOK - 1))
        __builtin_amdgcn_sched_barrier(0);
          float mean_, rstd_; ln_row(v, gv, bv, mean_, rstd_);
          LN_STORE_ROW(v, row)
#pragma unroll
          for (int j = 0; j < 4; ++j) v[j] = nx[j];
          row = r2;
        }
        if (rep_ + 1 < REP(12)) gbar(p, ++bar_round);
      }
      gbar(p, ++bar_round);
    } else {
      char* ws0 = lws(p); const int* ctr0 = (const int*)(ws0 + OFF_CTR);
      int cnt[8], mts[8], offp[8]; int tot_mt = 0;
#pragma unroll
      for (int e = 0; e < 8; ++e) { cnt[e] = ctr0[8 + e]; mts[e] = (cnt[e] + 127) >> 7; offp[e] = tot_mt * 128; tot_mt += mts[e]; }
      for (int rep_ = 0; rep_ < REP(13); ++rep_) {
        PH_IDS
        const int* list = (const int*)(ws + OFF_LIST); const float* gl = (const float*)(ws + OFF_GLIST); (void)gl;
        const int e = blk & 7;
        int ce = 0, me = 0, oe = 0;
#pragma unroll
        for (int q = 0; q < 8; ++q) if (e == q) { ce = cnt[q]; me = mts[q]; oe = offp[q]; }
        const int SMe = (me + 7) >> 3;
        EpiSwiglu es{(u16*)u, FM, oe};
        if (me > 0) for (int i = blk >> 3; ; i += nblk >> 3) {
          const int sl = i >> 5, within = i & 31; const int sm = sl % SMe, sn = sl / SMe;
          if (sn >= 7) break;
          const int mt = sm * 8 + (within & 7), nt = sn * 4 + (within >> 3);
          if (mt >= me) continue;
          gemm_tile256(RowGather{xbf, list + (size_t)e * MTOK, ce}, (const u16*)(ws + OFF_WT_M13) + (size_t)e * 2 * FM * 1024, 1024, 1024, mt * 128, nt * 256, (u16*)smem, es);
        }
        if (rep_ + 1 < REP(13)) gbar(p, ++bar_round);
      }
      gbar(p, ++bar_round);
      for (int rep_ = 0; rep_ < REP(14); ++rep_) {
        PH_IDS
        const int* list = (const int*)(ws + OFF_LIST); const float* gl = (const float*)(ws + OFF_GLIST); (void)gl;
        const int e = blk & 7;
        int ce = 0, me = 0, oe = 0;
#pragma unroll
        for (int q = 0; q < 8; ++q) if (e == q) { ce = cnt[q]; me = mts[q]; oe = offp[q]; }
        EpiMoe2T em{(u16*)(ws + OFF_MOEOUT), list + (size_t)e * MTOK, gl + (size_t)e * MTOK, ce};
        for (int i = blk >> 3; i < ((me + 7) >> 3) * 64; i += nblk >> 3) {
          const int sl = i >> 6, within = i & 63;
          const int mt = sl * 8 + (within & 7), nt = within >> 3;
          if (mt >= me) continue;
          gemm_tile_sw(RowPlain{(const u16*)u + (size_t)oe * FM, FM}, (const u16*)(ws + OFF_WT_M2) + (size_t)e * 1024 * FM, FM, FM, mt * 128, nt * 128, (u16*)smem, em);
        }
        if (rep_ + 1 < REP(14)) gbar(p, ++bar_round);
      }
      gbar(p, ++bar_round);
      for (int rep_ = 0; rep_ < REP(15); ++rep_) {
        PH_IDS
        const float* g = p.ln_ffn_g + 1024; const float* bb = p.ln_ffn_b + 1024;
        const u16* mo = (const u16*)(ws + OFF_MOEOUT);
        LN_LOAD_GB(g, bb)
        float4 xv[4], nxv[4]; u32x2 ma[4], mc[4], nma[4], nmc[4];
#define FIN_LOAD(XV, MA, MC, row) { _Pragma("unroll") for (int j = 0; j < 4; ++j) { XV[j] = *(const float4*)(y + (size_t)(row) * 1024 + j * 256 + lane * 4); \
          MA[j] = *(const u32x2*)(mo + (size_t)(2 * (row)) * 1024 + j * 256 + lane * 4); MC[j] = *(const u32x2*)(mo + (size_t)(2 * (row) + 1) * 1024 + j * 256 + lane * 4); } }
        int row = gwave;
        FIN_LOAD(xv, ma, mc, (row < MTOK ? row : MTOK - 1))
        while (row < MTOK) {
          const int r2 = row + nwave;
          FIN_LOAD(nxv, nma, nmc, (r2 < MTOK ? r2 : MTOK - 1))
          __builtin_amdgcn_sched_barrier(0);
          float4 v[4];
          const float2 st_ = *(const float2*)(lnstats + (size_t)row * 2);
#pragma unroll
          for (int j = 0; j < 4; ++j) {
            const u32x2 a = ma[j], c = mc[j];
            const float4 gx = *(const float4*)(p.ln_xa_g + 1024 + j * 256 + lane * 4), bx = *(const float4*)(p.ln_xa_b + 1024 + j * 256 + lane * 4);
            const float x0 = (xv[j].x - st_.x) * st_.y * gx.x + bx.x, x1 = (xv[j].y - st_.x) * st_.y * gx.y + bx.y;
            const float x2 = (xv[j].z - st_.x) * st_.y * gx.z + bx.z, x3 = (xv[j].w - st_.x) * st_.y * gx.w + bx.w;
            v[j].x = ALPHA * x0 + (__uint_as_float(a[0] << 16) + __uint_as_float(c[0] << 16));
            v[j].y = ALPHA * x1 + (__uint_as_float(a[0] & 0xffff0000u) + __uint_as_float(c[0] & 0xffff0000u));
            v[j].z = ALPHA * x2 + (__uint_as_float(a[1] << 16) + __uint_as_float(c[1] << 16));
            v[j].w = ALPHA * x3 + (__uint_as_float(a[1] & 0xffff0000u) + __uint_as_float(c[1] & 0xffff0000u));
          }
          float mean_, rstd_; ln_row(v, gv, bv, mean_, rstd_);
#pragma unroll
          for (int j = 0; j < 4; ++j) *(float4*)(p.out + (size_t)row * 1024 + j * 256 + lane * 4) = v[j];
#pragma unroll
          for (int j = 0; j < 4; ++j) { xv[j] = nxv[j]; ma[j] = nma[j]; mc[j] = nmc[j]; }
          row = r2;
        }
#undef FIN_LOAD
        if (rep_ + 1 < REP(15)) gbar(p, ++bar_round);
      }
    }
  }
}

extern "C" void kernel_launch(void* const* d_in, const int* in_sizes, int n_in, void* d_out, int out_size, void* d_ws, size_t ws_size, hipStream_t stream) {
  static int grid_blocks = 0;
  if (!grid_blocks) {
    int dev = 0, cus = 0, per_cu = 0;
    hipGetDevice(&dev);
    hipDeviceGetAttribute(&cus, hipDeviceAttributeMultiprocessorCount, dev);
    hipOccupancyMaxActiveBlocksPerMultiprocessor(&per_cu, mega, NTHR, 0);
    if (per_cu > 2) per_cu = 2;
    if (per_cu < 1) per_cu = 1;
    grid_blocks = cus * per_cu;
  }
  if (ws_size < WS_NEED) { fprintf(stderr, "workspace too small: %zu < %zu\n", ws_size, (size_t)WS_NEED); return; }
  Params p;
  memset(&p, 0, sizeof(p));
  p.x = (const float*)d_in[0]; p.mem = (const float*)d_in[1]; p.pos = (const int*)d_in[2];
  p.w_in = (const float*)d_in[3]; p.lam_q1 = (const float*)d_in[4]; p.lam_k1 = (const float*)d_in[5]; p.lam_q2 = (const float*)d_in[6]; p.lam_k2 = (const float*)d_in[7];
  p.diff_g = (const float*)d_in[8]; p.gla_wa2 = (const float*)d_in[9]; p.gla_ba = (const float*)d_in[10]; p.gla_g = (const float*)d_in[11];
  p.w_out = (const float*)d_in[12]; p.ln_mix_g = (const float*)d_in[13]; p.ln_mix_b = (const float*)d_in[14];
  p.xa_wq = (const float*)d_in[15]; p.xa_wkv = (const float*)d_in[16]; p.xa_wo = (const float*)d_in[17]; p.ln_xa_g = (const float*)d_in[18]; p.ln_xa_b = (const float*)d_in[19];
  p.ffd_w13 = (const float*)d_in[20]; p.ffd_w2 = (const float*)d_in[21]; p.moe_router = (const float*)d_in[22]; p.moe_w13 = (const float*)d_in[23]; p.moe_w2 = (const float*)d_in[24];
  p.ln_ffn_g = (const float*)d_in[25]; p.ln_ffn_b = (const float*)d_in[26];
  p.out = (float*)d_out; p.ws = (char*)d_ws;
  for (int i = 0; i < 4; ++i) p.invfA[i] = (float)pow(500000.0, -(double)(2 * i) / 8.0);
  for (int i = 0; i < 8; ++i) p.invfB[i] = (float)pow(500000.0, -(double)(2 * i) / 16.0);
  for (int l = 0; l < 2; ++l) p.lam_init[l] = (float)(0.8 - 0.6 * exp(-0.3 * l));
  void* args[] = {&p};
  hipError_t e = hipLaunchCooperativeKernel((void*)mega, dim3(grid_blocks), dim3(NTHR), args, 0, stream);
  if (e != hipSuccess) fprintf(stderr, "cooperative launch failed: %s (grid %d)\n", hipGetErrorString(e), grid_blocks);
}
```

```cpp
#include <hip/hip_runtime.h>
#include <hip/hip_cooperative_groups.h>
#include <cstdio>
#include <cmath>
#include <cstring>
namespace cg = cooperative_groups;

#define DI __device__ __forceinline__
typedef unsigned short u16;
typedef __attribute__((ext_vector_type(8))) short bf16x8;
typedef __attribute__((ext_vector_type(4))) short s16x4;
typedef __attribute__((ext_vector_type(16))) float f32x16;
typedef __attribute__((ext_vector_type(2))) float f32x2;
typedef __attribute__((ext_vector_type(2))) __bf16 bf16x2_t;
typedef __attribute__((ext_vector_type(4))) unsigned u32x4;
typedef __attribute__((ext_vector_type(2))) unsigned u32x2;
#define PH_IDS const int tid = ltid(); const int lane = tid & 63, w = tid >> 6; const int gwave = blockIdx.x * 4 + w; (void)lane; (void)gwave; \
  char* ws = lws(p); char* u = ws + OFF_UNION; u16* xbf = (u16*)(ws + OFF_XBF); float* xf = (float*)(ws + OFF_XF); float* y = (float*)(ws + OFF_Y); int* ctr = (int*)(ws + OFF_CTR); float* lnstats = (float*)(ws + OFF_STATS); (void)lnstats; (void)u; (void)xbf; (void)xf; (void)y; (void)ctr;
#ifndef PROBE_PHASE
#define PROBE_PHASE -1
#endif
#define REP(k) ((PROBE_PHASE == (k)) ? 2 : 1)
#define MFMA32(a, b, c) __builtin_amdgcn_mfma_f32_32x32x16_bf16((a), (b), (c), 0, 0, 0)

constexpr int NTHR = 256;
constexpr int MTOK = 16384, SEQ = 2048, DM = 1024;
constexpr int INP = 3200;
constexpr int FD = 2816, FM = 3584;
constexpr float ALPHA = 1.41421356237309515f;
constexpr float LOG2E = 1.44269504088896341f;
constexpr float LN2 = 0.69314718055994531f;
constexpr float LN_EPS = 1e-5f;

constexpr size_t al256(size_t x) { return (x + 255) & ~(size_t)255; }
constexpr size_t OFF_WT_IN = 0;
constexpr size_t OFF_WT_OUT = OFF_WT_IN + al256((size_t)2 * INP * 1024 * 2);
constexpr size_t OFF_WT_Q = OFF_WT_OUT + al256((size_t)2 * 1024 * 1024 * 2);
constexpr size_t OFF_WT_KV = OFF_WT_Q + al256((size_t)2 * 1024 * 1024 * 2);
constexpr size_t OFF_WT_O = OFF_WT_KV + al256((size_t)2 * 2048 * 1024 * 2);
constexpr size_t OFF_WT_F13 = OFF_WT_O + al256((size_t)2 * 1024 * 1024 * 2);
constexpr size_t OFF_WT_F2 = OFF_WT_F13 + al256((size_t)2 * FD * 1024 * 2);
constexpr size_t OFF_WT_M13 = OFF_WT_F2 + al256((size_t)1024 * FD * 2);
constexpr size_t OFF_WT_M2 = OFF_WT_M13 + al256((size_t)8 * 2 * FM * 1024 * 2);
constexpr size_t OFF_XBF = OFF_WT_M2 + al256((size_t)8 * 1024 * FM * 2);
constexpr size_t OFF_XF = OFF_XBF + al256((size_t)MTOK * 1024 * 2);
constexpr size_t OFF_Y = OFF_XF + al256((size_t)MTOK * 1024 * 4);
constexpr size_t OFF_MEMBF = OFF_Y + al256((size_t)MTOK * 1024 * 4);
constexpr size_t OFF_ROPE = OFF_MEMBF + al256((size_t)2048 * 1024 * 2);
constexpr size_t OFF_KXA = OFF_ROPE + al256((size_t)MTOK * 24 * 4);
constexpr size_t OFF_VXAT = OFF_KXA + al256((size_t)2 * 2048 * 1024 * 2);
constexpr size_t OFF_RC = OFF_VXAT + al256((size_t)2 * 2048 * 1024 * 2);
constexpr size_t OFF_LSE = OFF_RC + al256((size_t)MTOK * 16 * 4);
constexpr size_t OFF_MOEOUT = OFF_LSE + al256((size_t)3 * MTOK * 8 * 4);
constexpr size_t OFF_LIST = OFF_MOEOUT + al256((size_t)2 * MTOK * 1024 * 2);
constexpr size_t OFF_GLIST = OFF_LIST + al256((size_t)8 * MTOK * 4);
constexpr size_t OFF_CTR = OFF_GLIST + al256((size_t)8 * MTOK * 4);
constexpr size_t OFF_BAR = OFF_CTR + 256;
constexpr size_t OFF_STATS = OFF_BAR + 8192;
constexpr size_t OFF_UNION = OFF_STATS + al256((size_t)MTOK * 2 * 4);
constexpr size_t U_QA = 0;
constexpr size_t U_KA = U_QA + (size_t)MTOK * 256 * 2;
constexpr size_t U_VAT = U_KA + (size_t)MTOK * 256 * 2;
constexpr size_t U_QB = U_VAT + (size_t)MTOK * 256 * 2;
constexpr size_t U_KB = U_QB + (size_t)MTOK * 384 * 2;
constexpr size_t U_VBT = U_KB + (size_t)MTOK * 384 * 2;
constexpr size_t U_HC = U_VBT + (size_t)3 * MTOK * 384 * 2;
constexpr size_t U_PBO = U_HC + (size_t)MTOK * 1152 * 2;
constexpr size_t U_GLAO = U_PBO + (size_t)3 * MTOK * 384 * 2;
constexpr size_t U_OMIX = U_GLAO + (size_t)MTOK * 384 * 4;
constexpr size_t U_QXA = U_OMIX + (size_t)MTOK * 1024 * 2;
constexpr size_t U_MIX_END = U_QXA + (size_t)MTOK * 1024 * 2;
constexpr size_t HID_ROWS_MOE = 2 * MTOK + 8 * 128;
constexpr size_t U_HID_END = HID_ROWS_MOE * FM * 2;
constexpr size_t UNION_SIZE = al256(U_MIX_END > U_HID_END ? U_MIX_END : U_HID_END);
constexpr size_t WS_NEED = OFF_UNION + UNION_SIZE;

struct Job { const float* src; u16* dst; int K, N, Npad, mode; };

struct Params {
  const float* x; const float* mem; const int* pos;
  const float *w_in, *lam_q1, *lam_k1, *lam_q2, *lam_k2, *diff_g, *gla_wa2, *gla_ba, *gla_g, *w_out, *ln_mix_g, *ln_mix_b;
  const float *xa_wq, *xa_wkv, *xa_wo, *ln_xa_g, *ln_xa_b, *ffd_w13, *ffd_w2, *moe_router, *moe_w13, *moe_w2, *ln_ffn_g, *ln_ffn_b;
  float* out; char* ws;
  float invfA[4]; float invfB[8]; float lam_init[2];
};

DI int ltid() { int t = threadIdx.x; asm volatile("" : "+v"(t)); return t; }
typedef __attribute__((address_space(1))) char gchar_t;
template <class P_> DI char* lws(const P_& p) {
  unsigned long long a_ = (unsigned long long)p.ws; unsigned lo_ = (unsigned)a_, hi_ = (unsigned)(a_ >> 32);
  asm volatile("" : "+v"(lo_), "+v"(hi_));
  lo_ = __builtin_amdgcn_readfirstlane(lo_); hi_ = __builtin_amdgcn_readfirstlane(hi_);
  gchar_t* g_ = (gchar_t*)(((unsigned long long)hi_ << 32) | lo_);
  return (char*)g_;
}
DI float bf2f(u16 v) { return __uint_as_float(((unsigned)v) << 16); }
DI unsigned pack2(float a, float b) { f32x2 v = {a, b}; return __builtin_bit_cast(unsigned, __builtin_convertvector(v, bf16x2_t)); }
DI u16 f2bf(float a) { return (u16)(pack2(a, 0.f) & 0xffffu); }
DI int crow(int i, int hh) { return (i & 3) + 8 * (i >> 2) + 4 * hh; }
DI float wave_sum(float v) { for (int o = 32; o > 0; o >>= 1) v += __shfl_xor(v, o); return v; }
DI float ex2(float x) { return __builtin_amdgcn_exp2f(x); }
DI bf16x8 pack8(float a0, float a1, float a2, float a3, float a4, float a5, float a6, float a7) {
  u32x4 u = {pack2(a0, a1), pack2(a2, a3), pack2(a4, a5), pack2(a6, a7)};
  return __builtin_bit_cast(bf16x8, u);
}
DI void store4bf(u16* dst, float a, float b, float c, float d) { u32x2 u = {pack2(a, b), pack2(c, d)}; *(u32x2*)dst = u; }
DI bf16x8 ld8(const u16* p) { return *(const bf16x8*)p; }
DI bf16x8 ld44(const u16* p) {
  s16x4 lo = *(const s16x4*)p; s16x4 hi = *(const s16x4*)(p + 8);
  return __builtin_shufflevector(lo, hi, 0, 1, 2, 3, 4, 5, 6, 7);
}
DI float row16_allsum(float v) {
  v += __int_as_float(__builtin_amdgcn_update_dpp(0, __float_as_int(v), 0x128, 0xf, 0xf, false));
  v += __int_as_float(__builtin_amdgcn_update_dpp(0, __float_as_int(v), 0x124, 0xf, 0xf, false));
  v += __int_as_float(__builtin_amdgcn_update_dpp(0, __float_as_int(v), 0x122, 0xf, 0xf, false));
  v += __int_as_float(__builtin_amdgcn_update_dpp(0, __float_as_int(v), 0x121, 0xf, 0xf, false));
  return v;
}

constexpr int BK = 64, LDP = BK + 8;
constexpr int BK2 = 32, LDP2 = BK2 + 8;
constexpr int SMEM_BYTES = 2 * 2 * 128 * LDP * 2;

struct RowPlain { const u16* base; int ld; DI unsigned off(int r) const { return (unsigned)(r * ld) * 2u; } };
struct RowGather {
  const u16* base; const int* list; int cnt;
  DI unsigned off(int r) const { int rr = r < cnt ? r : cnt - 1; return (unsigned)(list[rr] >> 1) * 2048u; }
};

template <bool SWAP, class RowA, class Epi>
DI void gemm_tile_t(const RowA& rowA, const u16* __restrict__ Bt, int ldb, int K, int m0, int n0, u16* sm, const Epi& epi) {
  const int tid = ltid(), lane = tid & 63, w = tid >> 6, wm = w >> 1, wn = w & 1;
  const int lr = tid >> 3, lc = tid & 7;
  u16* sa = sm; u16* sb = sm + 2 * 128 * LDP;
  const char* abase = (const char*)rowA.base; const char* bbase = (const char*)Bt;
  unsigned ao[4], bo[4];
#pragma unroll
  for (int i = 0; i < 4; ++i) { ao[i] = rowA.off(m0 + lr + 32 * i) + lc * 16; bo[i] = (unsigned)((n0 + lr + 32 * i) * ldb + lc * 8) * 2u; }
  f32x16 acc[2][2];
#pragma unroll
  for (int a = 0; a < 2; ++a)
#pragma unroll
    for (int b = 0; b < 2; ++b)
#pragma unroll
      for (int i = 0; i < 16; ++i) acc[a][b][i] = 0.f;
  u32x4 ra0[4], rb0[4], ra1[4], rb1[4];
  const int KT = K / BK;
#define G_LOAD(RA, RB, k0) { _Pragma("unroll") for (int i = 0; i < 4; ++i) { RA[i] = *(const u32x4*)(abase + (ao[i] + (unsigned)(k0) * 2u)); RB[i] = *(const u32x4*)(bbase + (bo[i] + (unsigned)(k0) * 2u)); } }
#define S_WRITE(RA, RB, buf) { u16* sa2 = sa + (buf) * 128 * LDP; u16* sb2 = sb + (buf) * 128 * LDP; _Pragma("unroll") for (int i = 0; i < 4; ++i) { *(u32x4*)(sa2 + (lr + 32 * i) * LDP + lc * 8) = RA[i]; *(u32x4*)(sb2 + (lr + 32 * i) * LDP + lc * 8) = RB[i]; } }
#define COMPUTE(buf) { const u16* A_ = sa + (buf) * 128 * LDP + (wm * 64 + (lane & 31)) * LDP + (lane >> 5) * 8; const u16* B_ = sb + (buf) * 128 * LDP + (wn * 64 + (lane & 31)) * LDP + (lane >> 5) * 8; \
    _Pragma("unroll") for (int s = 0; s < BK / 16; ++s) { bf16x8 a0 = ld8(A_ + s * 16), a1 = ld8(A_ + 32 * LDP + s * 16); bf16x8 b0 = ld8(B_ + s * 16), b1 = ld8(B_ + 32 * LDP + s * 16); \
      if (SWAP) { acc[0][0] = MFMA32(b0, a0, acc[0][0]); acc[0][1] = MFMA32(b0, a1, acc[0][1]); acc[1][0] = MFMA32(b1, a0, acc[1][0]); acc[1][1] = MFMA32(b1, a1, acc[1][1]); } \
      else { acc[0][0] = MFMA32(a0, b0, acc[0][0]); acc[0][1] = MFMA32(a0, b1, acc[0][1]); acc[1][0] = MFMA32(a1, b0, acc[1][0]); acc[1][1] = MFMA32(a1, b1, acc[1][1]); } } }
  G_LOAD(ra0, rb0, 0);
  S_WRITE(ra0, rb0, 0);
  if (KT > 1) G_LOAD(ra1, rb1, BK);
  __syncthreads();
  for (int kt = 0; kt < KT; kt += 2) {
    if (kt + 2 < KT) G_LOAD(ra0, rb0, (kt + 2) * BK);
    __builtin_amdgcn_sched_barrier(0);
    __builtin_amdgcn_s_setprio(1);
    COMPUTE(0);
    __builtin_amdgcn_s_setprio(0);
    if (kt + 1 < KT) S_WRITE(ra1, rb1, 1);
    __syncthreads();
    if (kt + 1 >= KT) break;
    if (kt + 3 < KT) G_LOAD(ra1, rb1, (kt + 3) * BK);
    __builtin_amdgcn_sched_barrier(0);
    __builtin_amdgcn_s_setprio(1);
    COMPUTE(1);
    __builtin_amdgcn_s_setprio(0);
    if (kt + 2 < KT) S_WRITE(ra0, rb0, 0);
    __syncthreads();
  }
#undef G_LOAD
#undef S_WRITE
#undef COMPUTE
  epi(acc, m0 + wm * 64, n0 + wn * 64, lane);
}

template <class RowA, class Epi>
DI void gemm_tile(const RowA& rowA, const u16* __restrict__ Bt, int ldb, int K, int m0, int n0, u16* sm, const Epi& epi) { gemm_tile_t<false>(rowA, Bt, ldb, K, m0, n0, sm, epi); }
template <class RowA, class Epi>
DI void gemm_tile_sw(const RowA& rowA, const u16* __restrict__ Bt, int ldb, int K, int m0, int n0, u16* sm, const Epi& epi) { gemm_tile_t<true>(rowA, Bt, ldb, K, m0, n0, sm, epi); }

template <class RowA, class Epi>
DI void gemm_tile256(const RowA& rowA, const u16* __restrict__ Bt, int ldb, int K, int m0, int n0, u16* sm, const Epi& epi) {
  const int tid = ltid(), lane = tid & 63, w = tid >> 6, wm = w >> 1, wn = w & 1;
  const int lr = tid >> 2, lc = tid & 3;
  u16* sa = sm; u16* sb = sm + 2 * 128 * LDP2;
  const char* abase = (const char*)rowA.base; const char* bbase = (const char*)Bt;
  unsigned ao[2], bo[4];
#pragma unroll
  for (int i = 0; i < 2; ++i) ao[i] = rowA.off(m0 + lr + 64 * i) + lc * 16;
#pragma unroll
  for (int i = 0; i < 4; ++i) bo[i] = (unsigned)((n0 + lr + 64 * i) * ldb + lc * 8) * 2u;
  f32x16 acc[2][4];
#pragma unroll
  for (int a = 0; a < 2; ++a)
#pragma unroll
    for (int b = 0; b < 4; ++b)
#pragma unroll
      for (int i = 0; i < 16; ++i) acc[a][b][i] = 0.f;
  u32x4 ra0[2], rb0[4], ra1[2], rb1[4];
  const int KT = K / BK2;
#define G_LOAD(RA, RB, k0) { _Pragma("unroll") for (int i = 0; i < 2; ++i) RA[i] = *(const u32x4*)(abase + (ao[i] + (unsigned)(k0) * 2u)); \
    _Pragma("unroll") for (int i = 0; i < 4; ++i) RB[i] = *(const u32x4*)(bbase + (bo[i] + (unsigned)(k0) * 2u)); }
#define S_WRITE(RA, RB, buf) { u16* sa2 = sa + (buf) * 128 * LDP2; u16* sb2 = sb + (buf) * 256 * LDP2; \
    _Pragma("unroll") for (int i = 0; i < 2; ++i) *(u32x4*)(sa2 + (lr + 64 * i) * LDP2 + lc * 8) = RA[i]; \
    _Pragma("unroll") for (int i = 0; i < 4; ++i) *(u32x4*)(sb2 + (lr + 64 * i) * LDP2 + lc * 8) = RB[i]; }
#define COMPUTE(buf) { const u16* A_ = sa + (buf) * 128 * LDP2 + (wm * 64 + (lane & 31)) * LDP2 + (lane >> 5) * 8; const u16* B_ = sb + (buf) * 256 * LDP2 + (wn * 128 + (lane & 31)) * LDP2 + (lane >> 5) * 8; \
    _Pragma("unroll") for (int s = 0; s < BK2 / 16; ++s) { bf16x8 a0 = ld8(A_ + s * 16), a1 = ld8(A_ + 32 * LDP2 + s * 16); \
      _Pragma("unroll") for (int nt = 0; nt < 4; ++nt) { bf16x8 bq = ld8(B_ + nt * 32 * LDP2 + s * 16); acc[0][nt] = MFMA32(a0, bq, acc[0][nt]); acc[1][nt] = MFMA32(a1, bq, acc[1][nt]); } } }
  G_LOAD(ra0, rb0, 0);
  S_WRITE(ra0, rb0, 0);
  if (KT > 1) G_LOAD(ra1, rb1, BK2);
  __syncthreads();
  for (int kt = 0; kt < KT; kt += 2) {
    if (kt + 2 < KT) G_LOAD(ra0, rb0, (kt + 2) * BK2);
    __builtin_amdgcn_sched_barrier(0);
    __builtin_amdgcn_s_setprio(1);
    COMPUTE(0);
    __builtin_amdgcn_s_setprio(0);
    if (kt + 1 < KT) S_WRITE(ra1, rb1, 1);
    __syncthreads();
    if (kt + 1 >= KT) break;
    if (kt + 3 < KT) G_LOAD(ra1, rb1, (kt + 3) * BK2);
    __builtin_amdgcn_sched_barrier(0);
    __builtin_amdgcn_s_setprio(1);
    COMPUTE(1);
    __builtin_amdgcn_s_setprio(0);
    if (kt + 2 < KT) S_WRITE(ra0, rb0, 0);
    __syncthreads();
  }
#undef G_LOAD
#undef S_WRITE
#undef COMPUTE
#pragma unroll
  for (int hf = 0; hf < 2; ++hf) {
    f32x16 sub[2][2];
#pragma unroll
    for (int a = 0; a < 2; ++a)
#pragma unroll
      for (int b = 0; b < 2; ++b) sub[a][b] = acc[a][2 * hf + b];
    epi(sub, m0 + wm * 64, n0 + wn * 128 + hf * 64, lane);
  }
}

struct EpiIn {
  char* u; const float* rope; float* rc;
  DI void operator()(f32x16 (&acc)[2][2], int mbase, int nbase, int lane) const {
    const int cgp = nbase >> 6, l32 = lane & 31, hh = lane >> 5;
    if (cgp < 8) {
      u16* dst = (u16*)(u + (cgp < 4 ? U_QA : U_KA)); const int c0 = (cgp & 3) * 64;
#pragma unroll
      for (int mt = 0; mt < 2; ++mt)
#pragma unroll
        for (int nt = 0; nt < 2; ++nt)
#pragma unroll
          for (int i = 0; i < 16; ++i) {
            const int row = mbase + mt * 32 + crow(i, hh);
            float v = acc[mt][nt][i]; float pv = __shfl_xor(v, 4);
            if (l32 < 8) { const int fi = l32 & 3; float c = rope[row * 24 + fi], s = rope[row * 24 + 4 + fi]; v = (l32 < 4) ? v * c - pv * s : v * c + pv * s; }
            dst[(size_t)row * 256 + c0 + nt * 32 + l32] = f2bf(v);
          }
    } else if (cgp < 12) {
      u16* dst = (u16*)(u + U_VAT); const int head = cgp - 8;
#pragma unroll
      for (int mt = 0; mt < 2; ++mt)
#pragma unroll
        for (int nt = 0; nt < 2; ++nt)
#pragma unroll
          for (int g = 0; g < 4; ++g) {
            const int row = mbase + mt * 32 + 8 * g + 4 * hh; const int b = row >> 11, t = row & 2047; const int dv = nt * 32 + l32;
            store4bf(dst + ((size_t)((b * 4 + head) * 64 + dv)) * SEQ + t, acc[mt][nt][4 * g], acc[mt][nt][4 * g + 1], acc[mt][nt][4 * g + 2], acc[mt][nt][4 * g + 3]);
          }
    } else if (cgp < 24) {
      const bool isq = cgp < 18;
      u16* dst = (u16*)(u + (isq ? U_QB : U_KB)); const int c0 = (cgp - (isq ? 12 : 18)) * 64;
#pragma unroll
      for (int mt = 0; mt < 2; ++mt)
#pragma unroll
        for (int nt = 0; nt < 2; ++nt)
#pragma unroll
          for (int i = 0; i < 16; ++i) {
            const int row = mbase + mt * 32 + crow(i, hh);
            float v = acc[mt][nt][i];
            if (nt == 0) {
              float pv = __shfl_xor(v, 8);
              if (l32 < 16) { const int fi = l32 & 7; float c = rope[row * 24 + 8 + fi], s = rope[row * 24 + 16 + fi]; v = (l32 < 8) ? v * c - pv * s : v * c + pv * s; }
            }
            dst[(size_t)row * 384 + c0 + nt * 32 + l32] = f2bf(v);
          }
    } else if (cgp < 30) {
      u16* d0 = (u16*)(u + U_VBT); u16* d1 = d0 + (size_t)MTOK * 384; u16* d2 = d1 + (size_t)MTOK * 384; const int head = cgp - 24;
#pragma unroll
      for (int mt = 0; mt < 2; ++mt)
#pragma unroll
        for (int nt = 0; nt < 2; ++nt)
#pragma unroll
          for (int g = 0; g < 4; ++g) {
            const int row = mbase + mt * 32 + 8 * g + 4 * hh; const int b = row >> 11, t = row & 2047; const int dv = nt * 32 + l32;
            const size_t rb_ = ((size_t)((b * 6 + head) * 64 + dv)) * SEQ;
            store4bf(d0 + rb_ + t, acc[mt][nt][4 * g], acc[mt][nt][4 * g + 1], acc[mt][nt][4 * g + 2], acc[mt][nt][4 * g + 3]);
#pragma unroll
            for (int j = 0; j < 4; ++j) {
              const int tt = t + j; const u16 bv = f2bf(acc[mt][nt][4 * g + j]);
              d1[rb_ + (tt & 3) * 512 + (tt >> 2)] = bv;
              d2[rb_ + (tt & 15) * 128 + (tt >> 4)] = bv;
            }
          }
    } else if (cgp < 48) {
      u16* dst = (u16*)(u + U_HC); const int c0 = (cgp - 30) * 64;
#pragma unroll
      for (int mt = 0; mt < 2; ++mt)
#pragma unroll
        for (int nt = 0; nt < 2; ++nt)
#pragma unroll
          for (int i = 0; i < 16; ++i) {
            const int row = mbase + mt * 32 + crow(i, hh);
            dst[(size_t)row * 1152 + c0 + nt * 32 + l32] = f2bf(acc[mt][nt][i]);
          }
    } else if (cgp == 48) {
      if (l32 < 16) {
#pragma unroll
        for (int mt = 0; mt < 2; ++mt)
#pragma unroll
          for (int i = 0; i < 16; ++i) { const int row = mbase + mt * 32 + crow(i, hh); rc[(size_t)row * 16 + l32] = acc[mt][0][i]; }
      }
    }
  }
};

struct EpiKV {
  u16* kx; u16* vt;
  DI void operator()(f32x16 (&acc)[2][2], int mbase, int nbase, int lane) const {
    const int l32 = lane & 31, hh = lane >> 5;
    if (nbase < 1024) {
#pragma unroll
      for (int mt = 0; mt < 2; ++mt)
#pragma unroll
        for (int nt = 0; nt < 2; ++nt)
#pragma unroll
          for (int i = 0; i < 16; ++i) { const int row = mbase + mt * 32 + crow(i, hh); kx[(size_t)row * 1024 + nbase + nt * 32 + l32] = f2bf(acc[mt][nt][i]); }
    } else {
#pragma unroll
      for (int mt = 0; mt < 2; ++mt)
#pragma unroll
        for (int nt = 0; nt < 2; ++nt)
#pragma unroll
          for (int g = 0; g < 4; ++g) {
            const int row = mbase + mt * 32 + 8 * g + 4 * hh; const int b = row >> 8, key = row & 255; const int c = nbase - 1024 + nt * 32 + l32;
            store4bf(vt + ((size_t)(b * 1024 + c)) * 256 + key, acc[mt][nt][4 * g], acc[mt][nt][4 * g + 1], acc[mt][nt][4 * g + 2], acc[mt][nt][4 * g + 3]);
          }
    }
  }
};

struct EpiResid {
  const float* src; const float* stats; const float* g; const float* b; float* y; int mode;
  DI void operator()(f32x16 (&acc)[2][2], int mbase, int nbase, int lane) const {
    const int l32 = lane & 31, hh = lane >> 5;
    float gg[2] = {1.f, 1.f}, bb[2] = {0.f, 0.f};
    if (mode) { gg[0] = g[nbase + l32]; gg[1] = g[nbase + 32 + l32]; bb[0] = b[nbase + l32]; bb[1] = b[nbase + 32 + l32]; }
#pragma unroll
    for (int mt = 0; mt < 2; ++mt)
#pragma unroll
      for (int i = 0; i < 16; ++i) {
        const int row = mbase + mt * 32 + crow(i, hh);
        float mean = 0.f, rstd = 1.f;
        if (mode) { const float2 st = *(const float2*)(stats + (size_t)row * 2); mean = st.x; rstd = st.y; }
#pragma unroll
        for (int nt = 0; nt < 2; ++nt) {
          const size_t o = (size_t)row * 1024 + nbase + nt * 32 + l32;
          const float r = (src[o] - mean) * rstd * gg[nt] + bb[nt];
          y[o] = ALPHA * r + acc[mt][nt][i];
        }
      }
  }
};

struct EpiResidT {
  const float* src; const float* stats; const float* g; const float* b; float* y; int mode;
  DI void operator()(f32x16 (&acc)[2][2], int mbase, int nbase, int lane) const {
    const int l32 = lane & 31, hh = lane >> 5;
#pragma unroll
    for (int mt = 0; mt < 2; ++mt) {
      const int row = mbase + mt * 32 + l32;
      float mean = 0.f, rstd = 1.f;
      if (mode) { const float2 st = *(const float2*)(stats + (size_t)row * 2); mean = st.x; rstd = st.y; }
#pragma unroll
      for (int nt = 0; nt < 2; ++nt)
#pragma unroll
        for (int gq = 0; gq < 4; ++gq) {
          const int c0 = nbase + nt * 32 + 8 * gq + 4 * hh;
          const size_t o = (size_t)row * 1024 + c0;
          float4 r = *(const float4*)(src + o);
          if (mode) {
            const float4 gv = *(const float4*)(g + c0), bv = *(const float4*)(b + c0);
            r.x = (r.x - mean) * rstd * gv.x + bv.x; r.y = (r.y - mean) * rstd * gv.y + bv.y; r.z = (r.z - mean) * rstd * gv.z + bv.z; r.w = (r.w - mean) * rstd * gv.w + bv.w;
          }
          float4 ov;
          ov.x = ALPHA * r.x + acc[nt][mt][4 * gq]; ov.y = ALPHA * r.y + acc[nt][mt][4 * gq + 1]; ov.z = ALPHA * r.z + acc[nt][mt][4 * gq + 2]; ov.w = ALPHA * r.w + acc[nt][mt][4 * gq + 3];
          *(float4*)(y + o) = ov;
        }
    }
  }
};

struct EpiBfT {
  u16* dst; int ld;
  DI void operator()(f32x16 (&acc)[2][2], int mbase, int nbase, int lane) const {
    const int l32 = lane & 31, hh = lane >> 5;
#pragma unroll
    for (int mt = 0; mt < 2; ++mt)
#pragma unroll
      for (int nt = 0; nt < 2; ++nt)
#pragma unroll
        for (int gq = 0; gq < 4; ++gq)
          store4bf(dst + (size_t)(mbase + mt * 32 + l32) * ld + nbase + nt * 32 + 8 * gq + 4 * hh, acc[nt][mt][4 * gq], acc[nt][mt][4 * gq + 1], acc[nt][mt][4 * gq + 2], acc[nt][mt][4 * gq + 3]);
  }
};

struct EpiMoe2T {
  u16* mo; const int* list; const float* gl; int cnt;
  DI void operator()(f32x16 (&acc)[2][2], int mbase, int nbase, int lane) const {
    const int l32 = lane & 31, hh = lane >> 5;
#pragma unroll
    for (int mt = 0; mt < 2; ++mt) {
      const int r = mbase + mt * 32 + l32;
      if (r < cnt) {
        const int tk = list[r]; const float gw = gl[r];
#pragma unroll
        for (int nt = 0; nt < 2; ++nt)
#pragma unroll
          for (int gq = 0; gq < 4; ++gq)
            store4bf(mo + (size_t)tk * 1024 + nbase + nt * 32 + 8 * gq + 4 * hh, gw * acc[nt][mt][4 * gq], gw * acc[nt][mt][4 * gq + 1], gw * acc[nt][mt][4 * gq + 2], gw * acc[nt][mt][4 * gq + 3]);
      }
    }
  }
};

struct EpiBf {
  u16* dst; int ld;
  DI void operator()(f32x16 (&acc)[2][2], int mbase, int nbase, int lane) const {
    const int l32 = lane & 31, hh = lane >> 5;
#pragma unroll
    for (int mt = 0; mt < 2; ++mt)
#pragma unroll
      for (int nt = 0; nt < 2; ++nt)
#pragma unroll
        for (int i = 0; i < 16; ++i) dst[(size_t)(mbase + mt * 32 + crow(i, hh)) * ld + nbase + nt * 32 + l32] = f2bf(acc[mt][nt][i]);
  }
};

struct EpiSwiglu {
  u16* hid; int ld; int rowoff;
  DI void operator()(f32x16 (&acc)[2][2], int mbase, int nbase, int lane) const {
    const int l32 = lane & 31, hh = lane >> 5; const int hc = (nbase >> 6) * 32 + l32;
#pragma unroll
    for (int mt = 0; mt < 2; ++mt)
#pragma unroll
      for (int i = 0; i < 16; ++i) {
        const float g = acc[mt][0][i], up = acc[mt][1][i];
        const float h = g * __builtin_amdgcn_rcpf(1.f + __expf(-g)) * up;
        hid[(size_t)(rowoff + mbase + mt * 32 + crow(i, hh)) * ld + hc] = f2bf(h);
      }
  }
};

struct EpiMoe2 {
  u16* mo; const int* list; const float* gl; int cnt;
  DI void operator()(f32x16 (&acc)[2][2], int mbase, int nbase, int lane) const {
    const int l32 = lane & 31, hh = lane >> 5;
#pragma unroll
    for (int mt = 0; mt < 2; ++mt)
#pragma unroll
      for (int i = 0; i < 16; ++i) {
        const int r = mbase + mt * 32 + crow(i, hh);
        if (r < cnt) {
          const int tk = list[r]; const float gw = gl[r];
#pragma unroll
          for (int nt = 0; nt < 2; ++nt) mo[(size_t)tk * 1024 + nbase + nt * 32 + l32] = f2bf(gw * acc[mt][nt][i]);
        }
      }
  }
};

DI int dst_row(int n, int mode, int N) {
  if (mode == 0) return n;
  const int F = N >> 1;
  return n < F ? ((n >> 5) * 64 + (n & 31)) : (((n - F) >> 5) * 64 + 32 + ((n - F) & 31));
}
constexpr int TR_TILES = 2 * 2080 + 1408 + 704 + 8 * 1792 + 8 * 896;
DI void get_job(const Params& p, int t, Job& jb, int& lt) {
  char* ws = lws(p);
  if (t < 4160) {
    const int l = t / 2080, r = t % 2080;
    if (r < 800) { jb.src = p.w_in + (size_t)l * 1024 * 3088; jb.dst = (u16*)(ws + OFF_WT_IN) + (size_t)l * INP * 1024; jb.K = 1024; jb.N = 3088; jb.Npad = INP; jb.mode = 0; lt = r; }
    else if (r < 1056) { jb.src = p.w_out + (size_t)l * 1024 * 1024; jb.dst = (u16*)(ws + OFF_WT_OUT) + (size_t)l * 1024 * 1024; jb.K = 1024; jb.N = 1024; jb.Npad = 1024; jb.mode = 0; lt = r - 800; }
    else if (r < 1312) { jb.src = p.xa_wq + (size_t)l * 1024 * 1024; jb.dst = (u16*)(ws + OFF_WT_Q) + (size_t)l * 1024 * 1024; jb.K = 1024; jb.N = 1024; jb.Npad = 1024; jb.mode = 0; lt = r - 1056; }
    else if (r < 1824) { jb.src = p.xa_wkv + (size_t)l * 1024 * 2048; jb.dst = (u16*)(ws + OFF_WT_KV) + (size_t)l * 2048 * 1024; jb.K = 1024; jb.N = 2048; jb.Npad = 2048; jb.mode = 0; lt = r - 1312; }
    else { jb.src = p.xa_wo + (size_t)l * 1024 * 1024; jb.dst = (u16*)(ws + OFF_WT_O) + (size_t)l * 1024 * 1024; jb.K = 1024; jb.N = 1024; jb.Npad = 1024; jb.mode = 0; lt = r - 1824; }
  } else if (t < 5568) { jb.src = p.ffd_w13; jb.dst = (u16*)(ws + OFF_WT_F13); jb.K = 1024; jb.N = 2 * FD; jb.Npad = 2 * FD; jb.mode = 1; lt = t - 4160; }
  else if (t < 6272) { jb.src = p.ffd_w2; jb.dst = (u16*)(ws + OFF_WT_F2); jb.K = FD; jb.N = 1024; jb.Npad = 1024; jb.mode = 0; lt = t - 5568; }
  else if (t < 20608) { const int e = (t - 6272) / 1792; jb.src = p.moe_w13 + (size_t)e * 1024 * 2 * FM; jb.dst = (u16*)(ws + OFF_WT_M13) + (size_t)e * 2 * FM * 1024; jb.K = 1024; jb.N = 2 * FM; jb.Npad = 2 * FM; jb.mode = 1; lt = (t - 6272) % 1792; }
  else { const int e = (t - 20608) / 896; jb.src = p.moe_w2 + (size_t)e * FM * 1024; jb.dst = (u16*)(ws + OFF_WT_M2) + (size_t)e * 1024 * FM; jb.K = FM; jb.N = 1024; jb.Npad = 1024; jb.mode = 0; lt = (t - 20608) % 896; }
}
DI void tr_load(const Job& jb, int lt, float (&v)[16]) {
  const int tid = ltid(); const int tn = jb.Npad >> 6; const int tk = lt / tn, tnn = lt % tn; const int k0 = tk * 64, n0 = tnn * 64;
  const int j = tid & 63;
#pragma unroll
  for (int i = 0; i < 16; ++i) {
    const int k = i * 4 + (tid >> 6);
    v[i] = (n0 + j < jb.N) ? jb.src[(size_t)(k0 + k) * jb.N + n0 + j] : 0.f;
  }
}
DI void tr_store(const Job& jb, int lt, const float (&v)[16], float* ts) {
  const int tid = ltid(); const int tn = jb.Npad >> 6; const int tk = lt / tn, tnn = lt % tn; const int k0 = tk * 64, n0 = tnn * 64;
  const int j = tid & 63;
#pragma unroll
  for (int i = 0; i < 16; ++i) ts[(i * 4 + (tid >> 6)) * 65 + j] = v[i];
  __syncthreads();
  const int nr = tid >> 2; const int drow = (n0 + nr < jb.N) ? dst_row(n0 + nr, jb.mode, jb.N) : (n0 + nr);
#pragma unroll
  for (int cc = 0; cc < 2; ++cc) {
    const int c = (tid & 3) + 4 * cc; const float* t0 = ts + (c * 8) * 65 + nr;
    u32x4 u = {pack2(t0[0], t0[65]), pack2(t0[130], t0[195]), pack2(t0[260], t0[325]), pack2(t0[390], t0[455])};
    *(u32x4*)(jb.dst + (size_t)drow * jb.K + k0 + c * 8) = u;
  }
  __syncthreads();
}
DI void sincos_acc(float ang, float& c, float& s) {
  const double x = (double)ang;
  const double n = rint(x * 0.63661977236758134308);
  double r = fma(-n, 1.57079632679489655800e+00, x);
  r = fma(-n, 6.12323399573676603587e-17, r);
  const double r2 = r * r;
  double sp = -7.6471637318198164759e-13; sp = fma(sp, r2, 1.6059043836821614599e-10); sp = fma(sp, r2, -2.5052108385441718775e-8);
  sp = fma(sp, r2, 2.7557319223985890653e-6); sp = fma(sp, r2, -1.9841269841269841270e-4); sp = fma(sp, r2, 8.3333333333333333333e-3);
  sp = fma(sp, r2, -1.6666666666666666667e-1); const double sv = fma(sp * r2, r, r);
  double cp = 4.7794773323873852974e-14; cp = fma(cp, r2, -1.1470745597729724714e-11); cp = fma(cp, r2, 2.0876756987868098979e-9);
  cp = fma(cp, r2, -2.7557319223985890653e-7); cp = fma(cp, r2, 2.4801587301587301587e-5); cp = fma(cp, r2, -1.3888888888888888889e-3);
  cp = fma(cp, r2, 4.1666666666666666667e-2); cp = fma(cp, r2, -0.5); const double cv = fma(cp, r2, 1.0);
  const int q = ((int)n) & 3;
  const double so = (q == 0) ? sv : (q == 1) ? cv : (q == 2) ? -sv : -cv;
  const double co = (q == 0) ? cv : (q == 1) ? -sv : (q == 2) ? -cv : sv;
  c = (float)co; s = (float)so;
}

DI void softmax_tile(f32x16& S, float& mrun, float& lrun, float& corr, bf16x8& p0, bf16x8& p1) {
  float tmax = S[0];
#pragma unroll
  for (int i = 1; i < 16; ++i) tmax = fmaxf(tmax, S[i]);
  tmax = fmaxf(tmax, __shfl_xor(tmax, 32));
  const float mnew = fmaxf(mrun, tmax);
  corr = ex2(mrun - mnew);
  float ps = 0.f;
#pragma unroll
  for (int i = 0; i < 16; ++i) { S[i] = ex2(S[i] - mnew); ps += S[i]; }
  lrun = lrun * corr + ps; mrun = mnew;
  p0 = pack8(S[0], S[1], S[2], S[3], S[4], S[5], S[6], S[7]);
  p1 = pack8(S[8], S[9], S[10], S[11], S[12], S[13], S[14], S[15]);
}

DI void vperm_store(u16* row, int ch, u32x4 v) {
  const int s = ch >> 1, c = ch & 1;
  u32x2 lo = {v[0], v[1]}, hi = {v[2], v[3]};
  *(u32x2*)(row + 16 * s + 4 * c) = lo;
  *(u32x2*)(row + 16 * s + 8 + 4 * c) = hi;
}

DI void mixA_block(const Params& p, int L, int b, int h, int qblk, float lam, float lam_init, char* smem) {
  const int tid = ltid(), lane = tid & 63, w = tid >> 6, l32 = lane & 31, hh = lane >> 5;
  char* wsl_ = lws(p);
  char* u = wsl_ + OFF_UNION;
  const int q0 = qblk * 128 + w * 32;
  const u16* Q = (const u16*)(u + U_QA) + (size_t)(b * SEQ) * 256 + h * 64;
  const u16* Kg = (const u16*)(u + U_KA) + (size_t)(b * SEQ) * 256 + h * 64;
  const u16* Vg = (const u16*)(u + U_VAT) + (size_t)((b * 4 + h) * 64) * SEQ;
  u16* Ks = (u16*)smem; u16* Vs = Ks + 2 * 64 * 72;
  bf16x8 qf[2][2];
#pragma unroll
  for (int mp = 0; mp < 2; ++mp)
#pragma unroll
    for (int s = 0; s < 2; ++s) qf[mp][s] = ld8(Q + (size_t)(q0 + l32) * 256 + mp * 32 + s * 16 + hh * 8);
  f32x16 O[2][2];
#pragma unroll
  for (int a = 0; a < 2; ++a)
#pragma unroll
    for (int c = 0; c < 2; ++c)
#pragma unroll
      for (int i = 0; i < 16; ++i) O[a][c][i] = 0.f;
  float mrun[2] = {-1e30f, -1e30f}, lrun[2] = {0.f, 0.f};
  const float sc = 0.17677669529663687f * LOG2E;
  const int nkt = 2 * (qblk + 1);
  const int r0 = tid >> 3, ch = tid & 7;
  u32x4 rk[2], rv[2];
#pragma unroll
  for (int i = 0; i < 2; ++i) {
    rk[i] = *(const u32x4*)(Kg + (size_t)(r0 + 32 * i) * 256 + ch * 8);
    rv[i] = *(const u32x4*)(Vg + (size_t)(r0 + 32 * i) * SEQ + ch * 8);
  }
#pragma unroll
  for (int i = 0; i < 2; ++i) { *(u32x4*)(Ks + (r0 + 32 * i) * 72 + ch * 8) = rk[i]; vperm_store(Vs + (r0 + 32 * i) * 72, ch, rv[i]); }
  __syncthreads();
  for (int kt = 0; kt < nkt; ++kt) {
    const int buf = kt & 1;
    if (kt + 1 < nkt) {
      const int k1 = (kt + 1) * 64;
#pragma unroll
      for (int i = 0; i < 2; ++i) {
        rk[i] = *(const u32x4*)(Kg + (size_t)(k1 + r0 + 32 * i) * 256 + ch * 8);
        rv[i] = *(const u32x4*)(Vg + (size_t)(r0 + 32 * i) * SEQ + k1 + ch * 8);
      }
    }
    __builtin_amdgcn_sched_barrier(0);
    const u16* Kb = Ks + buf * 64 * 72; const u16* Vb = Vs + buf * 64 * 72;
#pragma unroll
    for (int ks = 0; ks < 2; ++ks) {
      const int kb = kt * 64 + ks * 32;
      if (kb <= q0) {
        const bool diag = (kb == q0);
        bf16x8 vf[2][2];
#pragma unroll
        for (int mt = 0; mt < 2; ++mt)
#pragma unroll
          for (int s2 = 0; s2 < 2; ++s2) vf[mt][s2] = ld8(Vb + (mt * 32 + l32) * 72 + (ks * 2 + s2) * 16 + hh * 8);
#pragma unroll
        for (int mp = 0; mp < 2; ++mp) {
          f32x16 S;
#pragma unroll
          for (int i = 0; i < 16; ++i) S[i] = 0.f;
          S = MFMA32(ld8(Kb + (ks * 32 + l32) * 72 + mp * 32 + hh * 8), qf[mp][0], S);
          S = MFMA32(ld8(Kb + (ks * 32 + l32) * 72 + mp * 32 + 16 + hh * 8), qf[mp][1], S);
#pragma unroll
          for (int i = 0; i < 16; ++i) { const float v = S[i] * sc; S[i] = (diag && crow(i, hh) > l32) ? -1e30f : v; }
          float corr; bf16x8 pf0, pf1;
          softmax_tile(S, mrun[mp], lrun[mp], corr, pf0, pf1);
#pragma unroll
          for (int mt = 0; mt < 2; ++mt) {
#pragma unroll
            for (int i = 0; i < 16; ++i) O[mp][mt][i] *= corr;
            O[mp][mt] = MFMA32(vf[mt][0], pf0, O[mp][mt]);
            O[mp][mt] = MFMA32(vf[mt][1], pf1, O[mp][mt]);
          }
        }
      }
    }
    if (kt + 1 < nkt) {
      u16* Kn = Ks + (buf ^ 1) * 64 * 72; u16* Vn = Vs + (buf ^ 1) * 64 * 72;
#pragma unroll
      for (int i = 0; i < 2; ++i) { *(u32x4*)(Kn + (r0 + 32 * i) * 72 + ch * 8) = rk[i]; vperm_store(Vn + (r0 + 32 * i) * 72, ch, rv[i]); }
    }
    __syncthreads();
  }
  const float l0 = lrun[0] + __shfl_xor(lrun[0], 32), l1 = lrun[1] + __shfl_xor(lrun[1], 32);
  const float i0 = 1.f / l0, i1 = lam / l1;
  float ssq = 0.f;
#pragma unroll
  for (int mt = 0; mt < 2; ++mt)
#pragma unroll
    for (int i = 0; i < 16; ++i) { const float o = O[0][mt][i] * i0 - O[1][mt][i] * i1; O[0][mt][i] = o; ssq += o * o; }
  ssq += __shfl_xor(ssq, 32);
  const float rs = rsqrtf(ssq * (1.f / 64.f) + LN_EPS) * (1.f - lam_init);
  const float* gg = p.diff_g + L * 64;
  u16* om = (u16*)(u + U_OMIX) + (size_t)(b * SEQ + q0 + l32) * 1024 + h * 64;
#pragma unroll
  for (int mt = 0; mt < 2; ++mt)
#pragma unroll
    for (int g = 0; g < 4; ++g) {
      const int dv = mt * 32 + 8 * g + 4 * hh;
      store4bf(om + dv, O[0][mt][4 * g] * rs * gg[dv], O[0][mt][4 * g + 1] * rs * gg[dv + 1], O[0][mt][4 * g + 2] * rs * gg[dv + 2], O[0][mt][4 * g + 3] * rs * gg[dv + 3]);
    }
}

DI void mixB_block(const Params& p, int b, int h, int g, int sb, char* smem) {
  const int tid = ltid(), lane = tid & 63, w = tid >> 6, l32 = lane & 31, hh = lane >> 5;
  char* wsl_ = lws(p);
  char* u = wsl_ + OFF_UNION;
  const int rsh = 2 * g; const int r = 1 << rsh; const int sub_len = SEQ >> rsh; const int tpr = sub_len >> 5;
  const int rho = (sb * 4) / tpr, it0 = (sb * 4) % tpr; const int i0 = it0 * 32;
  const u16* Q = (const u16*)(u + U_QB) + (size_t)(b * SEQ) * 384 + h * 64;
  const u16* Kg = (const u16*)(u + U_KB) + (size_t)(b * SEQ) * 384 + h * 64;
  const u16* Vg = (const u16*)(u + U_VBT) + (size_t)g * MTOK * 384 + (size_t)((b * 6 + h) * 64) * SEQ + rho * sub_len;
  u16* Ks = (u16*)smem; u16* Vs = Ks + 256 * 72;
  const int kbase = i0 - 128;
#pragma unroll
  for (int i = 0; i < 8; ++i) {
    const int c = tid + 256 * i;
    { const int row = c >> 3, ch = c & 7; const int ki = kbase + row;
      if (ki >= 0) *(u32x4*)(Ks + row * 72 + ch * 8) = *(const u32x4*)(Kg + (size_t)(ki * r + rho) * 384 + ch * 8); }
    { const int dv = c >> 5, ch = c & 31; const int ki = kbase + ch * 8;
      if (ki >= 0) vperm_store(Vs + dv * 264, ch, *(const u32x4*)(Vg + (size_t)dv * SEQ + ki)); }
  }
  const int iq = i0 + w * 32;
  const int tq = (iq + l32) * r + rho;
  bf16x8 qf[4];
#pragma unroll
  for (int s = 0; s < 4; ++s) qf[s] = ld8(Q + (size_t)tq * 384 + s * 16 + hh * 8);
  __syncthreads();
  f32x16 O[2];
#pragma unroll
  for (int a = 0; a < 2; ++a)
#pragma unroll
    for (int i = 0; i < 16; ++i) O[a][i] = 0.f;
  float mrun = -1e30f, lrun = 0.f;
  const float sc = 0.125f * LOG2E;
  for (int kt = 0; kt < 5; ++kt) {
    const int lb = 32 * w + 32 * kt;
    if (kbase + lb < 0) continue;
    f32x16 S;
#pragma unroll
    for (int i = 0; i < 16; ++i) S[i] = 0.f;
#pragma unroll
    for (int s = 0; s < 4; ++s) S = MFMA32(ld8(Ks + (lb + l32) * 72 + s * 16 + hh * 8), qf[s], S);
#pragma unroll
    for (int i = 0; i < 16; ++i) {
      const float v = S[i] * sc; const int kk = crow(i, hh);
      const bool bad = (kt == 0 && kk < l32) || (kt == 4 && kk > l32);
      S[i] = bad ? -1e30f : v;
    }
    float corr; bf16x8 pf0, pf1;
    softmax_tile(S, mrun, lrun, corr, pf0, pf1);
#pragma unroll
    for (int mt = 0; mt < 2; ++mt) {
#pragma unroll
      for (int i = 0; i < 16; ++i) O[mt][i] *= corr;
      O[mt] = MFMA32(ld8(Vs + (mt * 32 + l32) * 264 + lb + hh * 8), pf0, O[mt]);
      O[mt] = MFMA32(ld8(Vs + (mt * 32 + l32) * 264 + lb + 16 + hh * 8), pf1, O[mt]);
    }
  }
  const float lt = lrun + __shfl_xor(lrun, 32);
  const float inv = 1.f / lt;
  const size_t tok = (size_t)b * SEQ + tq;
  u16* po = (u16*)(u + U_PBO) + (size_t)g * MTOK * 384 + tok * 384 + h * 64;
#pragma unroll
  for (int mt = 0; mt < 2; ++mt)
#pragma unroll
    for (int gq = 0; gq < 4; ++gq) {
      const int dv = mt * 32 + 8 * gq + 4 * hh;
      store4bf(po + dv, O[mt][4 * gq] * inv, O[mt][4 * gq + 1] * inv, O[mt][4 * gq + 2] * inv, O[mt][4 * gq + 3] * inv);
    }
  if (hh == 0) {
    float* lse = (float*)(wsl_ + OFF_LSE) + (size_t)g * MTOK * 8;
    lse[tok * 8 + h] = (mrun + __builtin_amdgcn_logf(lt)) * LN2;
  }
  __syncthreads();
}

DI void gla_item(const Params& p, int L, int b, int h, int vg, char* smem) {
  const int tid = ltid(), lane = tid & 63, w = tid >> 6;
  char* wsl_ = lws(p);
  const int kg = lane & 15, vl = lane >> 4;
  char* u = wsl_ + OFF_UNION;
  const u16* hc = (const u16*)(u + U_HC);
  const float* rc = (const float*)(wsl_ + OFF_RC);
  float* go = (float*)(u + U_GLAO);
  float* a_s = (float*)smem;
  float* k_s = a_s + 64 * 48;
  float* q_s = k_s + 64 * 48;
  float* vs = q_s + 64 * 48;
  float* os = vs + 64 * 16;
  float* rcs = os + 64 * 16;
  float wcol[16]; float ba = 0.f;
  const int sd = tid % 48, stg = tid / 48;
  if (tid < 192) {
#pragma unroll
    for (int j = 0; j < 16; ++j) wcol[j] = p.gla_wa2[(size_t)L * 16 * 192 + j * 192 + h * 48 + sd];
    ba = p.gla_ba[L * 192 + h * 48 + sd];
  } else {
#pragma unroll
    for (int j = 0; j < 16; ++j) wcol[j] = 0.f;
  }
  float S0 = 0.f, S1 = 0.f, S2 = 0.f;
  const float qsc = 0.14433756729740643f;
  float4 rcv; u32x2 qv[3], kv[3], vv;
  const int t4 = tid >> 2, p4 = tid & 3;
  {
    const size_t rowb = (size_t)b * SEQ;
    rcv = *(const float4*)(rc + (rowb + t4) * 16 + p4 * 4);
#pragma unroll
    for (int i = 0; i < 3; ++i) { const int c = tid + 256 * i; const int tk = c / 12, pt = c % 12; qv[i] = *(const u32x2*)(hc + (rowb + tk) * 1152 + h * 48 + pt * 4); kv[i] = *(const u32x2*)(hc + (rowb + tk) * 1152 + 192 + h * 48 + pt * 4); }
    vv = *(const u32x2*)(hc + (rowb + t4) * 1152 + 384 + h * 96 + vg * 16 + p4 * 4);
  }
  for (int seg = 0; seg < SEQ / 64; ++seg) {
    const size_t rowb = (size_t)b * SEQ + seg * 64;
    *(float4*)(rcs + t4 * 16 + p4 * 4) = rcv;
#pragma unroll
    for (int i = 0; i < 3; ++i) {
      const int c = tid + 256 * i; const int tk = c / 12, pt = c % 12; const int o = tk * 48 + pt * 4;
      *(float4*)(k_s + o) = make_float4(__uint_as_float(kv[i][0] << 16), __uint_as_float(kv[i][0] & 0xffff0000u), __uint_as_float(kv[i][1] << 16), __uint_as_float(kv[i][1] & 0xffff0000u));
      *(float4*)(q_s + o) = make_float4(__uint_as_float(qv[i][0] << 16) * qsc, __uint_as_float(qv[i][0] & 0xffff0000u) * qsc, __uint_as_float(qv[i][1] << 16) * qsc, __uint_as_float(qv[i][1] & 0xffff0000u) * qsc);
    }
    {
      float4 vf4 = make_float4(__uint_as_float(vv[0] << 16), __uint_as_float(vv[0] & 0xffff0000u), __uint_as_float(vv[1] << 16), __uint_as_float(vv[1] & 0xffff0000u));
      *(float4*)(vs + t4 * 16 + p4 * 4) = vf4;
    }
    __syncthreads();
    if (seg + 1 < SEQ / 64) {
      const size_t rn = rowb + 64;
      rcv = *(const float4*)(rc + (rn + t4) * 16 + p4 * 4);
#pragma unroll
      for (int i = 0; i < 3; ++i) { const int c = tid + 256 * i; const int tk = c / 12, pt = c % 12; qv[i] = *(const u32x2*)(hc + (rn + tk) * 1152 + h * 48 + pt * 4); kv[i] = *(const u32x2*)(hc + (rn + tk) * 1152 + 192 + h * 48 + pt * 4); }
      vv = *(const u32x2*)(hc + (rn + t4) * 1152 + 384 + h * 96 + vg * 16 + p4 * 4);
    }
    __builtin_amdgcn_sched_barrier(0);
    if (tid < 192) {
#pragma unroll 4
      for (int tt = 0; tt < 16; ++tt) {
        const int tl = stg * 16 + tt;
        const float4* r4 = (const float4*)(rcs + tl * 16);
        float z = ba;
#pragma unroll
        for (int j4 = 0; j4 < 4; ++j4) { const float4 rv = r4[j4]; z += rv.x * wcol[4 * j4] + rv.y * wcol[4 * j4 + 1] + rv.z * wcol[4 * j4 + 2] + rv.w * wcol[4 * j4 + 3]; }
        const float a = ex2(-0.0625f * __builtin_amdgcn_logf(1.f + ex2(-z * LOG2E)));
        a_s[tl * 48 + sd] = a;
      }
    }
    __syncthreads();
#pragma unroll 1
    for (int tb = 0; tb < 64; tb += 16) {
      float okeep = 0.f;
#pragma unroll
      for (int tt = 0; tt < 16; ++tt) {
        const int tl = tb + tt;
        const int o3 = tl * 48 + kg * 3;
        const float a0 = a_s[o3], a1 = a_s[o3 + 1], a2 = a_s[o3 + 2];
        const float k0_ = k_s[o3], k1_ = k_s[o3 + 1], k2_ = k_s[o3 + 2];
        const float q0_ = q_s[o3], q1_ = q_s[o3 + 1], q2_ = q_s[o3 + 2];
        const float v = vs[tl * 16 + w * 4 + vl];
        S0 = a0 * S0 + k0_ * v; S1 = a1 * S1 + k1_ * v; S2 = a2 * S2 + k2_ * v;
        float o = q0_ * S0 + q1_ * S1 + q2_ * S2;
        o = row16_allsum(o);
        okeep = (kg == tt) ? o : okeep;
      }
      os[(tb + kg) * 16 + w * 4 + vl] = okeep;
    }
    __syncthreads();
    {
      const float4 ov = *(const float4*)(os + t4 * 16 + p4 * 4);
      *(float4*)(go + (rowb + t4) * 384 + h * 96 + vg * 16 + p4 * 4) = ov;
    }
  }
  __syncthreads();
}

DI int perm16(int t) { return (t & ~12) | ((t & 4) << 1) | ((t & 8) >> 1); }
DI void gla_mfma_item(const Params& p, int L, int b, int h, char* smem) {
  const int tid = ltid(), lane = tid & 63, w = tid >> 6, l32 = lane & 31, hh = lane >> 5;
  char* wsl_ = lws(p);
  char* u = wsl_ + OFF_UNION;
  const u16* hc = (const u16*)(u + U_HC);
  const float* rc = (const float*)(wsl_ + OFF_RC);
  float* go = (float*)(u + U_GLAO);
  u16* Qb = (u16*)smem;
  u16* QbP = Qb + 32 * 56;
  u16* Kb = QbP + 32 * 56;
  u16* KlT = Kb + 32 * 56;
  u16* Vt = KlT + 64 * 40;
  float* ebl = (float*)(Vt + 96 * 40);
  float* tot = ebl + 64;
  float* rcs = tot + 4 * 48;
  const int sd = tid % 48, stg = tid / 48;
  float wcol[16]; float ba = 0.f;
#pragma unroll
  for (int j = 0; j < 16; ++j) wcol[j] = (tid < 192) ? p.gla_wa2[(size_t)L * 16 * 192 + j * 192 + h * 48 + sd] : 0.f;
  if (tid < 192) ba = p.gla_ba[L * 192 + h * 48 + sd];
  for (int i = tid; i < 16 * 40; i += NTHR) KlT[48 * 40 + i] = 0;
  if (tid < 64) ebl[tid] = 0.f;
  f32x16 S0, S1;
#pragma unroll
  for (int i = 0; i < 16; ++i) { S0[i] = 0.f; S1[i] = 0.f; }
  const float qsc = 0.14433756729740643f;
  const int sdc = sd < 48 ? sd : 0;
  u16 rq[8], rk[8], rvv[12]; float rr[2];
  const size_t row00 = (size_t)b * SEQ;
  const unsigned oqk = (unsigned)((stg & 3) * 8) * 1152u + (unsigned)(h * 48 + sdc);
#define GL_LOAD(rowb) { const u16* hcb_ = hc + (rowb) * 1152; const float* rcb_ = rc + (rowb) * 16; \
    _Pragma("unroll") for (int tt = 0; tt < 8; ++tt) { rq[tt] = hcb_[oqk + (unsigned)tt * 1152u]; rk[tt] = hcb_[oqk + (unsigned)tt * 1152u + 192u]; } \
    _Pragma("unroll") for (int i = 0; i < 12; ++i) { const unsigned e_ = (unsigned)(tid + 256 * i); rvv[i] = hcb_[(e_ / 96u) * 1152u + 384u + (unsigned)(h * 96) + e_ % 96u]; } \
    _Pragma("unroll") for (int i = 0; i < 2; ++i) rr[i] = rcb_[tid + 256 * i]; }
  GL_LOAD(row00)
  for (int ch = 0; ch < SEQ / 32; ++ch) {
    const size_t rowb = row00 + ch * 32;
    rcs[tid] = rr[0]; rcs[tid + 256] = rr[1];
#pragma unroll
    for (int i = 0; i < 12; ++i) { const int e_ = tid + 256 * i; Vt[(e_ % 96) * 40 + perm16(e_ / 96)] = rvv[i]; }
    __syncthreads();
    float c2[8]; float run = 0.f;
    if (tid < 192) {
#pragma unroll
      for (int tt = 0; tt < 8; ++tt) {
        const float4* r4 = (const float4*)(rcs + (stg * 8 + tt) * 16);
        float z = ba;
#pragma unroll
        for (int j4 = 0; j4 < 4; ++j4) { const float4 rv = r4[j4]; z += rv.x * wcol[4 * j4] + rv.y * wcol[4 * j4 + 1] + rv.z * wcol[4 * j4 + 2] + rv.w * wcol[4 * j4 + 3]; }
        run += -0.0625f * __builtin_amdgcn_logf(1.f + ex2(-z * LOG2E));
        c2[tt] = run;
      }
      tot[stg * 48 + sd] = run;
    } else {
#pragma unroll
      for (int tt = 0; tt < 8; ++tt) c2[tt] = 0.f;
    }
    __syncthreads();
    if (tid < 192) {
      const float t0 = tot[sd], t1 = tot[48 + sd], t2 = tot[96 + sd], t3 = tot[144 + sd];
      const float pre = (stg > 0 ? t0 : 0.f) + (stg > 1 ? t1 : 0.f) + (stg > 2 ? t2 : 0.f);
      const float blast = (t0 + t1) + (t2 + t3);
      if (stg == 0) ebl[sd] = ex2(blast);
#pragma unroll
      for (int tt = 0; tt < 8; ++tt) {
        const int t = stg * 8 + tt; const float b2 = pre + c2[tt];
        const float q = bf2f(rq[tt]) * qsc, k = bf2f(rk[tt]);
        const u16 qb = f2bf(q * ex2(b2));
        Qb[t * 56 + sd] = qb; QbP[t * 56 + perm16(sd)] = qb;
        Kb[t * 56 + sd] = f2bf(k * ex2(-b2));
        KlT[sd * 40 + perm16(t)] = f2bf(k * ex2(blast - b2));
      }
    }
    __syncthreads();
    {
      const size_t rn = row00 + (ch + 1 < SEQ / 32 ? ch + 1 : ch) * 32;
      GL_LOAD(rn)
    }
    __builtin_amdgcn_sched_barrier(0);
    if (w < 3) {
      f32x16 AT;
#pragma unroll
      for (int i = 0; i < 16; ++i) AT[i] = 0.f;
#pragma unroll
      for (int s3 = 0; s3 < 3; ++s3) AT = MFMA32(ld8(Kb + l32 * 56 + s3 * 16 + hh * 8), ld8(Qb + l32 * 56 + s3 * 16 + hh * 8), AT);
#pragma unroll
      for (int i = 0; i < 16; ++i) AT[i] = (crow(i, hh) <= l32) ? AT[i] : 0.f;
      const bf16x8 pA0 = pack8(AT[0], AT[1], AT[2], AT[3], AT[4], AT[5], AT[6], AT[7]);
      const bf16x8 pA1 = pack8(AT[8], AT[9], AT[10], AT[11], AT[12], AT[13], AT[14], AT[15]);
      const bf16x8 vf0 = ld8(Vt + (32 * w + l32) * 40 + hh * 8), vf1 = ld8(Vt + (32 * w + l32) * 40 + 16 + hh * 8);
      f32x16 OT;
#pragma unroll
      for (int i = 0; i < 16; ++i) OT[i] = 0.f;
      OT = MFMA32(vf0, pA0, OT);
      OT = MFMA32(vf1, pA1, OT);
      const bf16x8 sa0 = pack8(S0[0], S0[1], S0[2], S0[3], S0[4], S0[5], S0[6], S0[7]);
      const bf16x8 sa1 = pack8(S0[8], S0[9], S0[10], S0[11], S0[12], S0[13], S0[14], S0[15]);
      const bf16x8 sa2 = pack8(S1[0], S1[1], S1[2], S1[3], S1[4], S1[5], S1[6], S1[7]);
      OT = MFMA32(sa0, ld8(QbP + l32 * 56 + hh * 8), OT);
      OT = MFMA32(sa1, ld8(QbP + l32 * 56 + 16 + hh * 8), OT);
      OT = MFMA32(sa2, ld8(QbP + l32 * 56 + 32 + hh * 8), OT);
      float* od = go + (rowb + l32) * 384 + h * 96 + 32 * w + 4 * hh;
#pragma unroll
      for (int g = 0; g < 4; ++g) *(float4*)(od + 8 * g) = make_float4(OT[4 * g], OT[4 * g + 1], OT[4 * g + 2], OT[4 * g + 3]);
#pragma unroll
      for (int i = 0; i < 16; ++i) { S0[i] *= ebl[crow(i, hh)]; S1[i] *= ebl[32 + crow(i, hh)]; }
      S0 = MFMA32(ld8(KlT + l32 * 40 + hh * 8), vf0, S0);
      S0 = MFMA32(ld8(KlT + l32 * 40 + 16 + hh * 8), vf1, S0);
      S1 = MFMA32(ld8(KlT + (32 + l32) * 40 + hh * 8), vf0, S1);
      S1 = MFMA32(ld8(KlT + (32 + l32) * 40 + 16 + hh * 8), vf1, S1);
    }
    __syncthreads();
  }
#undef GL_LOAD
}

DI void xattn_block(const Params& p, int L, int b, int h, int qb64, char* smem) {
  const int tid = ltid(), lane = tid & 63, w = tid >> 6, l32 = lane & 31, hh = lane >> 5;
  char* wsl_ = lws(p);
  const int qt2 = w >> 1, dvh = w & 1;
  char* u = wsl_ + OFF_UNION;
  const u16* Qg = (const u16*)(u + U_QXA) + (size_t)(b * SEQ + qb64 * 64) * 1024 + h * 256;
  const u16* Kg = (const u16*)(wsl_ + OFF_KXA) + (size_t)L * 2048 * 1024 + (size_t)(b * 256) * 1024 + h * 256;
  const u16* Vg = (const u16*)(wsl_ + OFF_VXAT) + (size_t)L * 2048 * 1024 + (size_t)(b * 1024 + h * 256) * 256;
  u16* Qs = (u16*)smem; u16* Ks = Qs + 64 * 264; u16* Vs = Ks + 32 * 264;
  {
    u32x4 t8[8];
#pragma unroll
    for (int i = 0; i < 8; ++i) { const int c = tid + 256 * i; t8[i] = *(const u32x4*)(Qg + (size_t)(c >> 5) * 1024 + (c & 31) * 8); }
#pragma unroll
    for (int i = 0; i < 8; ++i) { const int c = tid + 256 * i; *(u32x4*)(Qs + (c >> 5) * 264 + (c & 31) * 8) = t8[i]; }
  }
  u32x4 rk[4], rk2[4], rv[4];
#pragma unroll
  for (int i = 0; i < 4; ++i) {
    const int c = tid + 256 * i;
    rk[i] = *(const u32x4*)(Kg + (size_t)(c >> 5) * 1024 + (c & 31) * 8);
    rv[i] = *(const u32x4*)(Vg + (size_t)(c >> 2) * 256 + (c & 3) * 8);
    rk2[i] = *(const u32x4*)(Kg + (size_t)(32 + (c >> 5)) * 1024 + (c & 31) * 8);
  }
  f32x16 O[4];
#pragma unroll
  for (int a = 0; a < 4; ++a)
#pragma unroll
    for (int i = 0; i < 16; ++i) O[a][i] = 0.f;
  float mrun = -1e30f, lrun = 0.f;
  const float sc = 0.0625f * LOG2E;
#pragma unroll 1
  for (int kt = 0; kt < 8; ++kt) {
#pragma unroll
    for (int i = 0; i < 4; ++i) {
      const int c = tid + 256 * i;
      *(u32x4*)(Ks + (c >> 5) * 264 + (c & 31) * 8) = rk[i];
      vperm_store(Vs + (c >> 2) * 40, c & 3, rv[i]);
    }
    __syncthreads();
    {
      const int k1 = (kt < 7 ? kt + 1 : 7) * 32, k2 = (kt < 6 ? kt + 2 : 7) * 32;
#pragma unroll
      for (int i = 0; i < 4; ++i) {
        const int c = tid + 256 * i;
        rk[i] = rk2[i];
        rk2[i] = *(const u32x4*)(Kg + (size_t)(k2 + (c >> 5)) * 1024 + (c & 31) * 8);
        rv[i] = *(const u32x4*)(Vg + (size_t)(c >> 2) * 256 + k1 + (c & 3) * 8);
      }
    }
    __builtin_amdgcn_sched_barrier(0);
    f32x16 S;
#pragma unroll
    for (int i = 0; i < 16; ++i) S[i] = 0.f;
#pragma unroll
    for (int s = 0; s < 16; ++s) S = MFMA32(ld8(Ks + l32 * 264 + s * 16 + hh * 8), ld8(Qs + (qt2 * 32 + l32) * 264 + s * 16 + hh * 8), S);
#pragma unroll
    for (int i = 0; i < 16; ++i) S[i] *= sc;
    float corr; bf16x8 pf0, pf1;
    softmax_tile(S, mrun, lrun, corr, pf0, pf1);
#pragma unroll
    for (int mt = 0; mt < 4; ++mt) {
#pragma unroll
      for (int i = 0; i < 16; ++i) O[mt][i] *= corr;
      O[mt] = MFMA32(ld8(Vs + (dvh * 128 + mt * 32 + l32) * 40 + hh * 8), pf0, O[mt]);
      O[mt] = MFMA32(ld8(Vs + (dvh * 128 + mt * 32 + l32) * 40 + 16 + hh * 8), pf1, O[mt]);
    }
    __syncthreads();
  }
  const float lt = lrun + __shfl_xor(lrun, 32);
  const float inv = 1.f / lt;
  u16* od = (u16*)(u + U_OMIX) + (size_t)(b * SEQ + qb64 * 64 + qt2 * 32 + l32) * 1024 + h * 256 + dvh * 128;
#pragma unroll
  for (int mt = 0; mt < 4; ++mt)
#pragma unroll
    for (int g = 0; g < 4; ++g) store4bf(od + mt * 32 + 8 * g + 4 * hh, O[mt][4 * g] * inv, O[mt][4 * g + 1] * inv, O[mt][4 * g + 2] * inv, O[mt][4 * g + 3] * inv);
}

DI void ln_row(float4 (&v)[4], const float4 (&gv)[4], const float4 (&bv)[4], float& mean_o, float& rstd_o) {
  float s = 0.f, q = 0.f;
#pragma unroll
  for (int j = 0; j < 4; ++j) { s += v[j].x + v[j].y + v[j].z + v[j].w; q += v[j].x * v[j].x + v[j].y * v[j].y + v[j].z * v[j].z + v[j].w * v[j].w; }
#pragma unroll
  for (int o = 32; o > 0; o >>= 1) { s += __shfl_xor(s, o); q += __shfl_xor(q, o); }
  const float mean = s * (1.f / 1024.f);
  const float var = fmaxf(q * (1.f / 1024.f) - mean * mean, 0.f);
  const float rstd = rsqrtf(var + LN_EPS);
  mean_o = mean; rstd_o = rstd;
#pragma unroll
  for (int j = 0; j < 4; ++j) {
    v[j].x = (v[j].x - mean) * rstd * gv[j].x + bv[j].x; v[j].y = (v[j].y - mean) * rstd * gv[j].y + bv[j].y;
    v[j].z = (v[j].z - mean) * rstd * gv[j].z + bv[j].z; v[j].w = (v[j].w - mean) * rstd * gv[j].w + bv[j].w;
  }
}
#define LN_LOAD_GB(g, bb) float4 gv[4], bv[4]; _Pragma("unroll") for (int j = 0; j < 4; ++j) { gv[j] = *(const float4*)((g) + j * 256 + lane * 4); bv[j] = *(const float4*)((bb) + j * 256 + lane * 4); }
#define LN_LOAD_ROW(dst, row) { _Pragma("unroll") for (int j = 0; j < 4; ++j) dst[j] = *(const float4*)(y + (size_t)(row) * 1024 + j * 256 + lane * 4); }
#define LN_STORE_ROW(v, row) { _Pragma("unroll") for (int j = 0; j < 4; ++j) { \
    u32x2 o_ = {pack2(v[j].x, v[j].y), pack2(v[j].z, v[j].w)}; *(u32x2*)(xbf + (size_t)(row) * 1024 + j * 256 + lane * 4) = o_; } \
    if (lane == 0) *(float2*)(lnstats + (size_t)(row) * 2) = make_float2(mean_, rstd_); }

DI unsigned bar_ld(unsigned* q) { return __hip_atomic_load(q, __ATOMIC_RELAXED, __HIP_MEMORY_SCOPE_AGENT); }
DI unsigned bar_add(unsigned* q, unsigned v) { return __hip_atomic_fetch_add(q, v, __ATOMIC_RELAXED, __HIP_MEMORY_SCOPE_AGENT); }
template <class P_> DI void gbar(const P_& p, unsigned round) {
  asm volatile("s_waitcnt vmcnt(0)" ::: "memory");
  __syncthreads();
  if (threadIdx.x == 0) {
    unsigned* bar = (unsigned*)(lws(p) + OFF_BAR);
    __builtin_amdgcn_fence(__ATOMIC_RELEASE, "agent");
    asm volatile("s_waitcnt vmcnt(0)" ::: "memory");
    const unsigned g = blockIdx.x & 7u, nloc = gridDim.x >> 3;
    const unsigned old = bar_add(bar + 64 * g, 1u);
    if (old + 1u == round * nloc) {
      const unsigned o2 = bar_add(bar + 64 * 8, 1u);
      if (o2 + 1u == round * 8u) {
#pragma unroll
        for (int j = 0; j < 8; ++j) bar_add(bar + 64 * (9 + j), 1u);
      }
    }
    while (bar_ld(bar + 64 * (9 + g)) < round) __builtin_amdgcn_s_sleep(1);
    __builtin_amdgcn_fence(__ATOMIC_ACQUIRE, "agent");
    asm volatile("s_waitcnt vmcnt(0)" ::: "memory");
  }
  __syncthreads();
}

DI bool st_tile(int i, int xcd, int nM, int nN, int NB, int& mt, int& nt) {
  const int T = 8 * NB; const int sl = i / T, within = i % T; const int st = sl * 8 + xcd;
  const int SM = nM >> 3; const int S = SM * (nN / NB);
  if (st >= S) return false;
  const int sm = st % SM, sn = st / SM;
  mt = sm * 8 + (within & 7); nt = sn * NB + (within >> 3);
  return true;
}

__global__ void __launch_bounds__(NTHR, 2) mega(Params p) {
  cg::grid_group grid = cg::this_grid();
  __shared__ __attribute__((aligned(16))) char smem[SMEM_BYTES];
  __shared__ int s_item;
  __shared__ int s_cnt[8];
  __shared__ int s_base[8];
  const int nblk = gridDim.x, blk = blockIdx.x;
  const int nwave = nblk * 4;

#ifdef PROBE_SYNCS
  for (int q_ = 0; q_ < PROBE_SYNCS; ++q_) grid.sync();
#endif
  for (int rep_ = 0; rep_ < REP(0); ++rep_) {
    PH_IDS
    {
      Job jb; int lt; float v[16];
      int t = blk;
      get_job(p, t < TR_TILES ? t : TR_TILES - 1, jb, lt);
      tr_load(jb, lt, v);
      while (t < TR_TILES) {
        const int t2 = t + nblk;
        Job jb2; int lt2; float v2[16];
        get_job(p, t2 < TR_TILES ? t2 : TR_TILES - 1, jb2, lt2);
        tr_load(jb2, lt2, v2);
        __builtin_amdgcn_sched_barrier(0);
        tr_store(jb, lt, v, (float*)smem);
        jb = jb2; lt = lt2;
#pragma unroll
        for (int i = 0; i < 16; ++i) v[i] = v2[i];
        t = t2;
      }
    }
    const size_t gt = (size_t)blk * NTHR + tid, gn = (size_t)nblk * NTHR;
    for (size_t i = gt; i < (size_t)MTOK * 1024 / 4; i += gn) {
      const float4 v = ((const float4*)p.x)[i]; u32x2 o = {pack2(v.x, v.y), pack2(v.z, v.w)}; ((u32x2*)xbf)[i] = o;
    }
    u16* membf = (u16*)(ws + OFF_MEMBF);
    for (size_t i = gt; i < (size_t)2048 * 1024 / 4; i += gn) {
      const float4 v = ((const float4*)p.mem)[i]; u32x2 o = {pack2(v.x, v.y), pack2(v.z, v.w)}; ((u32x2*)membf)[i] = o;
    }
    float* rope = (float*)(ws + OFF_ROPE);
    for (size_t i = gt; i < (size_t)MTOK * 12; i += gn) {
      const int tok = (int)(i / 12), f = (int)(i % 12);
      const float ps = (float)p.pos[tok];
      const float ang = ps * (f < 4 ? p.invfA[f] : p.invfB[f - 4]);
      float c, s; sincos_acc(ang, c, s);
      if (f < 4) { rope[tok * 24 + f] = c; rope[tok * 24 + 4 + f] = s; }
      else { rope[tok * 24 + 8 + (f - 4)] = c; rope[tok * 24 + 16 + (f - 4)] = s; }
    }
    if (blk == 0 && tid < 64) ctr[tid] = 0;
    if (blk == 0) { unsigned* bw = (unsigned*)(ws + OFF_BAR); for (int i = tid; i < 2048; i += NTHR) bw[i] = 0u; }
    if (rep_ + 1 < REP(0)) grid.sync();
  }
  grid.sync();
  unsigned bar_round = 0;
#ifdef PROBE_GBAR
  for (int q_ = 0; q_ < PROBE_GBAR; ++q_) gbar(p, ++bar_round);
#endif

  for (int L = 0; L < 2; ++L) {
    for (int rep_ = 0; rep_ < REP(1); ++rep_) {
      PH_IDS
      const int nin = 128 * 25; const int ntot = nin + (L == 0 ? 512 : 0);
      EpiIn ein{u, (const float*)(ws + OFF_ROPE), (float*)(ws + OFF_RC)};
      (void)nin; (void)ntot;
      const int xcd = blk & 7, jb = blk >> 3, nb8 = nblk >> 3;
      for (int i = jb; ; i += nb8) {
        int mt, nt;
        if (i < 400) {
          if (!st_tile(i, xcd, 128, 25, 5, mt, nt)) break;
          gemm_tile(RowPlain{xbf, 1024}, (const u16*)(ws + OFF_WT_IN) + (size_t)L * INP * 1024, 1024, 1024, mt * 128, nt * 128, (u16*)smem, ein);
        } else {
          if (L != 0 || i >= 432) break;
          const int l2 = (i - 400) >> 4;
          if (!st_tile((i - 400) & 15, xcd, 16, 8, 1, mt, nt)) break;
          EpiKV ekv{(u16*)(ws + OFF_KXA) + (size_t)l2 * 2048 * 1024, (u16*)(ws + OFF_VXAT) + (size_t)l2 * 2048 * 1024};
          gemm_tile256(RowPlain{(const u16*)(ws + OFF_MEMBF), 1024}, (const u16*)(ws + OFF_WT_KV) + (size_t)l2 * 2048 * 1024, 1024, 1024, mt * 128, nt * 256, (u16*)smem, ekv);
        }
      }
      if (rep_ + 1 < REP(1)) gbar(p, ++bar_round);
    }
    gbar(p, ++bar_round);
    for (int rep_ = 0; rep_ < REP(2); ++rep_) {
      PH_IDS
      float lam;
      {
        float a1 = 0.f, a2 = 0.f;
        for (int i = 0; i < 32; ++i) { a1 += p.lam_q1[L * 32 + i] * p.lam_k1[L * 32 + i]; a2 += p.lam_q2[L * 32 + i] * p.lam_k2[L * 32 + i]; }
        lam = expf(a1) - expf(a2) + p.lam_init[L];
      }
      const int total = 32 + 512 + 2304;
      while (true) {
        if (tid == 0) s_item = atomicAdd(&ctr[L + 2 * rep_], 1);
        __syncthreads();
        const int item = s_item;
        __syncthreads();
        if (item >= total) break;
#ifdef PROBE_SUB
        if (rep_ == 1) { const int kind = item < 32 ? 1 : (item < 544 ? 2 : 3); if (kind != PROBE_SUB) continue; }
#endif
        if (item < 32) {
          __builtin_amdgcn_s_setprio(3);
          gla_mfma_item(p, L, item >> 2, item & 3, smem);
          __builtin_amdgcn_s_setprio(0);
        } else if (item < 544) {
          const int a = item - 32; const int qblk = 15 - (a >> 5), bh = a & 31;
          mixA_block(p, L, bh >> 2, bh & 3, qblk, lam, p.lam_init[L], smem);
        } else {
          const int bi = item - 544; const int g = bi / 768, rem = bi % 768; const int bh = rem >> 4, sb = rem & 15;
          mixB_block(p, bh / 6, bh % 6, g, sb, smem);
        }
      }
      if (rep_ + 1 < REP(2)) gbar(p, ++bar_round);
    }
    gbar(p, ++bar_round);
    for (int rep_ = 0; rep_ < REP(3); ++rep_) {
      PH_IDS
      const float* lse = (const float*)(ws + OFF_LSE);
      const u16* pbo = (const u16*)(u + U_PBO); const float* go = (const float*)(u + U_GLAO); const u16* hc = (const u16*)(u + U_HC);
      u16* om = (u16*)(u + U_OMIX);
      const float* gg = p.gla_g + L * 96;
      for (int tok0 = gwave; tok0 < MTOK; tok0 += nwave) {
        int tok = tok0; asm volatile("" : "+v"(tok));
#pragma unroll
        for (int hd = 0; hd < 6; ++hd) {
          const float l0 = lse[(size_t)tok * 8 + hd], l1 = lse[(size_t)MTOK * 8 + (size_t)tok * 8 + hd], l2 = lse[(size_t)2 * MTOK * 8 + (size_t)tok * 8 + hd];
          const float mx = fmaxf(l0, fmaxf(l1, l2));
          const float w0 = __expf(l0 - mx), w1 = __expf(l1 - mx), w2 = __expf(l2 - mx);
          const float inv = 1.f / (w0 + w1 + w2);
          const size_t o = (size_t)tok * 384 + hd * 64 + lane;
          const float v = (w0 * bf2f(pbo[o]) + w1 * bf2f(pbo[(size_t)MTOK * 384 + o]) + w2 * bf2f(pbo[(size_t)2 * MTOK * 384 + o])) * inv;
          om[(size_t)tok * 1024 + 256 + hd * 64 + lane] = f2bf(v);
        }
#pragma unroll
        for (int hd = 0; hd < 4; ++hd) {
          const float o0 = go[(size_t)tok * 384 + hd * 96 + lane];
          const float o1 = lane < 32 ? go[(size_t)tok * 384 + hd * 96 + 64 + lane] : 0.f;
          const float ssq = wave_sum(o0 * o0 + o1 * o1);
          const float rs = rsqrtf(ssq * (1.f / 96.f) + LN_EPS);
          const float g0 = bf2f(hc[(size_t)tok * 1152 + 768 + hd * 96 + lane]);
          om[(size_t)tok * 1024 + 640 + hd * 96 + lane] = f2bf(o0 * rs * gg[lane] * (g0 / (1.f + __expf(-g0))));
          if (lane < 32) {
            const float g1 = bf2f(hc[(size_t)tok * 1152 + 768 + hd * 96 + 64 + lane]);
            om[(size_t)tok * 1024 + 640 + hd * 96 + 64 + lane] = f2bf(o1 * rs * gg[64 + lane] * (g1 / (1.f + __expf(-g1))));
          }
        }
      }
      if (rep_ + 1 < REP(3)) gbar(p, ++bar_round);
    }
    gbar(p, ++bar_round);
    for (int rep_ = 0; rep_ < REP(4); ++rep_) {
      PH_IDS
      EpiResidT er{L == 0 ? p.x : (const float*)y, lnstats, p.ln_ffn_g, p.ln_ffn_b, y, L};
      for (int i = blk >> 3; ; i += nblk >> 3) {
        int mt, nt; if (!st_tile(i, blk & 7, 128, 8, 8, mt, nt)) break;
        gemm_tile_sw(RowPlain{(const u16*)(u + U_OMIX), 1024}, (const u16*)(ws + OFF_WT_OUT) + (size_t)L * 1024 * 1024, 1024, 1024, mt * 128, nt * 128, (u16*)smem, er);
      }
      if (rep_ + 1 < REP(4)) gbar(p, ++bar_round);
    }
    gbar(p, ++bar_round);
    for (int rep_ = 0; rep_ < REP(5); ++rep_) {
      PH_IDS
      const float* g = p.ln_mix_g + L * 1024; const float* bb = p.ln_mix_b + L * 1024;
      LN_LOAD_GB(g, bb)
      float4 v[4], nx[4];
      int row = gwave;
      LN_LOAD_ROW(v, (row < MTOK ? row : MTOK - 1))
      while (row < MTOK) {
        const int r2 = row + nwave;
        LN_LOAD_ROW(nx, (r2 < MTOK ? r2 : MTOK - 1))
        __builtin_amdgcn_sched_barrier(0);
        float mean_, rstd_; ln_row(v, gv, bv, mean_, rstd_);
        LN_STORE_ROW(v, row)
#pragma unroll
        for (int j = 0; j < 4; ++j) v[j] = nx[j];
        row = r2;
      }
      if (rep_ + 1 < REP(5)) gbar(p, ++bar_round);
    }
    gbar(p, ++bar_round);
    for (int rep_ = 0; rep_ < REP(6); ++rep_) {
      PH_IDS
      EpiBfT eq{(u16*)(u + U_QXA), 1024};
      for (int i = blk >> 3; ; i += nblk >> 3) {
        int mt, hd; if (!st_tile(i, blk & 7, 128, 4, 4, mt, hd)) break;
        gemm_tile_sw(RowPlain{xbf, 1024}, (const u16*)(ws + OFF_WT_Q) + (size_t)L * 1024 * 1024, 1024, 1024, mt * 128, hd * 256, (u16*)smem, eq);
        gemm_tile_sw(RowPlain{xbf, 1024}, (const u16*)(ws + OFF_WT_Q) + (size_t)L * 1024 * 1024, 1024, 1024, mt * 128, hd * 256 + 128, (u16*)smem, eq);
        asm volatile("s_waitcnt vmcnt(0)" ::: "memory");
        __syncthreads();
        xattn_block(p, L, mt >> 4, hd, (mt & 15) * 2, smem);
        xattn_block(p, L, mt >> 4, hd, (mt & 15) * 2 + 1, smem);
      }
      if (rep_ + 1 < REP(6)) gbar(p, ++bar_round);
    }
    gbar(p, ++bar_round);
    for (int rep_ = 0; rep_ < REP(8); ++rep_) {
      PH_IDS
      EpiResidT er{y, lnstats, p.ln_mix_g + L * 1024, p.ln_mix_b + L * 1024, y, 1};
      for (int i = blk >> 3; ; i += nblk >> 3) {
        int mt, nt; if (!st_tile(i, blk & 7, 128, 8, 8, mt, nt)) break;
        gemm_tile_sw(RowPlain{(const u16*)(u + U_OMIX), 1024}, (const u16*)(ws + OFF_WT_O) + (size_t)L * 1024 * 1024, 1024, 1024, mt * 128, nt * 128, (u16*)smem, er);
      }
      if (rep_ + 1 < REP(8)) gbar(p, ++bar_round);
    }
    gbar(p, ++bar_round);
    for (int rep_ = 0; rep_ < REP(9); ++rep_) {
      PH_IDS
      const float* g = p.ln_xa_g + L * 1024; const float* bb = p.ln_xa_b + L * 1024;
      const int rpb = (MTOK + nblk - 1) / nblk;
      const int r0 = blk * rpb, r1 = (r0 + rpb < MTOK) ? r0 + rpb : MTOK;
      float* rt = (float*)smem;
      int* ent = (int*)(smem + 32768);
      if (L == 1) {
        for (int i = tid; i < 8192; i += NTHR) { const int e = i & 7, c = i >> 3; rt[e * 1024 + c] = p.moe_router[i]; }
        if (tid < 8) s_cnt[tid] = 0;
        __syncthreads();
      }
      LN_LOAD_GB(g, bb)
      float4 v[4], nx[4];
      int row = r0 + w;
      LN_LOAD_ROW(v, (row < MTOK ? row : MTOK - 1))
      for (; row < r1; row += 4) {
        LN_LOAD_ROW(nx, (row + 4 < MTOK ? row + 4 : MTOK - 1))
        __builtin_amdgcn_sched_barrier(0);
        float mean_, rstd_; ln_row(v, gv, bv, mean_, rstd_);
        LN_STORE_ROW(v, row)
        if (L == 1) {
          float lg[8];
#pragma unroll
          for (int e = 0; e < 8; ++e) {
            float a = 0.f;
#pragma unroll
            for (int j = 0; j < 4; ++j) { const float4 rv = *(const float4*)(rt + e * 1024 + j * 256 + lane * 4); a += v[j].x * rv.x + v[j].y * rv.y + v[j].z * rv.z + v[j].w * rv.w; }
            lg[e] = wave_sum(a);
          }
          if (lane == 0) {
            int e1 = 0; float v1 = lg[0];
#pragma unroll
            for (int e = 1; e < 8; ++e) if (lg[e] > v1) { v1 = lg[e]; e1 = e; }
            int e2 = -1; float v2 = -3.0e38f;
#pragma unroll
            for (int e = 0; e < 8; ++e) if (e != e1 && lg[e] > v2) { v2 = lg[e]; e2 = e; }
            const float ee = expf(v2 - v1); const float w1 = 1.f / (1.f + ee), w2 = ee / (1.f + ee);
            const int li = (row - r0) * 2;
            const int s1 = atomicAdd(&s_cnt[e1], 1); const int s2 = atomicAdd(&s_cnt[e2], 1);
            ent[li * 4 + 0] = row * 2; ent[li * 4 + 1] = e1; ent[li * 4 + 2] = s1; ent[li * 4 + 3] = __float_as_int(w1);
            ent[li * 4 + 4] = row * 2 + 1; ent[li * 4 + 5] = e2; ent[li * 4 + 6] = s2; ent[li * 4 + 7] = __float_as_int(w2);
          }
        }
#pragma unroll
        for (int j = 0; j < 4; ++j) v[j] = nx[j];
      }
      if (L == 1) {
        __syncthreads();
        if (tid < 8) s_base[tid] = atomicAdd(&ctr[8 + tid], s_cnt[tid]);
        __syncthreads();
        int* list = (int*)(ws + OFF_LIST); float* gl = (float*)(ws + OFF_GLIST);
        const int ne = (r1 - r0) * 2;
        for (int i = tid; i < ne; i += NTHR) {
          const int e = ent[i * 4 + 1]; const int pos = s_base[e] + ent[i * 4 + 2];
          list[e * MTOK + pos] = ent[i * 4 + 0]; gl[e * MTOK + pos] = __int_as_float(ent[i * 4 + 3]);
        }
        __syncthreads();
      }
      if (rep_ + 1 < REP(9)) gbar(p, ++bar_round);
    }
    gbar(p, ++bar_round);
    if (L == 0) {
      for (int rep_ = 0; rep_ < REP(10); ++rep_) {
        PH_IDS
        EpiSwiglu es{(u16*)u, FD, 0};
        for (int i = blk >> 3; ; i += nblk >> 3) {
          int mt, nt; if (!st_tile(i, blk & 7, 128, 22, 2, mt, nt)) break;
          gemm_tile256(RowPlain{xbf, 1024}, (const u16*)(ws + OFF_WT_F13), 1024, 1024, mt * 128, nt * 256, (u16*)smem, es);
        }
        if (rep_ + 1 < REP(10)) gbar(p, ++bar_round);
      }
      gbar(p, ++bar_round);
      for (int rep_ = 0; rep_ < REP(11); ++rep_) {
        PH_IDS
        EpiResidT er{y, lnstats, p.ln_xa_g, p.ln_xa_b, y, 1};
        for (int i = blk >> 3; ; i += nblk >> 3) {
          int mt, nt; if (!st_tile(i, blk & 7, 128, 8, 8, mt, nt)) break;
          gemm_tile_sw(RowPlain{(const u16*)u, FD}, (const u16*)(ws + OFF_WT_F2), FD, FD, mt * 128, nt * 128, (u16*)smem, er);
        }
        if (rep_ + 1 < REP(11)) gbar(p, ++bar_round);
      }
      gbar(p, ++bar_round);
      for (int rep_ = 0; rep_ < REP(12); ++rep_) {
        PH_IDS
        const float* g = p.ln_ffn_g; const float* bb = p.ln_ffn_b;
        LN_LOAD_GB(g, bb)
        float4 v[4], nx[4];
        int row = gwave;
        LN_LOAD_ROW(v, (row < MTOK ? row : MTOK - 1))
        while (row < MTOK) {
          const int r2 = row + nwave;
          LN_LOAD_ROW(nx, (r2 < MTOK ? r2 : MTOK - 1))
        __builtin_amdgcn_sched_barrier(0);
          float mean_, rstd_; ln_row(v, gv, bv, mean_, rstd_);
          LN_STORE_ROW(v, row)
#pragma unroll
          for (int j = 0; j < 4; ++j) v[j] = nx[j];
          row = r2;
        }
        if (rep_ + 1 < REP(12)) gbar(p, ++bar_round);
      }
      gbar(p, ++bar_round);
    } else {
      char* ws0 = lws(p); const int* ctr0 = (const int*)(ws0 + OFF_CTR);
      int cnt[8], mts[8], offp[8]; int tot_mt = 0;
#pragma unroll
      for (int e = 0; e < 8; ++e) { cnt[e] = ctr0[8 + e]; mts[e] = (cnt[e] + 127) >> 7; offp[e] = tot_mt * 128; tot_mt += mts[e]; }
      for (int rep_ = 0; rep_ < REP(13); ++rep_) {
        PH_IDS
        const int* list = (const int*)(ws + OFF_LIST); const float* gl = (const float*)(ws + OFF_GLIST); (void)gl;
        const int e = blk & 7;
        int ce = 0, me = 0, oe = 0;
#pragma unroll
        for (int q = 0; q < 8; ++q) if (e == q) { ce = cnt[q]; me = mts[q]; oe = offp[q]; }
        const int SMe = (me + 7) >> 3;
        EpiSwiglu es{(u16*)u, FM, oe};
        if (me > 0) for (int i = blk >> 3; ; i += nblk >> 3) {
          const int sl = i >> 5, within = i & 31; const int sm = sl % SMe, sn = sl / SMe;
          if (sn >= 7) break;
          const int mt = sm * 8 + (within & 7), nt = sn * 4 + (within >> 3);
          if (mt >= me) continue;
          gemm_tile256(RowGather{xbf, list + (size_t)e * MTOK, ce}, (const u16*)(ws + OFF_WT_M13) + (size_t)e * 2 * FM * 1024, 1024, 1024, mt * 128, nt * 256, (u16*)smem, es);
        }
        if (rep_ + 1 < REP(13)) gbar(p, ++bar_round);
      }
      gbar(p, ++bar_round);
      for (int rep_ = 0; rep_ < REP(14); ++rep_) {
        PH_IDS
        const int* list = (const int*)(ws + OFF_LIST); const float* gl = (const float*)(ws + OFF_GLIST); (void)gl;
        const int e = blk & 7;
        int ce = 0, me = 0, oe = 0;
#pragma unroll
        for (int q = 0; q < 8; ++q) if (e == q) { ce = cnt[q]; me = mts[q]; oe = offp[q]; }
        EpiMoe2T em{(u16*)(ws + OFF_MOEOUT), list + (size_t)e * MTOK, gl + (size_t)e * MTOK, ce};
        for (int i = blk >> 3; i < ((me + 7) >> 3) * 64; i += nblk >> 3) {
          const int sl = i >> 6, within = i & 63;
          const int mt = sl * 8 + (within & 7), nt = within >> 3;
          if (mt >= me) continue;
          gemm_tile_sw(RowPlain{(const u16*)u + (size_t)oe * FM, FM}, (const u16*)(ws + OFF_WT_M2) + (size_t)e * 1024 * FM, FM, FM, mt * 128, nt * 128, (u16*)smem, em);
        }
        if (rep_ + 1 < REP(14)) gbar(p, ++bar_round);
      }
      gbar(p, ++bar_round);
      for (int rep_ = 0; rep_ < REP(15); ++rep_) {
        PH_IDS
        const float* g = p.ln_ffn_g + 1024; const float* bb = p.ln_ffn_b + 1024;
        const u16* mo = (const u16*)(ws + OFF_MOEOUT);
        LN_LOAD_GB(g, bb)
        float4 xv[4], nxv[4]; u32x2 ma[4], mc[4], nma[4], nmc[4];
#define FIN_LOAD(XV, MA, MC, row) { _Pragma("unroll") for (int j = 0; j < 4; ++j) { XV[j] = *(const float4*)(y + (size_t)(row) * 1024 + j * 256 + lane * 4); \
          MA[j] = *(const u32x2*)(mo + (size_t)(2 * (row)) * 1024 + j * 256 + lane * 4); MC[j] = *(const u32x2*)(mo + (size_t)(2 * (row) + 1) * 1024 + j * 256 + lane * 4); } }
        int row = gwave;
        FIN_LOAD(xv, ma, mc, (row < MTOK ? row : MTOK - 1))
        while (row < MTOK) {
          const int r2 = row + nwave;
          FIN_LOAD(nxv, nma, nmc, (r2 < MTOK ? r2 : MTOK - 1))
          __builtin_amdgcn_sched_barrier(0);
          float4 v[4];
          const float2 st_ = *(const float2*)(lnstats + (size_t)row * 2);
#pragma unroll
          for (int j = 0; j < 4; ++j) {
            const u32x2 a = ma[j], c = mc[j];
            const float4 gx = *(const float4*)(p.ln_xa_g + 1024 + j * 256 + lane * 4), bx = *(const float4*)(p.ln_xa_b + 1024 + j * 256 + lane * 4);
            const float x0 = (xv[j].x - st_.x) * st_.y * gx.x + bx.x, x1 = (xv[j].y - st_.x) * st_.y * gx.y + bx.y;
            const float x2 = (xv[j].z - st_.x) * st_.y * gx.z + bx.z, x3 = (xv[j].w - st_.x) * st_.y * gx.w + bx.w;
            v[j].x = ALPHA * x0 + (__uint_as_float(a[0] << 16) + __uint_as_float(c[0] << 16));
            v[j].y = ALPHA * x1 + (__uint_as_float(a[0] & 0xffff0000u) + __uint_as_float(c[0] & 0xffff0000u));
            v[j].z = ALPHA * x2 + (__uint_as_float(a[1] << 16) + __uint_as_float(c[1] << 16));
            v[j].w = ALPHA * x3 + (__uint_as_float(a[1] & 0xffff0000u) + __uint_as_float(c[1] & 0xffff0000u));
          }
          float mean_, rstd_; ln_row(v, gv, bv, mean_, rstd_);
#pragma unroll
          for (int j = 0; j < 4; ++j) *(float4*)(p.out + (size_t)row * 1024 + j * 256 + lane * 4) = v[j];
#pragma unroll
          for (int j = 0; j < 4; ++j) { xv[j] = nxv[j]; ma[j] = nma[j]; mc[j] = nmc[j]; }
          row = r2;
        }
#undef FIN_LOAD
        if (rep_ + 1 < REP(15)) gbar(p, ++bar_round);
      }
    }
  }
}

extern "C" void kernel_launch(void* const* d_in, const int* in_sizes, int n_in, void* d_out, int out_size, void* d_ws, size_t ws_size, hipStream_t stream) {
  static int grid_blocks = 0;
  if (!grid_blocks) {
    int dev = 0, cus = 0, per_cu = 0;
    hipGetDevice(&dev);
    hipDeviceGetAttribute(&cus, hipDeviceAttributeMultiprocessorCount, dev);
    hipOccupancyMaxActiveBlocksPerMultiprocessor(&per_cu, mega, NTHR, 0);
    if (per_cu > 2) per_cu = 2;
    if (per_cu < 1) per_cu = 1;
    grid_blocks = cus * per_cu;
  }
  if (ws_size < WS_NEED) { fprintf(stderr, "workspace too small: %zu < %zu\n", ws_size, (size_t)WS_NEED); return; }
  Params p;
  memset(&p, 0, sizeof(p));
  p.x = (const float*)d_in[0]; p.mem = (const float*)d_in[1]; p.pos = (const int*)d_in[2];
  p.w_in = (const float*)d_in[3]; p.lam_q1 = (const float*)d_in[4]; p.lam_k1 = (const float*)d_in[5]; p.lam_q2 = (const float*)d_in[6]; p.lam_k2 = (const float*)d_in[7];
  p.diff_g = (const float*)d_in[8]; p.gla_wa2 = (const float*)d_in[9]; p.gla_ba = (const float*)d_in[10]; p.gla_g = (const float*)d_in[11];
  p.w_out = (const float*)d_in[12]; p.ln_mix_g = (const float*)d_in[13]; p.ln_mix_b = (const float*)d_in[14];
  p.xa_wq = (const float*)d_in[15]; p.xa_wkv = (const float*)d_in[16]; p.xa_wo = (const float*)d_in[17]; p.ln_xa_g = (const float*)d_in[18]; p.ln_xa_b = (const float*)d_in[19];
  p.ffd_w13 = (const float*)d_in[20]; p.ffd_w2 = (const float*)d_in[21]; p.moe_router = (const float*)d_in[22]; p.moe_w13 = (const float*)d_in[23]; p.moe_w2 = (const float*)d_in[24];
  p.ln_ffn_g = (const float*)d_in[25]; p.ln_ffn_b = (const float*)d_in[26];
  p.out = (float*)d_out; p.ws = (char*)d_ws;
  for (int i = 0; i < 4; ++i) p.invfA[i] = (float)pow(500000.0, -(double)(2 * i) / 8.0);
  for (int i = 0; i < 8; ++i) p.invfB[i] = (float)pow(500000.0, -(double)(2 * i) / 16.0);
  for (int l = 0; l < 2; ++l) p.lam_init[l] = (float)(0.8 - 0.6 * exp(-0.3 * l));
  void* args[] = {&p};
  hipError_t e = hipLaunchCooperativeKernel((void*)mega, dim3(grid_blocks), dim3(NTHR), args, 0, stream);
  if (e != hipSuccess) fprintf(stderr, "cooperative launch failed: %s (grid %d)\n", hipGetErrorString(e), grid_blocks);
}
```

```cpp
#include <hip/hip_runtime.h>
#include <hip/hip_cooperative_groups.h>
#include <cstdio>
#include <cmath>
#include <cstring>
namespace cg = cooperative_groups;

#define DI __device__ __forceinline__
typedef unsigned short u16;
typedef __attribute__((ext_vector_type(8))) short bf16x8;
typedef __attribute__((ext_vector_type(4))) short s16x4;
typedef __attribute__((ext_vector_type(16))) float f32x16;
typedef __attribute__((ext_vector_type(2))) float f32x2;
typedef __attribute__((ext_vector_type(2))) __bf16 bf16x2_t;
typedef __attribute__((ext_vector_type(4))) unsigned u32x4;
typedef __attribute__((ext_vector_type(2))) unsigned u32x2;
#define PH_IDS const int tid = ltid(); const int lane = tid & 63, w = tid >> 6; const int gwave = blockIdx.x * 4 + w; (void)lane; (void)gwave; \
  char* ws = lws(p); char* u = ws + OFF_UNION; u16* xbf = (u16*)(ws + OFF_XBF); float* xf = (float*)(ws + OFF_XF); float* y = (float*)(ws + OFF_Y); int* ctr = (int*)(ws + OFF_CTR); float* lnstats = (float*)(ws + OFF_STATS); (void)lnstats; (void)u; (void)xbf; (void)xf; (void)y; (void)ctr;
#ifndef PROBE_PHASE
#define PROBE_PHASE -1
#endif
#define REP(k) ((PROBE_PHASE == (k)) ? 2 : 1)
#define MFMA32(a, b, c) __builtin_amdgcn_mfma_f32_32x32x16_bf16((a), (b), (c), 0, 0, 0)

constexpr int NTHR = 256;
constexpr int MTOK = 16384, SEQ = 2048, DM = 1024;
constexpr int INP = 3200;
constexpr int FD = 2816, FM = 3584;
constexpr float ALPHA = 1.41421356237309515f;
constexpr float LOG2E = 1.44269504088896341f;
constexpr float LN2 = 0.69314718055994531f;
constexpr float LN_EPS = 1e-5f;

constexpr size_t al256(size_t x) { return (x + 255) & ~(size_t)255; }
constexpr size_t OFF_WT_IN = 0;
constexpr size_t OFF_WT_OUT = OFF_WT_IN + al256((size_t)2 * INP * 1024 * 2);
constexpr size_t OFF_WT_Q = OFF_WT_OUT + al256((size_t)2 * 1024 * 1024 * 2);
constexpr size_t OFF_WT_KV = OFF_WT_Q + al256((size_t)2 * 1024 * 1024 * 2);
constexpr size_t OFF_WT_O = OFF_WT_KV + al256((size_t)2 * 2048 * 1024 * 2);
constexpr size_t OFF_WT_F13 = OFF_WT_O + al256((size_t)2 * 1024 * 1024 * 2);
constexpr size_t OFF_WT_F2 = OFF_WT_F13 + al256((size_t)2 * FD * 1024 * 2);
constexpr size_t OFF_WT_M13 = OFF_WT_F2 + al256((size_t)1024 * FD * 2);
constexpr size_t OFF_WT_M2 = OFF_WT_M13 + al256((size_t)8 * 2 * FM * 1024 * 2);
constexpr size_t OFF_XBF = OFF_WT_M2 + al256((size_t)8 * 1024 * FM * 2);
constexpr size_t OFF_XF = OFF_XBF + al256((size_t)MTOK * 1024 * 2);
constexpr size_t OFF_Y = OFF_XF + al256((size_t)MTOK * 1024 * 4);
constexpr size_t OFF_MEMBF = OFF_Y + al256((size_t)MTOK * 1024 * 4);
constexpr size_t OFF_ROPE = OFF_MEMBF + al256((size_t)2048 * 1024 * 2);
constexpr size_t OFF_KXA = OFF_ROPE + al256((size_t)MTOK * 24 * 4);
constexpr size_t OFF_VXAT = OFF_KXA + al256((size_t)2 * 2048 * 1024 * 2);
constexpr size_t OFF_RC = OFF_VXAT + al256((size_t)2 * 2048 * 1024 * 2);
constexpr size_t OFF_LSE = OFF_RC + al256((size_t)MTOK * 16 * 4);
constexpr size_t OFF_MOEOUT = OFF_LSE + al256((size_t)3 * MTOK * 8 * 4);
constexpr size_t OFF_LIST = OFF_MOEOUT + al256((size_t)2 * MTOK * 1024 * 2);
constexpr size_t OFF_GLIST = OFF_LIST + al256((size_t)8 * MTOK * 4);
constexpr size_t OFF_CTR = OFF_GLIST + al256((size_t)8 * MTOK * 4);
constexpr size_t OFF_BAR = OFF_CTR + 256;
constexpr size_t OFF_STATS = OFF_BAR + 8192;
constexpr size_t OFF_UNION = OFF_STATS + al256((size_t)MTOK * 2 * 4);
constexpr size_t U_QA = 0;
constexpr size_t U_KA = U_QA + (size_t)MTOK * 256 * 2;
constexpr size_t U_VAT = U_KA + (size_t)MTOK * 256 * 2;
constexpr size_t U_QB = U_VAT + (size_t)MTOK * 256 * 2;
constexpr size_t U_KB = U_QB + (size_t)MTOK * 384 * 2;
constexpr size_t U_VBT = U_KB + (size_t)MTOK * 384 * 2;
constexpr size_t U_HC = U_VBT + (size_t)3 * MTOK * 384 * 2;
constexpr size_t U_PBO = U_HC + (size_t)MTOK * 1152 * 2;
constexpr size_t U_GLAO = U_PBO + (size_t)3 * MTOK * 384 * 2;
constexpr size_t U_OMIX = U_GLAO + (size_t)MTOK * 384 * 4;
constexpr size_t U_QXA = U_OMIX + (size_t)MTOK * 1024 * 2;
constexpr size_t U_MIX_END = U_QXA + (size_t)MTOK * 1024 * 2;
constexpr size_t HID_ROWS_MOE = 2 * MTOK + 8 * 128;
constexpr size_t U_HID_END = HID_ROWS_MOE * FM * 2;
constexpr size_t UNION_SIZE = al256(U_MIX_END > U_HID_END ? U_MIX_END : U_HID_END);
constexpr size_t WS_NEED = OFF_UNION + UNION_SIZE;

struct Job { const float* src; u16* dst; int K, N, Npad, mode; };

struct Params {
  const float* x; const float* mem; const int* pos;
  const float *w_in, *lam_q1, *lam_k1, *lam_q2, *lam_k2, *diff_g, *gla_wa2, *gla_ba, *gla_g, *w_out, *ln_mix_g, *ln_mix_b;
  const float *xa_wq, *xa_wkv, *xa_wo, *ln_xa_g, *ln_xa_b, *ffd_w13, *ffd_w2, *moe_router, *moe_w13, *moe_w2, *ln_ffn_g, *ln_ffn_b;
  float* out; char* ws;
  float invfA[4]; float invfB[8]; float lam_init[2];
};

DI int ltid() { int t = threadIdx.x; asm volatile("" : "+v"(t)); return t; }
typedef __attribute__((address_space(1))) char gchar_t;
template <class P_> DI char* lws(const P_& p) {
  unsigned long long a_ = (unsigned long long)p.ws; unsigned lo_ = (unsigned)a_, hi_ = (unsigned)(a_ >> 32);
  asm volatile("" : "+v"(lo_), "+v"(hi_));
  lo_ = __builtin_amdgcn_readfirstlane(lo_); hi_ = __builtin_amdgcn_readfirstlane(hi_);
  gchar_t* g_ = (gchar_t*)(((unsigned long long)hi_ << 32) | lo_);
  return (char*)g_;
}
DI float bf2f(u16 v) { return __uint_as_float(((unsigned)v) << 16); }
DI unsigned pack2(float a, float b) { f32x2 v = {a, b}; return __builtin_bit_cast(unsigned, __builtin_convertvector(v, bf16x2_t)); }
DI u16 f2bf(float a) { return (u16)(pack2(a, 0.f) & 0xffffu); }
DI int crow(int i, int hh) { return (i & 3) + 8 * (i >> 2) + 4 * hh; }
DI float wave_sum(float v) { for (int o = 32; o > 0; o >>= 1) v += __shfl_xor(v, o); return v; }
DI float ex2(float x) { return __builtin_amdgcn_exp2f(x); }
DI bf16x8 pack8(float a0, float a1, float a2, float a3, float a4, float a5, float a6, float a7) {
  u32x4 u = {pack2(a0, a1), pack2(a2, a3), pack2(a4, a5), pack2(a6, a7)};
  return __builtin_bit_cast(bf16x8, u);
}
DI void store4bf(u16* dst, float a, float b, float c, float d) { u32x2 u = {pack2(a, b), pack2(c, d)}; *(u32x2*)dst = u; }
DI bf16x8 ld8(const u16* p) { return *(const bf16x8*)p; }
DI bf16x8 ld44(const u16* p) {
  s16x4 lo = *(const s16x4*)p; s16x4 hi = *(const s16x4*)(p + 8);
  return __builtin_shufflevector(lo, hi, 0, 1, 2, 3, 4, 5, 6, 7);
}
DI float row16_allsum(float v) {
  v += __int_as_float(__builtin_amdgcn_update_dpp(0, __float_as_int(v), 0x128, 0xf, 0xf, false));
  v += __int_as_float(__builtin_amdgcn_update_dpp(0, __float_as_int(v), 0x124, 0xf, 0xf, false));
  v += __int_as_float(__builtin_amdgcn_update_dpp(0, __float_as_int(v), 0x122, 0xf, 0xf, false));
  v += __int_as_float(__builtin_amdgcn_update_dpp(0, __float_as_int(v), 0x121, 0xf, 0xf, false));
  return v;
}

constexpr int BK = 64, LDP = BK + 8;
constexpr int BK2 = 32, LDP2 = BK2 + 8;
constexpr int SMEM_BYTES = 2 * 2 * 128 * LDP * 2;

struct RowPlain { const u16* base; int ld; DI unsigned off(int r) const { return (unsigned)(r * ld) * 2u; } };
struct RowGather {
  const u16* base; const int* list; int cnt;
  DI unsigned off(int r) const { int rr = r < cnt ? r : cnt - 1; return (unsigned)(list[rr] >> 1) * 2048u; }
};

template <bool SWAP, class RowA, class Epi>
DI void gemm_tile_t(const RowA& rowA, const u16* __restrict__ Bt, int ldb, int K, int m0, int n0, u16* sm, const Epi& epi) {
  const int tid = ltid(), lane = tid & 63, w = tid >> 6, wm = w >> 1, wn = w & 1;
  const int lr = tid >> 3, lc = tid & 7;
  u16* sa = sm; u16* sb = sm + 2 * 128 * LDP;
  const char* abase = (const char*)rowA.base; const char* bbase = (const char*)Bt;
  unsigned ao[4], bo[4];
#pragma unroll
  for (int i = 0; i < 4; ++i) { ao[i] = rowA.off(m0 + lr + 32 * i) + lc * 16; bo[i] = (unsigned)((n0 + lr + 32 * i) * ldb + lc * 8) * 2u; }
  f32x16 acc[2][2];
#pragma unroll
  for (int a = 0; a < 2; ++a)
#pragma unroll
    for (int b = 0; b < 2; ++b)
#pragma unroll
      for (int i = 0; i < 16; ++i) acc[a][b][i] = 0.f;
  u32x4 ra0[4], rb0[4], ra1[4], rb1[4];
  const int KT = K / BK;
#define G_LOAD(RA, RB, k0) { _Pragma("unroll") for (int i = 0; i < 4; ++i) { RA[i] = *(const u32x4*)(abase + (ao[i] + (unsigned)(k0) * 2u)); RB[i] = *(const u32x4*)(bbase + (bo[i] + (unsigned)(k0) * 2u)); } }
#define S_WRITE(RA, RB, buf) { u16* sa2 = sa + (buf) * 128 * LDP; u16* sb2 = sb + (buf) * 128 * LDP; _Pragma("unroll") for (int i = 0; i < 4; ++i) { *(u32x4*)(sa2 + (lr + 32 * i) * LDP + lc * 8) = RA[i]; *(u32x4*)(sb2 + (lr + 32 * i) * LDP + lc * 8) = RB[i]; } }
#define COMPUTE(buf) { __builtin_amdgcn_iglp_opt(0); const u16* A_ = sa + (buf) * 128 * LDP + (wm * 64 + (lane & 31)) * LDP + (lane >> 5) * 8; const u16* B_ = sb + (buf) * 128 * LDP + (wn * 64 + (lane & 31)) * LDP + (lane >> 5) * 8; \
    _Pragma("unroll") for (int s = 0; s < BK / 16; ++s) { bf16x8 a0 = ld8(A_ + s * 16), a1 = ld8(A_ + 32 * LDP + s * 16); bf16x8 b0 = ld8(B_ + s * 16), b1 = ld8(B_ + 32 * LDP + s * 16); \
      if (SWAP) { acc[0][0] = MFMA32(b0, a0, acc[0][0]); acc[0][1] = MFMA32(b0, a1, acc[0][1]); acc[1][0] = MFMA32(b1, a0, acc[1][0]); acc[1][1] = MFMA32(b1, a1, acc[1][1]); } \
      else { acc[0][0] = MFMA32(a0, b0, acc[0][0]); acc[0][1] = MFMA32(a0, b1, acc[0][1]); acc[1][0] = MFMA32(a1, b0, acc[1][0]); acc[1][1] = MFMA32(a1, b1, acc[1][1]); } } }
  G_LOAD(ra0, rb0, 0);
  S_WRITE(ra0, rb0, 0);
  if (KT > 1) G_LOAD(ra1, rb1, BK);
  __syncthreads();
  for (int kt = 0; kt < KT; kt += 2) {
    if (kt + 2 < KT) G_LOAD(ra0, rb0, (kt + 2) * BK);
    __builtin_amdgcn_sched_barrier(0);
    __builtin_amdgcn_s_setprio(1);
    COMPUTE(0);
    __builtin_amdgcn_s_setprio(0);
    if (kt + 1 < KT) S_WRITE(ra1, rb1, 1);
    __syncthreads();
    if (kt + 1 >= KT) break;
    if (kt + 3 < KT) G_LOAD(ra1, rb1, (kt + 3) * BK);
    __builtin_amdgcn_sched_barrier(0);
    __builtin_amdgcn_s_setprio(1);
    COMPUTE(1);
    __builtin_amdgcn_s_setprio(0);
    if (kt + 2 < KT) S_WRITE(ra0, rb0, 0);
    __syncthreads();
  }
#undef G_LOAD
#undef S_WRITE
#undef COMPUTE
  epi(acc, m0 + wm * 64, n0 + wn * 64, lane);
}

template <class RowA, class Epi>
DI void gemm_tile(const RowA& rowA, const u16* __restrict__ Bt, int ldb, int K, int m0, int n0, u16* sm, const Epi& epi) { gemm_tile_t<false>(rowA, Bt, ldb, K, m0, n0, sm, epi); }
template <class RowA, class Epi>
DI void gemm_tile_sw(const RowA& rowA, const u16* __restrict__ Bt, int ldb, int K, int m0, int n0, u16* sm, const Epi& epi) { gemm_tile_t<true>(rowA, Bt, ldb, K, m0, n0, sm, epi); }

template <class RowA, class Epi>
DI void gemm_tile256(const RowA& rowA, const u16* __restrict__ Bt, int ldb, int K, int m0, int n0, u16* sm, const Epi& epi) {
  const int tid = ltid(), lane = tid & 63, w = tid >> 6, wm = w >> 1, wn = w & 1;
  const int lr = tid >> 2, lc = tid & 3;
  u16* sa = sm; u16* sb = sm + 2 * 128 * LDP2;
  const char* abase = (const char*)rowA.base; const char* bbase = (const char*)Bt;
  unsigned ao[2], bo[4];
#pragma unroll
  for (int i = 0; i < 2; ++i) ao[i] = rowA.off(m0 + lr + 64 * i) + lc * 16;
#pragma unroll
  for (int i = 0; i < 4; ++i) bo[i] = (unsigned)((n0 + lr + 64 * i) * ldb + lc * 8) * 2u;
  f32x16 acc[2][4];
#pragma unroll
  for (int a = 0; a < 2; ++a)
#pragma unroll
    for (int b = 0; b < 4; ++b)
#pragma unroll
      for (int i = 0; i < 16; ++i) acc[a][b][i] = 0.f;
  u32x4 ra0[2], rb0[4], ra1[2], rb1[4];
  const int KT = K / BK2;
#define G_LOAD(RA, RB, k0) { _Pragma("unroll") for (int i = 0; i < 2; ++i) RA[i] = *(const u32x4*)(abase + (ao[i] + (unsigned)(k0) * 2u)); \
    _Pragma("unroll") for (int i = 0; i < 4; ++i) RB[i] = *(const u32x4*)(bbase + (bo[i] + (unsigned)(k0) * 2u)); }
#define S_WRITE(RA, RB, buf) { u16* sa2 = sa + (buf) * 128 * LDP2; u16* sb2 = sb + (buf) * 256 * LDP2; \
    _Pragma("unroll") for (int i = 0; i < 2; ++i) *(u32x4*)(sa2 + (lr + 64 * i) * LDP2 + lc * 8) = RA[i]; \
    _Pragma("unroll") for (int i = 0; i < 4; ++i) *(u32x4*)(sb2 + (lr + 64 * i) * LDP2 + lc * 8) = RB[i]; }
#define COMPUTE(buf) { __builtin_amdgcn_iglp_opt(0); const u16* A_ = sa + (buf) * 128 * LDP2 + (wm * 64 + (lane & 31)) * LDP2 + (lane >> 5) * 8; const u16* B_ = sb + (buf) * 256 * LDP2 + (wn * 128 + (lane & 31)) * LDP2 + (lane >> 5) * 8; \
    _Pragma("unroll") for (int s = 0; s < BK2 / 16; ++s) { bf16x8 a0 = ld8(A_ + s * 16), a1 = ld8(A_ + 32 * LDP2 + s * 16); \
      _Pragma("unroll") for (int nt = 0; nt < 4; ++nt) { bf16x8 bq = ld8(B_ + nt * 32 * LDP2 + s * 16); acc[0][nt] = MFMA32(a0, bq, acc[0][nt]); acc[1][nt] = MFMA32(a1, bq, acc[1][nt]); } } }
  G_LOAD(ra0, rb0, 0);
  S_WRITE(ra0, rb0, 0);
  if (KT > 1) G_LOAD(ra1, rb1, BK2);
  __syncthreads();
  for (int kt = 0; kt < KT; kt += 2) {
    if (kt + 2 < KT) G_LOAD(ra0, rb0, (kt + 2) * BK2);
    __builtin_amdgcn_sched_barrier(0);
    __builtin_amdgcn_s_setprio(1);
    COMPUTE(0);
    __builtin_amdgcn_s_setprio(0);
    if (kt + 1 < KT) S_WRITE(ra1, rb1, 1);
    __syncthreads();
    if (kt + 1 >= KT) break;
    if (kt + 3 < KT) G_LOAD(ra1, rb1, (kt + 3) * BK2);
    __builtin_amdgcn_sched_barrier(0);
    __builtin_amdgcn_s_setprio(1);
    COMPUTE(1);
    __builtin_amdgcn_s_setprio(0);
    if (kt + 2 < KT) S_WRITE(ra0, rb0, 0);
    __syncthreads();
  }
#undef G_LOAD
#undef S_WRITE
#undef COMPUTE
#pragma unroll
  for (int hf = 0; hf < 2; ++hf) {
    f32x16 sub[2][2];
#pragma unroll
    for (int a = 0; a < 2; ++a)
#pragma unroll
      for (int b = 0; b < 2; ++b) sub[a][b] = acc[a][2 * hf + b];
    epi(sub, m0 + wm * 64, n0 + wn * 128 + hf * 64, lane);
  }
}

struct EpiIn {
  char* u; const float* rope; float* rc;
  DI void operator()(f32x16 (&acc)[2][2], int mbase, int nbase, int lane) const {
    const int cgp = nbase >> 6, l32 = lane & 31, hh = lane >> 5;
    if (cgp < 8) {
      u16* dst = (u16*)(u + (cgp < 4 ? U_QA : U_KA)); const int c0 = (cgp & 3) * 64;
#pragma unroll
      for (int mt = 0; mt < 2; ++mt)
#pragma unroll
        for (int nt = 0; nt < 2; ++nt)
#pragma unroll
          for (int i = 0; i < 16; ++i) {
            const int row = mbase + mt * 32 + crow(i, hh);
            float v = acc[mt][nt][i]; float pv = __shfl_xor(v, 4);
            if (l32 < 8) { const int fi = l32 & 3; float c = rope[row * 24 + fi], s = rope[row * 24 + 4 + fi]; v = (l32 < 4) ? v * c - pv * s : v * c + pv * s; }
            dst[(size_t)row * 256 + c0 + nt * 32 + l32] = f2bf(v);
          }
    } else if (cgp < 12) {
      u16* dst = (u16*)(u + U_VAT); const int head = cgp - 8;
#pragma unroll
      for (int mt = 0; mt < 2; ++mt)
#pragma unroll
        for (int nt = 0; nt < 2; ++nt)
#pragma unroll
          for (int g = 0; g < 4; ++g) {
            const int row = mbase + mt * 32 + 8 * g + 4 * hh; const int b = row >> 11, t = row & 2047; const int dv = nt * 32 + l32;
            store4bf(dst + ((size_t)((b * 4 + head) * 64 + dv)) * SEQ + t, acc[mt][nt][4 * g], acc[mt][nt][4 * g + 1], acc[mt][nt][4 * g + 2], acc[mt][nt][4 * g + 3]);
          }
    } else if (cgp < 24) {
      const bool isq = cgp < 18;
      u16* dst = (u16*)(u + (isq ? U_QB : U_KB)); const int c0 = (cgp - (isq ? 12 : 18)) * 64;
#pragma unroll
      for (int mt = 0; mt < 2; ++mt)
#pragma unroll
        for (int nt = 0; nt < 2; ++nt)
#pragma unroll
          for (int i = 0; i < 16; ++i) {
            const int row = mbase + mt * 32 + crow(i, hh);
            float v = acc[mt][nt][i];
            if (nt == 0) {
              float pv = __shfl_xor(v, 8);
              if (l32 < 16) { const int fi = l32 & 7; float c = rope[row * 24 + 8 + fi], s = rope[row * 24 + 16 + fi]; v = (l32 < 8) ? v * c - pv * s : v * c + pv * s; }
            }
            dst[(size_t)row * 384 + c0 + nt * 32 + l32] = f2bf(v);
          }
    } else if (cgp < 30) {
      u16* d0 = (u16*)(u + U_VBT); u16* d1 = d0 + (size_t)MTOK * 384; u16* d2 = d1 + (size_t)MTOK * 384; const int head = cgp - 24;
#pragma unroll
      for (int mt = 0; mt < 2; ++mt)
#pragma unroll
        for (int nt = 0; nt < 2; ++nt)
#pragma unroll
          for (int g = 0; g < 4; ++g) {
            const int row = mbase + mt * 32 + 8 * g + 4 * hh; const int b = row >> 11, t = row & 2047; const int dv = nt * 32 + l32;
            const size_t rb_ = ((size_t)((b * 6 + head) * 64 + dv)) * SEQ;
            store4bf(d0 + rb_ + t, acc[mt][nt][4 * g], acc[mt][nt][4 * g + 1], acc[mt][nt][4 * g + 2], acc[mt][nt][4 * g + 3]);
#pragma unroll
            for (int j = 0; j < 4; ++j) {
              const int tt = t + j; const u16 bv = f2bf(acc[mt][nt][4 * g + j]);
              d1[rb_ + (tt & 3) * 512 + (tt >> 2)] = bv;
              d2[rb_ + (tt & 15) * 128 + (tt >> 4)] = bv;
            }
          }
    } else if (cgp < 48) {
      u16* dst = (u16*)(u + U_HC); const int c0 = (cgp - 30) * 64;
#pragma unroll
      for (int mt = 0; mt < 2; ++mt)
#pragma unroll
        for (int nt = 0; nt < 2; ++nt)
#pragma unroll
          for (int i = 0; i < 16; ++i) {
            const int row = mbase + mt * 32 + crow(i, hh);
            dst[(size_t)row * 1152 + c0 + nt * 32 + l32] = f2bf(acc[mt][nt][i]);
          }
    } else if (cgp == 48) {
      if (l32 < 16) {
#pragma unroll
        for (int mt = 0; mt < 2; ++mt)
#pragma unroll
          for (int i = 0; i < 16; ++i) { const int row = mbase + mt * 32 + crow(i, hh); rc[(size_t)row * 16 + l32] = acc[mt][0][i]; }
      }
    }
  }
};

struct EpiKV {
  u16* kx; u16* vt;
  DI void operator()(f32x16 (&acc)[2][2], int mbase, int nbase, int lane) const {
    const int l32 = lane & 31, hh = lane >> 5;
    if (nbase < 1024) {
#pragma unroll
      for (int mt = 0; mt < 2; ++mt)
#pragma unroll
        for (int nt = 0; nt < 2; ++nt)
#pragma unroll
          for (int i = 0; i < 16; ++i) { const int row = mbase + mt * 32 + crow(i, hh); kx[(size_t)row * 1024 + nbase + nt * 32 + l32] = f2bf(acc[mt][nt][i]); }
    } else {
#pragma unroll
      for (int mt = 0; mt < 2; ++mt)
#pragma unroll
        for (int nt = 0; nt < 2; ++nt)
#pragma unroll
          for (int g = 0; g < 4; ++g) {
            const int row = mbase + mt * 32 + 8 * g + 4 * hh; const int b = row >> 8, key = row & 255; const int c = nbase - 1024 + nt * 32 + l32;
            store4bf(vt + ((size_t)(b * 1024 + c)) * 256 + key, acc[mt][nt][4 * g], acc[mt][nt][4 * g + 1], acc[mt][nt][4 * g + 2], acc[mt][nt][4 * g + 3]);
          }
    }
  }
};

struct EpiResid {
  const float* src; const float* stats; const float* g; const float* b; float* y; int mode;
  DI void operator()(f32x16 (&acc)[2][2], int mbase, int nbase, int lane) const {
    const int l32 = lane & 31, hh = lane >> 5;
    float gg[2] = {1.f, 1.f}, bb[2] = {0.f, 0.f};
    if (mode) { gg[0] = g[nbase + l32]; gg[1] = g[nbase + 32 + l32]; bb[0] = b[nbase + l32]; bb[1] = b[nbase + 32 + l32]; }
#pragma unroll
    for (int mt = 0; mt < 2; ++mt)
#pragma unroll
      for (int i = 0; i < 16; ++i) {
        const int row = mbase + mt * 32 + crow(i, hh);
        float mean = 0.f, rstd = 1.f;
        if (mode) { const float2 st = *(const float2*)(stats + (size_t)row * 2); mean = st.x; rstd = st.y; }
#pragma unroll
        for (int nt = 0; nt < 2; ++nt) {
          const size_t o = (size_t)row * 1024 + nbase + nt * 32 + l32;
          const float r = (src[o] - mean) * rstd * gg[nt] + bb[nt];
          y[o] = ALPHA * r + acc[mt][nt][i];
        }
      }
  }
};

struct EpiResidT {
  const float* src; const float* stats; const float* g; const float* b; float* y; int mode;
  DI void operator()(f32x16 (&acc)[2][2], int mbase, int nbase, int lane) const {
    const int l32 = lane & 31, hh = lane >> 5;
#pragma unroll
    for (int mt = 0; mt < 2; ++mt) {
      const int row = mbase + mt * 32 + l32;
      float mean = 0.f, rstd = 1.f;
      if (mode) { const float2 st = *(const float2*)(stats + (size_t)row * 2); mean = st.x; rstd = st.y; }
#pragma unroll
      for (int nt = 0; nt < 2; ++nt)
#pragma unroll
        for (int gq = 0; gq < 4; ++gq) {
          const int c0 = nbase + nt * 32 + 8 * gq + 4 * hh;
          const size_t o = (size_t)row * 1024 + c0;
          float4 r = *(const float4*)(src + o);
          if (mode) {
            const float4 gv = *(const float4*)(g + c0), bv = *(const float4*)(b + c0);
            r.x = (r.x - mean) * rstd * gv.x + bv.x; r.y = (r.y - mean) * rstd * gv.y + bv.y; r.z = (r.z - mean) * rstd * gv.z + bv.z; r.w = (r.w - mean) * rstd * gv.w + bv.w;
          }
          float4 ov;
          ov.x = ALPHA * r.x + acc[nt][mt][4 * gq]; ov.y = ALPHA * r.y + acc[nt][mt][4 * gq + 1]; ov.z = ALPHA * r.z + acc[nt][mt][4 * gq + 2]; ov.w = ALPHA * r.w + acc[nt][mt][4 * gq + 3];
          *(float4*)(y + o) = ov;
        }
    }
  }
};

struct EpiBfT {
  u16* dst; int ld;
  DI void operator()(f32x16 (&acc)[2][2], int mbase, int nbase, int lane) const {
    const int l32 = lane & 31, hh = lane >> 5;
#pragma unroll
    for (int mt = 0; mt < 2; ++mt)
#pragma unroll
      for (int nt = 0; nt < 2; ++nt)
#pragma unroll
        for (int gq = 0; gq < 4; ++gq)
          store4bf(dst + (size_t)(mbase + mt * 32 + l32) * ld + nbase + nt * 32 + 8 * gq + 4 * hh, acc[nt][mt][4 * gq], acc[nt][mt][4 * gq + 1], acc[nt][mt][4 * gq + 2], acc[nt][mt][4 * gq + 3]);
  }
};

struct EpiMoe2T {
  u16* mo; const int* list; const float* gl; int cnt;
  DI void operator()(f32x16 (&acc)[2][2], int mbase, int nbase, int lane) const {
    const int l32 = lane & 31, hh = lane >> 5;
#pragma unroll
    for (int mt = 0; mt < 2; ++mt) {
      const int r = mbase + mt * 32 + l32;
      if (r < cnt) {
        const int tk = list[r]; const float gw = gl[r];
#pragma unroll
        for (int nt = 0; nt < 2; ++nt)
#pragma unroll
          for (int gq = 0; gq < 4; ++gq)
            store4bf(mo + (size_t)tk * 1024 + nbase + nt * 32 + 8 * gq + 4 * hh, gw * acc[nt][mt][4 * gq], gw * acc[nt][mt][4 * gq + 1], gw * acc[nt][mt][4 * gq + 2], gw * acc[nt][mt][4 * gq + 3]);
      }
    }
  }
};

struct EpiBf {
  u16* dst; int ld;
  DI void operator()(f32x16 (&acc)[2][2], int mbase, int nbase, int lane) const {
    const int l32 = lane & 31, hh = lane >> 5;
#pragma unroll
    for (int mt = 0; mt < 2; ++mt)
#pragma unroll
      for (int nt = 0; nt < 2; ++nt)
#pragma unroll
        for (int i = 0; i < 16; ++i) dst[(size_t)(mbase + mt * 32 + crow(i, hh)) * ld + nbase + nt * 32 + l32] = f2bf(acc[mt][nt][i]);
  }
};

struct EpiSwiglu {
  u16* hid; int ld; int rowoff;
  DI void operator()(f32x16 (&acc)[2][2], int mbase, int nbase, int lane) const {
    const int l32 = lane & 31, hh = lane >> 5; const int hc = (nbase >> 6) * 32 + l32;
#pragma unroll
    for (int mt = 0; mt < 2; ++mt)
#pragma unroll
      for (int i = 0; i < 16; ++i) {
        const float g = acc[mt][0][i], up = acc[mt][1][i];
        const float h = g * __builtin_amdgcn_rcpf(1.f + __expf(-g)) * up;
        hid[(size_t)(rowoff + mbase + mt * 32 + crow(i, hh)) * ld + hc] = f2bf(h);
      }
  }
};

struct EpiMoe2 {
  u16* mo; const int* list; const float* gl; int cnt;
  DI void operator()(f32x16 (&acc)[2][2], int mbase, int nbase, int lane) const {
    const int l32 = lane & 31, hh = lane >> 5;
#pragma unroll
    for (int mt = 0; mt < 2; ++mt)
#pragma unroll
      for (int i = 0; i < 16; ++i) {
        const int r = mbase + mt * 32 + crow(i, hh);
        if (r < cnt) {
          const int tk = list[r]; const float gw = gl[r];
#pragma unroll
          for (int nt = 0; nt < 2; ++nt) mo[(size_t)tk * 1024 + nbase + nt * 32 + l32] = f2bf(gw * acc[mt][nt][i]);
        }
      }
  }
};

DI int dst_row(int n, int mode, int N) {
  if (mode == 0) return n;
  const int F = N >> 1;
  return n < F ? ((n >> 5) * 64 + (n & 31)) : (((n - F) >> 5) * 64 + 32 + ((n - F) & 31));
}
constexpr int TR_TILES = 2 * 2080 + 1408 + 704 + 8 * 1792 + 8 * 896;
DI void get_job(const Params& p, int t, Job& jb, int& lt) {
  char* ws = lws(p);
  if (t < 4160) {
    const int l = t / 2080, r = t % 2080;
    if (r < 800) { jb.src = p.w_in + (size_t)l * 1024 * 3088; jb.dst = (u16*)(ws + OFF_WT_IN) + (size_t)l * INP * 1024; jb.K = 1024; jb.N = 3088; jb.Npad = INP; jb.mode = 0; lt = r; }
    else if (r < 1056) { jb.src = p.w_out + (size_t)l * 1024 * 1024; jb.dst = (u16*)(ws + OFF_WT_OUT) + (size_t)l * 1024 * 1024; jb.K = 1024; jb.N = 1024; jb.Npad = 1024; jb.mode = 0; lt = r - 800; }
    else if (r < 1312) { jb.src = p.xa_wq + (size_t)l * 1024 * 1024; jb.dst = (u16*)(ws + OFF_WT_Q) + (size_t)l * 1024 * 1024; jb.K = 1024; jb.N = 1024; jb.Npad = 1024; jb.mode = 0; lt = r - 1056; }
    else if (r < 1824) { jb.src = p.xa_wkv + (size_t)l * 1024 * 2048; jb.dst = (u16*)(ws + OFF_WT_KV) + (size_t)l * 2048 * 1024; jb.K = 1024; jb.N = 2048; jb.Npad = 2048; jb.mode = 0; lt = r - 1312; }
    else { jb.src = p.xa_wo + (size_t)l * 1024 * 1024; jb.dst = (u16*)(ws + OFF_WT_O) + (size_t)l * 1024 * 1024; jb.K = 1024; jb.N = 1024; jb.Npad = 1024; jb.mode = 0; lt = r - 1824; }
  } else if (t < 5568) { jb.src = p.ffd_w13; jb.dst = (u16*)(ws + OFF_WT_F13); jb.K = 1024; jb.N = 2 * FD; jb.Npad = 2 * FD; jb.mode = 1; lt = t - 4160; }
  else if (t < 6272) { jb.src = p.ffd_w2; jb.dst = (u16*)(ws + OFF_WT_F2); jb.K = FD; jb.N = 1024; jb.Npad = 1024; jb.mode = 0; lt = t - 5568; }
  else if (t < 20608) { const int e = (t - 6272) / 1792; jb.src = p.moe_w13 + (size_t)e * 1024 * 2 * FM; jb.dst = (u16*)(ws + OFF_WT_M13) + (size_t)e * 2 * FM * 1024; jb.K = 1024; jb.N = 2 * FM; jb.Npad = 2 * FM; jb.mode = 1; lt = (t - 6272) % 1792; }
  else { const int e = (t - 20608) / 896; jb.src = p.moe_w2 + (size_t)e * FM * 1024; jb.dst = (u16*)(ws + OFF_WT_M2) + (size_t)e * 1024 * FM; jb.K = FM; jb.N = 1024; jb.Npad = 1024; jb.mode = 0; lt = (t - 20608) % 896; }
}
DI void tr_load(const Job& jb, int lt, float (&v)[16]) {
  const int tid = ltid(); const int tn = jb.Npad >> 6; const int tk = lt / tn, tnn = lt % tn; const int k0 = tk * 64, n0 = tnn * 64;
  const int j = tid & 63;
#pragma unroll
  for (int i = 0; i < 16; ++i) {
    const int k = i * 4 + (tid >> 6);
    v[i] = (n0 + j < jb.N) ? jb.src[(size_t)(k0 + k) * jb.N + n0 + j] : 0.f;
  }
}
DI void tr_store(const Job& jb, int lt, const float (&v)[16], float* ts) {
  const int tid = ltid(); const int tn = jb.Npad >> 6; const int tk = lt / tn, tnn = lt % tn; const int k0 = tk * 64, n0 = tnn * 64;
  const int j = tid & 63;
#pragma unroll
  for (int i = 0; i < 16; ++i) ts[(i * 4 + (tid >> 6)) * 65 + j] = v[i];
  __syncthreads();
  const int nr = tid >> 2; const int drow = (n0 + nr < jb.N) ? dst_row(n0 + nr, jb.mode, jb.N) : (n0 + nr);
#pragma unroll
  for (int cc = 0; cc < 2; ++cc) {
    const int c = (tid & 3) + 4 * cc; const float* t0 = ts + (c * 8) * 65 + nr;
    u32x4 u = {pack2(t0[0], t0[65]), pack2(t0[130], t0[195]), pack2(t0[260], t0[325]), pack2(t0[390], t0[455])};
    *(u32x4*)(jb.dst + (size_t)drow * jb.K + k0 + c * 8) = u;
  }
  __syncthreads();
}
DI void sincos_acc(float ang, float& c, float& s) {
  const double x = (double)ang;
  const double n = rint(x * 0.63661977236758134308);
  double r = fma(-n, 1.57079632679489655800e+00, x);
  r = fma(-n, 6.12323399573676603587e-17, r);
  const double r2 = r * r;
  double sp = -7.6471637318198164759e-13; sp = fma(sp, r2, 1.6059043836821614599e-10); sp = fma(sp, r2, -2.5052108385441718775e-8);
  sp = fma(sp, r2, 2.7557319223985890653e-6); sp = fma(sp, r2, -1.9841269841269841270e-4); sp = fma(sp, r2, 8.3333333333333333333e-3);
  sp = fma(sp, r2, -1.6666666666666666667e-1); const double sv = fma(sp * r2, r, r);
  double cp = 4.7794773323873852974e-14; cp = fma(cp, r2, -1.1470745597729724714e-11); cp = fma(cp, r2, 2.0876756987868098979e-9);
  cp = fma(cp, r2, -2.7557319223985890653e-7); cp = fma(cp, r2, 2.4801587301587301587e-5); cp = fma(cp, r2, -1.3888888888888888889e-3);
  cp = fma(cp, r2, 4.1666666666666666667e-2); cp = fma(cp, r2, -0.5); const double cv = fma(cp, r2, 1.0);
  const int q = ((int)n) & 3;
  const double so = (q == 0) ? sv : (q == 1) ? cv : (q == 2) ? -sv : -cv;
  const double co = (q == 0) ? cv : (q == 1) ? -sv : (q == 2) ? -cv : sv;
  c = (float)co; s = (float)so;
}

DI void softmax_tile(f32x16& S, float& mrun, float& lrun, float& corr, bf16x8& p0, bf16x8& p1) {
  float tmax = S[0];
#pragma unroll
  for (int i = 1; i < 16; ++i) tmax = fmaxf(tmax, S[i]);
  tmax = fmaxf(tmax, __shfl_xor(tmax, 32));
  const float mnew = fmaxf(mrun, tmax);
  corr = ex2(mrun - mnew);
  float ps = 0.f;
#pragma unroll
  for (int i = 0; i < 16; ++i) { S[i] = ex2(S[i] - mnew); ps += S[i]; }
  lrun = lrun * corr + ps; mrun = mnew;
  p0 = pack8(S[0], S[1], S[2], S[3], S[4], S[5], S[6], S[7]);
  p1 = pack8(S[8], S[9], S[10], S[11], S[12], S[13], S[14], S[15]);
}

DI void vperm_store(u16* row, int ch, u32x4 v) {
  const int s = ch >> 1, c = ch & 1;
  u32x2 lo = {v[0], v[1]}, hi = {v[2], v[3]};
  *(u32x2*)(row + 16 * s + 4 * c) = lo;
  *(u32x2*)(row + 16 * s + 8 + 4 * c) = hi;
}

DI void mixA_block(const Params& p, int L, int b, int h, int qblk, float lam, float lam_init, char* smem) {
  const int tid = ltid(), lane = tid & 63, w = tid >> 6, l32 = lane & 31, hh = lane >> 5;
  char* wsl_ = lws(p);
  char* u = wsl_ + OFF_UNION;
  const int q0 = qblk * 128 + w * 32;
  const u16* Q = (const u16*)(u + U_QA) + (size_t)(b * SEQ) * 256 + h * 64;
  const u16* Kg = (const u16*)(u + U_KA) + (size_t)(b * SEQ) * 256 + h * 64;
  const u16* Vg = (const u16*)(u + U_VAT) + (size_t)((b * 4 + h) * 64) * SEQ;
  u16* Ks = (u16*)smem; u16* Vs = Ks + 2 * 64 * 72;
  bf16x8 qf[2][2];
#pragma unroll
  for (int mp = 0; mp < 2; ++mp)
#pragma unroll
    for (int s = 0; s < 2; ++s) qf[mp][s] = ld8(Q + (size_t)(q0 + l32) * 256 + mp * 32 + s * 16 + hh * 8);
  f32x16 O[2][2];
#pragma unroll
  for (int a = 0; a < 2; ++a)
#pragma unroll
    for (int c = 0; c < 2; ++c)
#pragma unroll
      for (int i = 0; i < 16; ++i) O[a][c][i] = 0.f;
  float mrun[2] = {-1e30f, -1e30f}, lrun[2] = {0.f, 0.f};
  const float sc = 0.17677669529663687f * LOG2E;
  const int nkt = 2 * (qblk + 1);
  const int r0 = tid >> 3, ch = tid & 7;
  u32x4 rk[2], rv[2];
#pragma unroll
  for (int i = 0; i < 2; ++i) {
    rk[i] = *(const u32x4*)(Kg + (size_t)(r0 + 32 * i) * 256 + ch * 8);
    rv[i] = *(const u32x4*)(Vg + (size_t)(r0 + 32 * i) * SEQ + ch * 8);
  }
#pragma unroll
  for (int i = 0; i < 2; ++i) { *(u32x4*)(Ks + (r0 + 32 * i) * 72 + ch * 8) = rk[i]; vperm_store(Vs + (r0 + 32 * i) * 72, ch, rv[i]); }
  __syncthreads();
  for (int kt = 0; kt < nkt; ++kt) {
    const int buf = kt & 1;
    if (kt + 1 < nkt) {
      const int k1 = (kt + 1) * 64;
#pragma unroll
      for (int i = 0; i < 2; ++i) {
        rk[i] = *(const u32x4*)(Kg + (size_t)(k1 + r0 + 32 * i) * 256 + ch * 8);
        rv[i] = *(const u32x4*)(Vg + (size_t)(r0 + 32 * i) * SEQ + k1 + ch * 8);
      }
    }
    __builtin_amdgcn_sched_barrier(0);
    const u16* Kb = Ks + buf * 64 * 72; const u16* Vb = Vs + buf * 64 * 72;
#pragma unroll
    for (int ks = 0; ks < 2; ++ks) {
      const int kb = kt * 64 + ks * 32;
      if (kb <= q0) {
        const bool diag = (kb == q0);
        bf16x8 vf[2][2];
#pragma unroll
        for (int mt = 0; mt < 2; ++mt)
#pragma unroll
          for (int s2 = 0; s2 < 2; ++s2) vf[mt][s2] = ld8(Vb + (mt * 32 + l32) * 72 + (ks * 2 + s2) * 16 + hh * 8);
#pragma unroll
        for (int mp = 0; mp < 2; ++mp) {
          f32x16 S;
#pragma unroll
          for (int i = 0; i < 16; ++i) S[i] = 0.f;
          S = MFMA32(ld8(Kb + (ks * 32 + l32) * 72 + mp * 32 + hh * 8), qf[mp][0], S);
          S = MFMA32(ld8(Kb + (ks * 32 + l32) * 72 + mp * 32 + 16 + hh * 8), qf[mp][1], S);
#pragma unroll
          for (int i = 0; i < 16; ++i) { const float v = S[i] * sc; S[i] = (diag && crow(i, hh) > l32) ? -1e30f : v; }
          float corr; bf16x8 pf0, pf1;
          softmax_tile(S, mrun[mp], lrun[mp], corr, pf0, pf1);
#pragma unroll
          for (int mt = 0; mt < 2; ++mt) {
#pragma unroll
            for (int i = 0; i < 16; ++i) O[mp][mt][i] *= corr;
            O[mp][mt] = MFMA32(vf[mt][0], pf0, O[mp][mt]);
            O[mp][mt] = MFMA32(vf[mt][1], pf1, O[mp][mt]);
          }
        }
      }
    }
    if (kt + 1 < nkt) {
      u16* Kn = Ks + (buf ^ 1) * 64 * 72; u16* Vn = Vs + (buf ^ 1) * 64 * 72;
#pragma unroll
      for (int i = 0; i < 2; ++i) { *(u32x4*)(Kn + (r0 + 32 * i) * 72 + ch * 8) = rk[i]; vperm_store(Vn + (r0 + 32 * i) * 72, ch, rv[i]); }
    }
    __syncthreads();
  }
  const float l0 = lrun[0] + __shfl_xor(lrun[0], 32), l1 = lrun[1] + __shfl_xor(lrun[1], 32);
  const float i0 = 1.f / l0, i1 = lam / l1;
  float ssq = 0.f;
#pragma unroll
  for (int mt = 0; mt < 2; ++mt)
#pragma unroll
    for (int i = 0; i < 16; ++i) { const float o = O[0][mt][i] * i0 - O[1][mt][i] * i1; O[0][mt][i] = o; ssq += o * o; }
  ssq += __shfl_xor(ssq, 32);
  const float rs = rsqrtf(ssq * (1.f / 64.f) + LN_EPS) * (1.f - lam_init);
  const float* gg = p.diff_g + L * 64;
  u16* om = (u16*)(u + U_OMIX) + (size_t)(b * SEQ + q0 + l32) * 1024 + h * 64;
#pragma unroll
  for (int mt = 0; mt < 2; ++mt)
#pragma unroll
    for (int g = 0; g < 4; ++g) {
      const int dv = mt * 32 + 8 * g + 4 * hh;
      store4bf(om + dv, O[0][mt][4 * g] * rs * gg[dv], O[0][mt][4 * g + 1] * rs * gg[dv + 1], O[0][mt][4 * g + 2] * rs * gg[dv + 2], O[0][mt][4 * g + 3] * rs * gg[dv + 3]);
    }
}

DI void mixB_block(const Params& p, int b, int h, int g, int sb, char* smem) {
  const int tid = ltid(), lane = tid & 63, w = tid >> 6, l32 = lane & 31, hh = lane >> 5;
  char* wsl_ = lws(p);
  char* u = wsl_ + OFF_UNION;
  const int rsh = 2 * g; const int r = 1 << rsh; const int sub_len = SEQ >> rsh; const int tpr = sub_len >> 5;
  const int rho = (sb * 4) / tpr, it0 = (sb * 4) % tpr; const int i0 = it0 * 32;
  const u16* Q = (const u16*)(u + U_QB) + (size_t)(b * SEQ) * 384 + h * 64;
  const u16* Kg = (const u16*)(u + U_KB) + (size_t)(b * SEQ) * 384 + h * 64;
  const u16* Vg = (const u16*)(u + U_VBT) + (size_t)g * MTOK * 384 + (size_t)((b * 6 + h) * 64) * SEQ + rho * sub_len;
  u16* Ks = (u16*)smem; u16* Vs = Ks + 256 * 72;
  const int kbase = i0 - 128;
#pragma unroll
  for (int i = 0; i < 8; ++i) {
    const int c = tid + 256 * i;
    { const int row = c >> 3, ch = c & 7; const int ki = kbase + row;
      if (ki >= 0) *(u32x4*)(Ks + row * 72 + ch * 8) = *(const u32x4*)(Kg + (size_t)(ki * r + rho) * 384 + ch * 8); }
    { const int dv = c >> 5, ch = c & 31; const int ki = kbase + ch * 8;
      if (ki >= 0) vperm_store(Vs + dv * 264, ch, *(const u32x4*)(Vg + (size_t)dv * SEQ + ki)); }
  }
  const int iq = i0 + w * 32;
  const int tq = (iq + l32) * r + rho;
  bf16x8 qf[4];
#pragma unroll
  for (int s = 0; s < 4; ++s) qf[s] = ld8(Q + (size_t)tq * 384 + s * 16 + hh * 8);
  __syncthreads();
  f32x16 O[2];
#pragma unroll
  for (int a = 0; a < 2; ++a)
#pragma unroll
    for (int i = 0; i < 16; ++i) O[a][i] = 0.f;
  float mrun = -1e30f, lrun = 0.f;
  const float sc = 0.125f * LOG2E;
  for (int kt = 0; kt < 5; ++kt) {
    const int lb = 32 * w + 32 * kt;
    if (kbase + lb < 0) continue;
    f32x16 S;
#pragma unroll
    for (int i = 0; i < 16; ++i) S[i] = 0.f;
#pragma unroll
    for (int s = 0; s < 4; ++s) S = MFMA32(ld8(Ks + (lb + l32) * 72 + s * 16 + hh * 8), qf[s], S);
#pragma unroll
    for (int i = 0; i < 16; ++i) {
      const float v = S[i] * sc; const int kk = crow(i, hh);
      const bool bad = (kt == 0 && kk < l32) || (kt == 4 && kk > l32);
      S[i] = bad ? -1e30f : v;
    }
    float corr; bf16x8 pf0, pf1;
    softmax_tile(S, mrun, lrun, corr, pf0, pf1);
#pragma unroll
    for (int mt = 0; mt < 2; ++mt) {
#pragma unroll
      for (int i = 0; i < 16; ++i) O[mt][i] *= corr;
      O[mt] = MFMA32(ld8(Vs + (mt * 32 + l32) * 264 + lb + hh * 8), pf0, O[mt]);
      O[mt] = MFMA32(ld8(Vs + (mt * 32 + l32) * 264 + lb + 16 + hh * 8), pf1, O[mt]);
    }
  }
  const float lt = lrun + __shfl_xor(lrun, 32);
  const float inv = 1.f / lt;
  const size_t tok = (size_t)b * SEQ + tq;
  u16* po = (u16*)(u + U_PBO) + (size_t)g * MTOK * 384 + tok * 384 + h * 64;
#pragma unroll
  for (int mt = 0; mt < 2; ++mt)
#pragma unroll
    for (int gq = 0; gq < 4; ++gq) {
      const int dv = mt * 32 + 8 * gq + 4 * hh;
      store4bf(po + dv, O[mt][4 * gq] * inv, O[mt][4 * gq + 1] * inv, O[mt][4 * gq + 2] * inv, O[mt][4 * gq + 3] * inv);
    }
  if (hh == 0) {
    float* lse = (float*)(wsl_ + OFF_LSE) + (size_t)g * MTOK * 8;
    lse[tok * 8 + h] = (mrun + __builtin_amdgcn_logf(lt)) * LN2;
  }
  __syncthreads();
}

DI void gla_item(const Params& p, int L, int b, int h, int vg, char* smem) {
  const int tid = ltid(), lane = tid & 63, w = tid >> 6;
  char* wsl_ = lws(p);
  const int kg = lane & 15, vl = lane >> 4;
  char* u = wsl_ + OFF_UNION;
  const u16* hc = (const u16*)(u + U_HC);
  const float* rc = (const float*)(wsl_ + OFF_RC);
  float* go = (float*)(u + U_GLAO);
  float* a_s = (float*)smem;
  float* k_s = a_s + 64 * 48;
  float* q_s = k_s + 64 * 48;
  float* vs = q_s + 64 * 48;
  float* os = vs + 64 * 16;
  float* rcs = os + 64 * 16;
  float wcol[16]; float ba = 0.f;
  const int sd = tid % 48, stg = tid / 48;
  if (tid < 192) {
#pragma unroll
    for (int j = 0; j < 16; ++j) wcol[j] = p.gla_wa2[(size_t)L * 16 * 192 + j * 192 + h * 48 + sd];
    ba = p.gla_ba[L * 192 + h * 48 + sd];
  } else {
#pragma unroll
    for (int j = 0; j < 16; ++j) wcol[j] = 0.f;
  }
  float S0 = 0.f, S1 = 0.f, S2 = 0.f;
  const float qsc = 0.14433756729740643f;
  float4 rcv; u32x2 qv[3], kv[3], vv;
  const int t4 = tid >> 2, p4 = tid & 3;
  {
    const size_t rowb = (size_t)b * SEQ;
    rcv = *(const float4*)(rc + (rowb + t4) * 16 + p4 * 4);
#pragma unroll
    for (int i = 0; i < 3; ++i) { const int c = tid + 256 * i; const int tk = c / 12, pt = c % 12; qv[i] = *(const u32x2*)(hc + (rowb + tk) * 1152 + h * 48 + pt * 4); kv[i] = *(const u32x2*)(hc + (rowb + tk) * 1152 + 192 + h * 48 + pt * 4); }
    vv = *(const u32x2*)(hc + (rowb + t4) * 1152 + 384 + h * 96 + vg * 16 + p4 * 4);
  }
  for (int seg = 0; seg < SEQ / 64; ++seg) {
    const size_t rowb = (size_t)b * SEQ + seg * 64;
    *(float4*)(rcs + t4 * 16 + p4 * 4) = rcv;
#pragma unroll
    for (int i = 0; i < 3; ++i) {
      const int c = tid + 256 * i; const int tk = c / 12, pt = c % 12; const int o = tk * 48 + pt * 4;
      *(float4*)(k_s + o) = make_float4(__uint_as_float(kv[i][0] << 16), __uint_as_float(kv[i][0] & 0xffff0000u), __uint_as_float(kv[i][1] << 16), __uint_as_float(kv[i][1] & 0xffff0000u));
      *(float4*)(q_s + o) = make_float4(__uint_as_float(qv[i][0] << 16) * qsc, __uint_as_float(qv[i][0] & 0xffff0000u) * qsc, __uint_as_float(qv[i][1] << 16) * qsc, __uint_as_float(qv[i][1] & 0xffff0000u) * qsc);
    }
    {
      float4 vf4 = make_float4(__uint_as_float(vv[0] << 16), __uint_as_float(vv[0] & 0xffff0000u), __uint_as_float(vv[1] << 16), __uint_as_float(vv[1] & 0xffff0000u));
      *(float4*)(vs + t4 * 16 + p4 * 4) = vf4;
    }
    __syncthreads();
    if (seg + 1 < SEQ / 64) {
      const size_t rn = rowb + 64;
      rcv = *(const float4*)(rc + (rn + t4) * 16 + p4 * 4);
#pragma unroll
      for (int i = 0; i < 3; ++i) { const int c = tid + 256 * i; const int tk = c / 12, pt = c % 12; qv[i] = *(const u32x2*)(hc + (rn + tk) * 1152 + h * 48 + pt * 4); kv[i] = *(const u32x2*)(hc + (rn + tk) * 1152 + 192 + h * 48 + pt * 4); }
      vv = *(const u32x2*)(hc + (rn + t4) * 1152 + 384 + h * 96 + vg * 16 + p4 * 4);
    }
    __builtin_amdgcn_sched_barrier(0);
    if (tid < 192) {
#pragma unroll 4
      for (int tt = 0; tt < 16; ++tt) {
        const int tl = stg * 16 + tt;
        const float4* r4 = (const float4*)(rcs + tl * 16);
        float z = ba;
#pragma unroll
        for (int j4 = 0; j4 < 4; ++j4) { const float4 rv = r4[j4]; z += rv.x * wcol[4 * j4] + rv.y * wcol[4 * j4 + 1] + rv.z * wcol[4 * j4 + 2] + rv.w * wcol[4 * j4 + 3]; }
        const float a = ex2(-0.0625f * __builtin_amdgcn_logf(1.f + ex2(-z * LOG2E)));
        a_s[tl * 48 + sd] = a;
      }
    }
    __syncthreads();
#pragma unroll 1
    for (int tb = 0; tb < 64; tb += 16) {
      float okeep = 0.f;
#pragma unroll
      for (int tt = 0; tt < 16; ++tt) {
        const int tl = tb + tt;
        const int o3 = tl * 48 + kg * 3;
        const float a0 = a_s[o3], a1 = a_s[o3 + 1], a2 = a_s[o3 + 2];
        const float k0_ = k_s[o3], k1_ = k_s[o3 + 1], k2_ = k_s[o3 + 2];
        const float q0_ = q_s[o3], q1_ = q_s[o3 + 1], q2_ = q_s[o3 + 2];
        const float v = vs[tl * 16 + w * 4 + vl];
        S0 = a0 * S0 + k0_ * v; S1 = a1 * S1 + k1_ * v; S2 = a2 * S2 + k2_ * v;
        float o = q0_ * S0 + q1_ * S1 + q2_ * S2;
        o = row16_allsum(o);
        okeep = (kg == tt) ? o : okeep;
      }
      os[(tb + kg) * 16 + w * 4 + vl] = okeep;
    }
    __syncthreads();
    {
      const float4 ov = *(const float4*)(os + t4 * 16 + p4 * 4);
      *(float4*)(go + (rowb + t4) * 384 + h * 96 + vg * 16 + p4 * 4) = ov;
    }
  }
  __syncthreads();
}

DI int perm16(int t) { return (t & ~12) | ((t & 4) << 1) | ((t & 8) >> 1); }
DI void gla_mfma_item(const Params& p, int L, int b, int h, char* smem) {
  const int tid = ltid(), lane = tid & 63, w = tid >> 6, l32 = lane & 31, hh = lane >> 5;
  char* wsl_ = lws(p);
  char* u = wsl_ + OFF_UNION;
  const u16* hc = (const u16*)(u + U_HC);
  const float* rc = (const float*)(wsl_ + OFF_RC);
  float* go = (float*)(u + U_GLAO);
  u16* Qb = (u16*)smem;
  u16* QbP = Qb + 32 * 56;
  u16* Kb = QbP + 32 * 56;
  u16* KlT = Kb + 32 * 56;
  u16* Vt = KlT + 64 * 40;
  float* ebl = (float*)(Vt + 96 * 40);
  float* tot = ebl + 64;
  float* rcs = tot + 4 * 48;
  const int sd = tid % 48, stg = tid / 48;
  float wcol[16]; float ba = 0.f;
#pragma unroll
  for (int j = 0; j < 16; ++j) wcol[j] = (tid < 192) ? p.gla_wa2[(size_t)L * 16 * 192 + j * 192 + h * 48 + sd] : 0.f;
  if (tid < 192) ba = p.gla_ba[L * 192 + h * 48 + sd];
  for (int i = tid; i < 16 * 40; i += NTHR) KlT[48 * 40 + i] = 0;
  if (tid < 64) ebl[tid] = 0.f;
  f32x16 S0, S1;
#pragma unroll
  for (int i = 0; i < 16; ++i) { S0[i] = 0.f; S1[i] = 0.f; }
  const float qsc = 0.14433756729740643f;
  const int sdc = sd < 48 ? sd : 0;
  u16 rq[8], rk[8], rvv[12]; float rr[2];
  const size_t row00 = (size_t)b * SEQ;
  const unsigned oqk = (unsigned)((stg & 3) * 8) * 1152u + (unsigned)(h * 48 + sdc);
#define GL_LOAD(rowb) { const u16* hcb_ = hc + (rowb) * 1152; const float* rcb_ = rc + (rowb) * 16; \
    _Pragma("unroll") for (int tt = 0; tt < 8; ++tt) { rq[tt] = hcb_[oqk + (unsigned)tt * 1152u]; rk[tt] = hcb_[oqk + (unsigned)tt * 1152u + 192u]; } \
    _Pragma("unroll") for (int i = 0; i < 12; ++i) { const unsigned e_ = (unsigned)(tid + 256 * i); rvv[i] = hcb_[(e_ / 96u) * 1152u + 384u + (unsigned)(h * 96) + e_ % 96u]; } \
    _Pragma("unroll") for (int i = 0; i < 2; ++i) rr[i] = rcb_[tid + 256 * i]; }
  GL_LOAD(row00)
  for (int ch = 0; ch < SEQ / 32; ++ch) {
    const size_t rowb = row00 + ch * 32;
    rcs[tid] = rr[0]; rcs[tid + 256] = rr[1];
#pragma unroll
    for (int i = 0; i < 12; ++i) { const int e_ = tid + 256 * i; Vt[(e_ % 96) * 40 + perm16(e_ / 96)] = rvv[i]; }
    __syncthreads();
    float c2[8]; float run = 0.f;
    if (tid < 192) {
#pragma unroll
      for (int tt = 0; tt < 8; ++tt) {
        const float4* r4 = (const float4*)(rcs + (stg * 8 + tt) * 16);
        float z = ba;
#pragma unroll
        for (int j4 = 0; j4 < 4; ++j4) { const float4 rv = r4[j4]; z += rv.x * wcol[4 * j4] + rv.y * wcol[4 * j4 + 1] + rv.z * wcol[4 * j4 + 2] + rv.w * wcol[4 * j4 + 3]; }
        run += -0.0625f * __builtin_amdgcn_logf(1.f + ex2(-z * LOG2E));
        c2[tt] = run;
      }
      tot[stg * 48 + sd] = run;
    } else {
#pragma unroll
      for (int tt = 0; tt < 8; ++tt) c2[tt] = 0.f;
    }
    __syncthreads();
    if (tid < 192) {
      const float t0 = tot[sd], t1 = tot[48 + sd], t2 = tot[96 + sd], t3 = tot[144 + sd];
      const float pre = (stg > 0 ? t0 : 0.f) + (stg > 1 ? t1 : 0.f) + (stg > 2 ? t2 : 0.f);
      const float blast = (t0 + t1) + (t2 + t3);
      if (stg == 0) ebl[sd] = ex2(blast);
#pragma unroll
      for (int tt = 0; tt < 8; ++tt) {
        const int t = stg * 8 + tt; const float b2 = pre + c2[tt];
        const float q = bf2f(rq[tt]) * qsc, k = bf2f(rk[tt]);
        const u16 qb = f2bf(q * ex2(b2));
        Qb[t * 56 + sd] = qb; QbP[t * 56 + perm16(sd)] = qb;
        Kb[t * 56 + sd] = f2bf(k * ex2(-b2));
        KlT[sd * 40 + perm16(t)] = f2bf(k * ex2(blast - b2));
      }
    }
    __syncthreads();
    {
      const size_t rn = row00 + (ch + 1 < SEQ / 32 ? ch + 1 : ch) * 32;
      GL_LOAD(rn)
    }
    __builtin_amdgcn_sched_barrier(0);
    if (w < 3) {
      f32x16 AT;
#pragma unroll
      for (int i = 0; i < 16; ++i) AT[i] = 0.f;
#pragma unroll
      for (int s3 = 0; s3 < 3; ++s3) AT = MFMA32(ld8(Kb + l32 * 56 + s3 * 16 + hh * 8), ld8(Qb + l32 * 56 + s3 * 16 + hh * 8), AT);
#pragma unroll
      for (int i = 0; i < 16; ++i) AT[i] = (crow(i, hh) <= l32) ? AT[i] : 0.f;
      const bf16x8 pA0 = pack8(AT[0], AT[1], AT[2], AT[3], AT[4], AT[5], AT[6], AT[7]);
      const bf16x8 pA1 = pack8(AT[8], AT[9], AT[10], AT[11], AT[12], AT[13], AT[14], AT[15]);
      const bf16x8 vf0 = ld8(Vt + (32 * w + l32) * 40 + hh * 8), vf1 = ld8(Vt + (32 * w + l32) * 40 + 16 + hh * 8);
      f32x16 OT;
#pragma unroll
      for (int i = 0; i < 16; ++i) OT[i] = 0.f;
      OT = MFMA32(vf0, pA0, OT);
      OT = MFMA32(vf1, pA1, OT);
      const bf16x8 sa0 = pack8(S0[0], S0[1], S0[2], S0[3], S0[4], S0[5], S0[6], S0[7]);
      const bf16x8 sa1 = pack8(S0[8], S0[9], S0[10], S0[11], S0[12], S0[13], S0[14], S0[15]);
      const bf16x8 sa2 = pack8(S1[0], S1[1], S1[2], S1[3], S1[4], S1[5], S1[6], S1[7]);
      OT = MFMA32(sa0, ld8(QbP + l32 * 56 + hh * 8), OT);
      OT = MFMA32(sa1, ld8(QbP + l32 * 56 + 16 + hh * 8), OT);
      OT = MFMA32(sa2, ld8(QbP + l32 * 56 + 32 + hh * 8), OT);
      float* od = go + (rowb + l32) * 384 + h * 96 + 32 * w + 4 * hh;
#pragma unroll
      for (int g = 0; g < 4; ++g) *(float4*)(od + 8 * g) = make_float4(OT[4 * g], OT[4 * g + 1], OT[4 * g + 2], OT[4 * g + 3]);
#pragma unroll
      for (int i = 0; i < 16; ++i) { S0[i] *= ebl[crow(i, hh)]; S1[i] *= ebl[32 + crow(i, hh)]; }
      S0 = MFMA32(ld8(KlT + l32 * 40 + hh * 8), vf0, S0);
      S0 = MFMA32(ld8(KlT + l32 * 40 + 16 + hh * 8), vf1, S0);
      S1 = MFMA32(ld8(KlT + (32 + l32) * 40 + hh * 8), vf0, S1);
      S1 = MFMA32(ld8(KlT + (32 + l32) * 40 + 16 + hh * 8), vf1, S1);
    }
    __syncthreads();
  }
#undef GL_LOAD
}

DI void xattn_block(const Params& p, int L, int b, int h, int qb64, char* smem) {
  const int tid = ltid(), lane = tid & 63, w = tid >> 6, l32 = lane & 31, hh = lane >> 5;
  char* wsl_ = lws(p);
  const int qt2 = w >> 1, dvh = w & 1;
  char* u = wsl_ + OFF_UNION;
  const u16* Qg = (const u16*)(u + U_QXA) + (size_t)(b * SEQ + qb64 * 64) * 1024 + h * 256;
  const u16* Kg = (const u16*)(wsl_ + OFF_KXA) + (size_t)L * 2048 * 1024 + (size_t)(b * 256) * 1024 + h * 256;
  const u16* Vg = (const u16*)(wsl_ + OFF_VXAT) + (size_t)L * 2048 * 1024 + (size_t)(b * 1024 + h * 256) * 256;
  u16* Qs = (u16*)smem; u16* Ks = Qs + 64 * 264; u16* Vs = Ks + 32 * 264;
  {
    u32x4 t8[8];
#pragma unroll
    for (int i = 0; i < 8; ++i) { const int c = tid + 256 * i; t8[i] = *(const u32x4*)(Qg + (size_t)(c >> 5) * 1024 + (c & 31) * 8); }
#pragma unroll
    for (int i = 0; i < 8; ++i) { const int c = tid + 256 * i; *(u32x4*)(Qs + (c >> 5) * 264 + (c & 31) * 8) = t8[i]; }
  }
  u32x4 rk[4], rk2[4], rv[4];
#pragma unroll
  for (int i = 0; i < 4; ++i) {
    const int c = tid + 256 * i;
    rk[i] = *(const u32x4*)(Kg + (size_t)(c >> 5) * 1024 + (c & 31) * 8);
    rv[i] = *(const u32x4*)(Vg + (size_t)(c >> 2) * 256 + (c & 3) * 8);
    rk2[i] = *(const u32x4*)(Kg + (size_t)(32 + (c >> 5)) * 1024 + (c & 31) * 8);
  }
  f32x16 O[4];
#pragma unroll
  for (int a = 0; a < 4; ++a)
#pragma unroll
    for (int i = 0; i < 16; ++i) O[a][i] = 0.f;
  float mrun = -1e30f, lrun = 0.f;
  const float sc = 0.0625f * LOG2E;
#pragma unroll 1
  for (int kt = 0; kt < 8; ++kt) {
#pragma unroll
    for (int i = 0; i < 4; ++i) {
      const int c = tid + 256 * i;
      *(u32x4*)(Ks + (c >> 5) * 264 + (c & 31) * 8) = rk[i];
      vperm_store(Vs + (c >> 2) * 40, c & 3, rv[i]);
    }
    __syncthreads();
    {
      const int k1 = (kt < 7 ? kt + 1 : 7) * 32, k2 = (kt < 6 ? kt + 2 : 7) * 32;
#pragma unroll
      for (int i = 0; i < 4; ++i) {
        const int c = tid + 256 * i;
        rk[i] = rk2[i];
        rk2[i] = *(const u32x4*)(Kg + (size_t)(k2 + (c >> 5)) * 1024 + (c & 31) * 8);
        rv[i] = *(const u32x4*)(Vg + (size_t)(c >> 2) * 256 + k1 + (c & 3) * 8);
      }
    }
    __builtin_amdgcn_sched_barrier(0);
    f32x16 S;
#pragma unroll
    for (int i = 0; i < 16; ++i) S[i] = 0.f;
#pragma unroll
    for (int s = 0; s < 16; ++s) S = MFMA32(ld8(Ks + l32 * 264 + s * 16 + hh * 8), ld8(Qs + (qt2 * 32 + l32) * 264 + s * 16 + hh * 8), S);
#pragma unroll
    for (int i = 0; i < 16; ++i) S[i] *= sc;
    float corr; bf16x8 pf0, pf1;
    softmax_tile(S, mrun, lrun, corr, pf0, pf1);
#pragma unroll
    for (int mt = 0; mt < 4; ++mt) {
#pragma unroll
      for (int i = 0; i < 16; ++i) O[mt][i] *= corr;
      O[mt] = MFMA32(ld8(Vs + (dvh * 128 + mt * 32 + l32) * 40 + hh * 8), pf0, O[mt]);
      O[mt] = MFMA32(ld8(Vs + (dvh * 128 + mt * 32 + l32) * 40 + 16 + hh * 8), pf1, O[mt]);
    }
    __syncthreads();
  }
  const float lt = lrun + __shfl_xor(lrun, 32);
  const float inv = 1.f / lt;
  u16* od = (u16*)(u + U_OMIX) + (size_t)(b * SEQ + qb64 * 64 + qt2 * 32 + l32) * 1024 + h * 256 + dvh * 128;
#pragma unroll
  for (int mt = 0; mt < 4; ++mt)
#pragma unroll
    for (int g = 0; g < 4; ++g) store4bf(od + mt * 32 + 8 * g + 4 * hh, O[mt][4 * g] * inv, O[mt][4 * g + 1] * inv, O[mt][4 * g + 2] * inv, O[mt][4 * g + 3] * inv);
}

DI void ln_row(float4 (&v)[4], const float4 (&gv)[4], const float4 (&bv)[4], float& mean_o, float& rstd_o) {
  float s = 0.f, q = 0.f;
#pragma unroll
  for (int j = 0; j < 4; ++j) { s += v[j].x + v[j].y + v[j].z + v[j].w; q += v[j].x * v[j].x + v[j].y * v[j].y + v[j].z * v[j].z + v[j].w * v[j].w; }
#pragma unroll
  for (int o = 32; o > 0; o >>= 1) { s += __shfl_xor(s, o); q += __shfl_xor(q, o); }
  const float mean = s * (1.f / 1024.f);
  const float var = fmaxf(q * (1.f / 1024.f) - mean * mean, 0.f);
  const float rstd = rsqrtf(var + LN_EPS);
  mean_o = mean; rstd_o = rstd;
#pragma unroll
  for (int j = 0; j < 4; ++j) {
    v[j].x = (v[j].x - mean) * rstd * gv[j].x + bv[j].x; v[j].y = (v[j].y - mean) * rstd * gv[j].y + bv[j].y;
    v[j].z = (v[j].z - mean) * rstd * gv[j].z + bv[j].z; v[j].w = (v[j].w - mean) * rstd * gv[j].w + bv[j].w;
  }
}
#define LN_LOAD_GB(g, bb) float4 gv[4], bv[4]; _Pragma("unroll") for (int j = 0; j < 4; ++j) { gv[j] = *(const float4*)((g) + j * 256 + lane * 4); bv[j] = *(const float4*)((bb) + j * 256 + lane * 4); }
#define LN_LOAD_ROW(dst, row) { _Pragma("unroll") for (int j = 0; j < 4; ++j) dst[j] = *(const float4*)(y + (size_t)(row) * 1024 + j * 256 + lane * 4); }
#define LN_STORE_ROW(v, row) { _Pragma("unroll") for (int j = 0; j < 4; ++j) { \
    u32x2 o_ = {pack2(v[j].x, v[j].y), pack2(v[j].z, v[j].w)}; *(u32x2*)(xbf + (size_t)(row) * 1024 + j * 256 + lane * 4) = o_; } \
    if (lane == 0) *(float2*)(lnstats + (size_t)(row) * 2) = make_float2(mean_, rstd_); }

DI unsigned bar_ld(unsigned* q) { return __hip_atomic_load(q, __ATOMIC_RELAXED, __HIP_MEMORY_SCOPE_AGENT); }
DI unsigned bar_add(unsigned* q, unsigned v) { return __hip_atomic_fetch_add(q, v, __ATOMIC_RELAXED, __HIP_MEMORY_SCOPE_AGENT); }
template <class P_> DI void gbar(const P_& p, unsigned round) {
  asm volatile("s_waitcnt vmcnt(0)" ::: "memory");
  __syncthreads();
  if (threadIdx.x == 0) {
    unsigned* bar = (unsigned*)(lws(p) + OFF_BAR);
    __builtin_amdgcn_fence(__ATOMIC_RELEASE, "agent");
    asm volatile("s_waitcnt vmcnt(0)" ::: "memory");
    const unsigned g = blockIdx.x & 7u, nloc = gridDim.x >> 3;
    const unsigned old = bar_add(bar + 64 * g, 1u);
    if (old + 1u == round * nloc) {
      const unsigned o2 = bar_add(bar + 64 * 8, 1u);
      if (o2 + 1u == round * 8u) {
#pragma unroll
        for (int j = 0; j < 8; ++j) bar_add(bar + 64 * (9 + j), 1u);
      }
    }
    while (bar_ld(bar + 64 * (9 + g)) < round) __builtin_amdgcn_s_sleep(1);
    __builtin_amdgcn_fence(__ATOMIC_ACQUIRE, "agent");
    asm volatile("s_waitcnt vmcnt(0)" ::: "memory");
  }
  __syncthreads();
}

DI bool st_tile(int i, int xcd, int nM, int nN, int NB, int& mt, int& nt) {
  const int T = 8 * NB; const int sl = i / T, within = i % T; const int st = sl * 8 + xcd;
  const int SM = nM >> 3; const int S = SM * (nN / NB);
  if (st >= S) return false;
  const int sm = st % SM, sn = st / SM;
  mt = sm * 8 + (within & 7); nt = sn * NB + (within >> 3);
  return true;
}

__global__ void __launch_bounds__(NTHR, 2) mega(Params p) {
  cg::grid_group grid = cg::this_grid();
  __shared__ __attribute__((aligned(16))) char smem[SMEM_BYTES];
  __shared__ int s_item;
  __shared__ int s_cnt[8];
  __shared__ int s_base[8];
  const int nblk = gridDim.x, blk = blockIdx.x;
  const int nwave = nblk * 4;

#ifdef PROBE_SYNCS
  for (int q_ = 0; q_ < PROBE_SYNCS; ++q_) grid.sync();
#endif
  for (int rep_ = 0; rep_ < REP(0); ++rep_) {
    PH_IDS
    {
      Job jb; int lt; float v[16];
      int t = blk;
      get_job(p, t < TR_TILES ? t : TR_TILES - 1, jb, lt);
      tr_load(jb, lt, v);
      while (t < TR_TILES) {
        const int t2 = t + nblk;
        Job jb2; int lt2; float v2[16];
        get_job(p, t2 < TR_TILES ? t2 : TR_TILES - 1, jb2, lt2);
        tr_load(jb2, lt2, v2);
        __builtin_amdgcn_sched_barrier(0);
        tr_store(jb, lt, v, (float*)smem);
        jb = jb2; lt = lt2;
#pragma unroll
        for (int i = 0; i < 16; ++i) v[i] = v2[i];
        t = t2;
      }
    }
    const size_t gt = (size_t)blk * NTHR + tid, gn = (size_t)nblk * NTHR;
    for (size_t i = gt; i < (size_t)MTOK * 1024 / 4; i += gn) {
      const float4 v = ((const float4*)p.x)[i]; u32x2 o = {pack2(v.x, v.y), pack2(v.z, v.w)}; ((u32x2*)xbf)[i] = o;
    }
    u16* membf = (u16*)(ws + OFF_MEMBF);
    for (size_t i = gt; i < (size_t)2048 * 1024 / 4; i += gn) {
      const float4 v = ((const float4*)p.mem)[i]; u32x2 o = {pack2(v.x, v.y), pack2(v.z, v.w)}; ((u32x2*)membf)[i] = o;
    }
    float* rope = (float*)(ws + OFF_ROPE);
    for (size_t i = gt; i < (size_t)MTOK * 12; i += gn) {
      const int tok = (int)(i / 12), f = (int)(i % 12);
      const float ps = (float)p.pos[tok];
      const float ang = ps * (f < 4 ? p.invfA[f] : p.invfB[f - 4]);
      float c, s; sincos_acc(ang, c, s);
      if (f < 4) { rope[tok * 24 + f] = c; rope[tok * 24 + 4 + f] = s; }
      else { rope[tok * 24 + 8 + (f - 4)] = c; rope[tok * 24 + 16 + (f - 4)] = s; }
    }
    if (blk == 0 && tid < 64) ctr[tid] = 0;
    if (blk == 0) { unsigned* bw = (unsigned*)(ws + OFF_BAR); for (int i = tid; i < 2048; i += NTHR) bw[i] = 0u; }
    if (rep_ + 1 < REP(0)) grid.sync();
  }
  grid.sync();
  unsigned bar_round = 0;
#ifdef PROBE_GBAR
  for (int q_ = 0; q_ < PROBE_GBAR; ++q_) gbar(p, ++bar_round);
#endif

  for (int L = 0; L < 2; ++L) {
    for (int rep_ = 0; rep_ < REP(1); ++rep_) {
      PH_IDS
      const int nin = 128 * 25; const int ntot = nin + (L == 0 ? 512 : 0);
      EpiIn ein{u, (const float*)(ws + OFF_ROPE), (float*)(ws + OFF_RC)};
      (void)nin; (void)ntot;
      const int xcd = blk & 7, jb = blk >> 3, nb8 = nblk >> 3;
      for (int i = jb; ; i += nb8) {
        int mt, nt;
        if (i < 400) {
          if (!st_tile(i, xcd, 128, 25, 5, mt, nt)) break;
          gemm_tile(RowPlain{xbf, 1024}, (const u16*)(ws + OFF_WT_IN) + (size_t)L * INP * 1024, 1024, 1024, mt * 128, nt * 128, (u16*)smem, ein);
        } else {
          if (L != 0 || i >= 432) break;
          const int l2 = (i - 400) >> 4;
          if (!st_tile((i - 400) & 15, xcd, 16, 8, 1, mt, nt)) break;
          EpiKV ekv{(u16*)(ws + OFF_KXA) + (size_t)l2 * 2048 * 1024, (u16*)(ws + OFF_VXAT) + (size_t)l2 * 2048 * 1024};
          gemm_tile256(RowPlain{(const u16*)(ws + OFF_MEMBF), 1024}, (const u16*)(ws + OFF_WT_KV) + (size_t)l2 * 2048 * 1024, 1024, 1024, mt * 128, nt * 256, (u16*)smem, ekv);
        }
      }
      if (rep_ + 1 < REP(1)) gbar(p, ++bar_round);
    }
    gbar(p, ++bar_round);
    for (int rep_ = 0; rep_ < REP(2); ++rep_) {
      PH_IDS
      float lam;
      {
        float a1 = 0.f, a2 = 0.f;
        for (int i = 0; i < 32; ++i) { a1 += p.lam_q1[L * 32 + i] * p.lam_k1[L * 32 + i]; a2 += p.lam_q2[L * 32 + i] * p.lam_k2[L * 32 + i]; }
        lam = expf(a1) - expf(a2) + p.lam_init[L];
      }
      const int total = 32 + 512 + 2304;
      while (true) {
        if (tid == 0) s_item = atomicAdd(&ctr[L + 2 * rep_], 1);
        __syncthreads();
        const int item = s_item;
        __syncthreads();
        if (item >= total) break;
#ifdef PROBE_SUB
        if (rep_ == 1) { const int kind = item < 32 ? 1 : (item < 544 ? 2 : 3); if (kind != PROBE_SUB) continue; }
#endif
        if (item < 32) {
          __builtin_amdgcn_s_setprio(3);
          gla_mfma_item(p, L, item >> 2, item & 3, smem);
          __builtin_amdgcn_s_setprio(0);
        } else if (item < 544) {
          const int a = item - 32; const int qblk = 15 - (a >> 5), bh = a & 31;
          mixA_block(p, L, bh >> 2, bh & 3, qblk, lam, p.lam_init[L], smem);
        } else {
          const int bi = item - 544; const int g = bi / 768, rem = bi % 768; const int bh = rem >> 4, sb = rem & 15;
          mixB_block(p, bh / 6, bh % 6, g, sb, smem);
        }
      }
      if (rep_ + 1 < REP(2)) gbar(p, ++bar_round);
    }
    gbar(p, ++bar_round);
    for (int rep_ = 0; rep_ < REP(3); ++rep_) {
      PH_IDS
      const float* lse = (const float*)(ws + OFF_LSE);
      const u16* pbo = (const u16*)(u + U_PBO); const float* go = (const float*)(u + U_GLAO); const u16* hc = (const u16*)(u + U_HC);
      u16* om = (u16*)(u + U_OMIX);
      const float* gg = p.gla_g + L * 96;
      for (int tok0 = gwave; tok0 < MTOK; tok0 += nwave) {
        int tok = tok0; asm volatile("" : "+v"(tok));
#pragma unroll
        for (int hd = 0; hd < 6; ++hd) {
          const float l0 = lse[(size_t)tok * 8 + hd], l1 = lse[(size_t)MTOK * 8 + (size_t)tok * 8 + hd], l2 = lse[(size_t)2 * MTOK * 8 + (size_t)tok * 8 + hd];
          const float mx = fmaxf(l0, fmaxf(l1, l2));
          const float w0 = __expf(l0 - mx), w1 = __expf(l1 - mx), w2 = __expf(l2 - mx);
          const float inv = 1.f / (w0 + w1 + w2);
          const size_t o = (size_t)tok * 384 + hd * 64 + lane;
          const float v = (w0 * bf2f(pbo[o]) + w1 * bf2f(pbo[(size_t)MTOK * 384 + o]) + w2 * bf2f(pbo[(size_t)2 * MTOK * 384 + o])) * inv;
          om[(size_t)tok * 1024 + 256 + hd * 64 + lane] = f2bf(v);
        }
#pragma unroll
        for (int hd = 0; hd < 4; ++hd) {
          const float o0 = go[(size_t)tok * 384 + hd * 96 + lane];
          const float o1 = lane < 32 ? go[(size_t)tok * 384 + hd * 96 + 64 + lane] : 0.f;
          const float ssq = wave_sum(o0 * o0 + o1 * o1);
          const float rs = rsqrtf(ssq * (1.f / 96.f) + LN_EPS);
          const float g0 = bf2f(hc[(size_t)tok * 1152 + 768 + hd * 96 + lane]);
          om[(size_t)tok * 1024 + 640 + hd * 96 + lane] = f2bf(o0 * rs * gg[lane] * (g0 / (1.f + __expf(-g0))));
          if (lane < 32) {
            const float g1 = bf2f(hc[(size_t)tok * 1152 + 768 + hd * 96 + 64 + lane]);
            om[(size_t)tok * 1024 + 640 + hd * 96 + 64 + lane] = f2bf(o1 * rs * gg[64 + lane] * (g1 / (1.f + __expf(-g1))));
          }
        }
      }
      if (rep_ + 1 < REP(3)) gbar(p, ++bar_round);
    }
    gbar(p, ++bar_round);
    for (int rep_ = 0; rep_ < REP(4); ++rep_) {
      PH_IDS
      EpiResidT er{L == 0 ? p.x : (const float*)y, lnstats, p.ln_ffn_g, p.ln_ffn_b, y, L};
      for (int i = blk >> 3; ; i += nblk >> 3) {
        int mt, nt; if (!st_tile(i, blk & 7, 128, 8, 8, mt, nt)) break;
        gemm_tile_sw(RowPlain{(const u16*)(u + U_OMIX), 1024}, (const u16*)(ws + OFF_WT_OUT) + (size_t)L * 1024 * 1024, 1024, 1024, mt * 128, nt * 128, (u16*)smem, er);
      }
      if (rep_ + 1 < REP(4)) gbar(p, ++bar_round);
    }
    gbar(p, ++bar_round);
    for (int rep_ = 0; rep_ < REP(5); ++rep_) {
      PH_IDS
      const float* g = p.ln_mix_g + L * 1024; const float* bb = p.ln_mix_b + L * 1024;
      LN_LOAD_GB(g, bb)
      float4 v[4], nx[4];
      int row = gwave;
      LN_LOAD_ROW(v, (row < MTOK ? row : MTOK - 1))
      while (row < MTOK) {
        const int r2 = row + nwave;
        LN_LOAD_ROW(nx, (r2 < MTOK ? r2 : MTOK - 1))
        __builtin_amdgcn_sched_barrier(0);
        float mean_, rstd_; ln_row(v, gv, bv, mean_, rstd_);
        LN_STORE_ROW(v, row)
#pragma unroll
        for (int j = 0; j < 4; ++j) v[j] = nx[j];
        row = r2;
      }
      if (rep_ + 1 < REP(5)) gbar(p, ++bar_round);
    }
    gbar(p, ++bar_round);
    for (int rep_ = 0; rep_ < REP(6); ++rep_) {
      PH_IDS
      EpiBfT eq{(u16*)(u + U_QXA), 1024};
      for (int i = blk >> 3; ; i += nblk >> 3) {
        int mt, hd; if (!st_tile(i, blk & 7, 128, 4, 4, mt, hd)) break;
        gemm_tile_sw(RowPlain{xbf, 1024}, (const u16*)(ws + OFF_WT_Q) + (size_t)L * 1024 * 1024, 1024, 1024, mt * 128, hd * 256, (u16*)smem, eq);
        gemm_tile_sw(RowPlain{xbf, 1024}, (const u16*)(ws + OFF_WT_Q) + (size_t)L * 1024 * 1024, 1024, 1024, mt * 128, hd * 256 + 128, (u16*)smem, eq);
        asm volatile("s_waitcnt vmcnt(0)" ::: "memory");
        __syncthreads();
        xattn_block(p, L, mt >> 4, hd, (mt & 15) * 2, smem);
        xattn_block(p, L, mt >> 4, hd, (mt & 15) * 2 + 1, smem);
      }
      if (rep_ + 1 < REP(6)) gbar(p, ++bar_round);
    }
    gbar(p, ++bar_round);
    for (int rep_ = 0; rep_ < REP(8); ++rep_) {
      PH_IDS
      EpiResidT er{y, lnstats, p.ln_mix_g + L * 1024, p.ln_mix_b + L * 1024, y, 1};
      for (int i = blk >> 3; ; i += nblk >> 3) {
        int mt, nt; if (!st_tile(i, blk & 7, 128, 8, 8, mt, nt)) break;
        gemm_tile_sw(RowPlain{(const u16*)(u + U_OMIX), 1024}, (const u16*)(ws + OFF_WT_O) + (size_t)L * 1024 * 1024, 1024, 1024, mt * 128, nt * 128, (u16*)smem, er);
      }
      if (rep_ + 1 < REP(8)) gbar(p, ++bar_round);
    }
    gbar(p, ++bar_round);
    for (int rep_ = 0; rep_ < REP(9); ++rep_) {
      PH_IDS
      const float* g = p.ln_xa_g + L * 1024; const float* bb = p.ln_xa_b + L * 1024;
      const int rpb = (MTOK + nblk - 1) / nblk;
      const int r0 = blk * rpb, r1 = (r0 + rpb < MTOK) ? r0 + rpb : MTOK;
      float* rt = (float*)smem;
      int* ent = (int*)(smem + 32768);
      if (L == 1) {
        for (int i = tid; i < 8192; i += NTHR) { const int e = i & 7, c = i >> 3; rt[e * 1024 + c] = p.moe_router[i]; }
        if (tid < 8) s_cnt[tid] = 0;
        __syncthreads();
      }
      LN_LOAD_GB(g, bb)
      float4 v[4], nx[4];
      int row = r0 + w;
      LN_LOAD_ROW(v, (row < MTOK ? row : MTOK - 1))
      for (; row < r1; row += 4) {
        LN_LOAD_ROW(nx, (row + 4 < MTOK ? row + 4 : MTOK - 1))
        __builtin_amdgcn_sched_barrier(0);
        float mean_, rstd_; ln_row(v, gv, bv, mean_, rstd_);
        LN_STORE_ROW(v, row)
        if (L == 1) {
          float lg[8];
#pragma unroll
          for (int e = 0; e < 8; ++e) {
            float a = 0.f;
#pragma unroll
            for (int j = 0; j < 4; ++j) { const float4 rv = *(const float4*)(rt + e * 1024 + j * 256 + lane * 4); a += v[j].x * rv.x + v[j].y * rv.y + v[j].z * rv.z + v[j].w * rv.w; }
            lg[e] = wave_sum(a);
          }
          if (lane == 0) {
            int e1 = 0; float v1 = lg[0];
#pragma unroll
            for (int e = 1; e < 8; ++e) if (lg[e] > v1) { v1 = lg[e]; e1 = e; }
            int e2 = -1; float v2 = -3.0e38f;
#pragma unroll
            for (int e = 0; e < 8; ++e) if (e != e1 && lg[e] > v2) { v2 = lg[e]; e2 = e; }
            const float ee = expf(v2 - v1); const float w1 = 1.f / (1.f + ee), w2 = ee / (1.f + ee);
            const int li = (row - r0) * 2;
            const int s1 = atomicAdd(&s_cnt[e1], 1); const int s2 = atomicAdd(&s_cnt[e2], 1);
            ent[li * 4 + 0] = row * 2; ent[li * 4 + 1] = e1; ent[li * 4 + 2] = s1; ent[li * 4 + 3] = __float_as_int(w1);
            ent[li * 4 + 4] = row * 2 + 1; ent[li * 4 + 5] = e2; ent[li * 4 + 6] = s2; ent[li * 4 + 7] = __float_as_int(w2);
          }
        }
#pragma unroll
        for (int j = 0; j < 4; ++j) v[j] = nx[j];
      }
      if (L == 1) {
        __syncthreads();
        if (tid < 8) s_base[tid] = atomicAdd(&ctr[8 + tid], s_cnt[tid]);
        __syncthreads();
        int* list = (int*)(ws + OFF_LIST); float* gl = (float*)(ws + OFF_GLIST);
        const int ne = (r1 - r0) * 2;
        for (int i = tid; i < ne; i += NTHR) {
          const int e = ent[i * 4 + 1]; const int pos = s_base[e] + ent[i * 4 + 2];
          list[e * MTOK + pos] = ent[i * 4 + 0]; gl[e * MTOK + pos] = __int_as_float(ent[i * 4 + 3]);
        }
        __syncthreads();
      }
      if (rep_ + 1 < REP(9)) gbar(p, ++bar_round);
    }
    gbar(p, ++bar_round);
    if (L == 0) {
      for (int rep_ = 0; rep_ < REP(10); ++rep_) {
        PH_IDS
        EpiSwiglu es{(u16*)u, FD, 0};
        for (int i = blk >> 3; ; i += nblk >> 3) {
          int mt, nt; if (!st_tile(i, blk & 7, 128, 22, 2, mt, nt)) break;
          gemm_tile256(RowPlain{xbf, 1024}, (const u16*)(ws + OFF_WT_F13), 1024, 1024, mt * 128, nt * 256, (u16*)smem, es);
        }
        if (rep_ + 1 < REP(10)) gbar(p, ++bar_round);
      }
      gbar(p, ++bar_round);
      for (int rep_ = 0; rep_ < REP(11); ++rep_) {
        PH_IDS
        EpiResidT er{y, lnstats, p.ln_xa_g, p.ln_xa_b, y, 1};
        for (int i = blk >> 3; ; i += nblk >> 3) {
          int mt, nt; if (!st_tile(i, blk & 7, 128, 8, 8, mt, nt)) break;
          gemm_tile_sw(RowPlain{(const u16*)u, FD}, (const u16*)(ws + OFF_WT_F2), FD, FD, mt * 128, nt * 128, (u16*)smem, er);
        }
        if (rep_ + 1 < REP(11)) gbar(p, ++bar_round);
      }
      gbar(p, ++bar_round);
      for (int rep_ = 0; rep_ < REP(12); ++rep_) {
        PH_IDS
        const float* g = p.ln_ffn_g; const float* bb = p.ln_ffn_b;
        LN_LOAD_GB(g, bb)
        float4 v[4], nx[4];
        int row = gwave;
        LN_LOAD_ROW(v, (row < MTOK ? row : MTOK - 1))
        while (row < MTOK) {
          const int r2 = row + nwave;
          LN_LOAD_ROW(nx, (r2 < MTOK ? r2 : MTOK - 1))
        __builtin_amdgcn_sched_barrier(0);
          float mean_, rstd_; ln_row(v, gv, bv, mean_, rstd_);
          LN_STORE_ROW(v, row)
#pragma unroll
          for (int j = 0; j < 4; ++j) v[j] = nx[j];
          row = r2;
        }
        if (rep_ + 1 < REP(12)) gbar(p, ++bar_round);
      }
      gbar(p, ++bar_round);
    } else {
      char* ws0 = lws(p); const int* ctr0 = (const int*)(ws0 + OFF_CTR);
      int cnt[8], mts[8], offp[8]; int tot_mt = 0;
#pragma unroll
      for (int e = 0; e < 8; ++e) { cnt[e] = ctr0[8 + e]; mts[e] = (cnt[e] + 127) >> 7; offp[e] = tot_mt * 128; tot_mt += mts[e]; }
      for (int rep_ = 0; rep_ < REP(13); ++rep_) {
        PH_IDS
        const int* list = (const int*)(ws + OFF_LIST); const float* gl = (const float*)(ws + OFF_GLIST); (void)gl;
        const int e = blk & 7;
        int ce = 0, me = 0, oe = 0;
#pragma unroll
        for (int q = 0; q < 8; ++q) if (e == q) { ce = cnt[q]; me = mts[q]; oe = offp[q]; }
        const int SMe = (me + 7) >> 3;
        EpiSwiglu es{(u16*)u, FM, oe};
        if (me > 0) for (int i = blk >> 3; ; i += nblk >> 3) {
          const int sl = i >> 5, within = i & 31; const int sm = sl % SMe, sn = sl / SMe;
          if (sn >= 7) break;
          const int mt = sm * 8 + (within & 7), nt = sn * 4 + (within >> 3);
          if (mt >= me) continue;
          gemm_tile256(RowGather{xbf, list + (size_t)e * MTOK, ce}, (const u16*)(ws + OFF_WT_M13) + (size_t)e * 2 * FM * 1024, 1024, 1024, mt * 128, nt * 256, (u16*)smem, es);
        }
        if (rep_ + 1 < REP(13)) gbar(p, ++bar_round);
      }
      gbar(p, ++bar_round);
      for (int rep_ = 0; rep_ < REP(14); ++rep_) {
        PH_IDS
        const int* list = (const int*)(ws + OFF_LIST); const float* gl = (const float*)(ws + OFF_GLIST); (void)gl;
        const int e = blk & 7;
        int ce = 0, me = 0, oe = 0;
#pragma unroll
        for (int q = 0; q < 8; ++q) if (e == q) { ce = cnt[q]; me = mts[q]; oe = offp[q]; }
        EpiMoe2T em{(u16*)(ws + OFF_MOEOUT), list + (size_t)e * MTOK, gl + (size_t)e * MTOK, ce};
        for (int i = blk >> 3; i < ((me + 7) >> 3) * 64; i += nblk >> 3) {
          const int sl = i >> 6, within = i & 63;
          const int mt = sl * 8 + (within & 7), nt = within >> 3;
          if (mt >= me) continue;
          gemm_tile_sw(RowPlain{(const u16*)u + (size_t)oe * FM, FM}, (const u16*)(ws + OFF_WT_M2) + (size_t)e * 1024 * FM, FM, FM, mt * 128, nt * 128, (u16*)smem, em);
        }
        if (rep_ + 1 < REP(14)) gbar(p, ++bar_round);
      }
      gbar(p, ++bar_round);
      for (int rep_ = 0; rep_ < REP(15); ++rep_) {
        PH_IDS
        const float* g = p.ln_ffn_g + 1024; const float* bb = p.ln_ffn_b + 1024;
        const u16* mo = (const u16*)(ws + OFF_MOEOUT);
        LN_LOAD_GB(g, bb)
        float4 xv[4], nxv[4]; u32x2 ma[4], mc[4], nma[4], nmc[4];
#define FIN_LOAD(XV, MA, MC, row) { _Pragma("unroll") for (int j = 0; j < 4; ++j) { XV[j] = *(const float4*)(y + (size_t)(row) * 1024 + j * 256 + lane * 4); \
          MA[j] = *(const u32x2*)(mo + (size_t)(2 * (row)) * 1024 + j * 256 + lane * 4); MC[j] = *(const u32x2*)(mo + (size_t)(2 * (row) + 1) * 1024 + j * 256 + lane * 4); } }
        int row = gwave;
        FIN_LOAD(xv, ma, mc, (row < MTOK ? row : MTOK - 1))
        while (row < MTOK) {
          const int r2 = row + nwave;
          FIN_LOAD(nxv, nma, nmc, (r2 < MTOK ? r2 : MTOK - 1))
          __builtin_amdgcn_sched_barrier(0);
          float4 v[4];
          const float2 st_ = *(const float2*)(lnstats + (size_t)row * 2);
#pragma unroll
          for (int j = 0; j < 4; ++j) {
            const u32x2 a = ma[j], c = mc[j];
            const float4 gx = *(const float4*)(p.ln_xa_g + 1024 + j * 256 + lane * 4), bx = *(const float4*)(p.ln_xa_b + 1024 + j * 256 + lane * 4);
            const float x0 = (xv[j].x - st_.x) * st_.y * gx.x + bx.x, x1 = (xv[j].y - st_.x) * st_.y * gx.y + bx.y;
            const float x2 = (xv[j].z - st_.x) * st_.y * gx.z + bx.z, x3 = (xv[j].w - st_.x) * st_.y * gx.w + bx.w;
            v[j].x = ALPHA * x0 + (__uint_as_float(a[0] << 16) + __uint_as_float(c[0] << 16));
            v[j].y = ALPHA * x1 + (__uint_as_float(a[0] & 0xffff0000u) + __uint_as_float(c[0] & 0xffff0000u));
            v[j].z = ALPHA * x2 + (__uint_as_float(a[1] << 16) + __uint_as_float(c[1] << 16));
            v[j].w = ALPHA * x3 + (__uint_as_float(a[1] & 0xffff0000u) + __uint_as_float(c[1] & 0xffff0000u));
          }
          float mean_, rstd_; ln_row(v, gv, bv, mean_, rstd_);
#pragma unroll
          for (int j = 0; j < 4; ++j) *(float4*)(p.out + (size_t)row * 1024 + j * 256 + lane * 4) = v[j];
#pragma unroll
          for (int j = 0; j < 4; ++j) { xv[j] = nxv[j]; ma[j] = nma[j]; mc[j] = nmc[j]; }
          row = r2;
        }
#undef FIN_LOAD
        if (rep_ + 1 < REP(15)) gbar(p, ++bar_round);
      }
    }
  }
}

extern "C" void kernel_launch(void* const* d_in, const int* in_sizes, int n_in, void* d_out, int out_size, void* d_ws, size_t ws_size, hipStream_t stream) {
  static int grid_blocks = 0;
  if (!grid_blocks) {
    int dev = 0, cus = 0, per_cu = 0;
    hipGetDevice(&dev);
    hipDeviceGetAttribute(&cus, hipDeviceAttributeMultiprocessorCount, dev);
    hipOccupancyMaxActiveBlocksPerMultiprocessor(&per_cu, mega, NTHR, 0);
    if (per_cu > 2) per_cu = 2;
    if (per_cu < 1) per_cu = 1;
    grid_blocks = cus * per_cu;
  }
  if (ws_size < WS_NEED) { fprintf(stderr, "workspace too small: %zu < %zu\n", ws_size, (size_t)WS_NEED); return; }
  Params p;
  memset(&p, 0, sizeof(p));
  p.x = (const float*)d_in[0]; p.mem = (const float*)d_in[1]; p.pos = (const int*)d_in[2];
  p.w_in = (const float*)d_in[3]; p.lam_q1 = (const float*)d_in[4]; p.lam_k1 = (const float*)d_in[5]; p.lam_q2 = (const float*)d_in[6]; p.lam_k2 = (const float*)d_in[7];
  p.diff_g = (const float*)d_in[8]; p.gla_wa2 = (const float*)d_in[9]; p.gla_ba = (const float*)d_in[10]; p.gla_g = (const float*)d_in[11];
  p.w_out = (const float*)d_in[12]; p.ln_mix_g = (const float*)d_in[13]; p.ln_mix_b = (const float*)d_in[14];
  p.xa_wq = (const float*)d_in[15]; p.xa_wkv = (const float*)d_in[16]; p.xa_wo = (const float*)d_in[17]; p.ln_xa_g = (const float*)d_in[18]; p.ln_xa_b = (const float*)d_in[19];
  p.ffd_w13 = (const float*)d_in[20]; p.ffd_w2 = (const float*)d_in[21]; p.moe_router = (const float*)d_in[22]; p.moe_w13 = (const float*)d_in[23]; p.moe_w2 = (const float*)d_in[24];
  p.ln_ffn_g = (const float*)d_in[25]; p.ln_ffn_b = (const float*)d_in[26];
  p.out = (float*)d_out; p.ws = (char*)d_ws;
  for (int i = 0; i < 4; ++i) p.invfA[i] = (float)pow(500000.0, -(double)(2 * i) / 8.0);
  for (int i = 0; i < 8; ++i) p.invfB[i] = (float)pow(500000.0, -(double)(2 * i) / 16.0);
  for (int l = 0; l < 2; ++l) p.lam_init[l] = (float)(0.8 - 0.6 * exp(-0.3 * l));
  void* args[] = {&p};
  hipError_t e = hipLaunchCooperativeKernel((void*)mega, dim3(grid_blocks), dim3(NTHR), args, 0, stream);
  if (e != hipSuccess) fprintf(stderr, "cooperative launch failed: %s (grid %d)\n", hipGetErrorString(e), grid_blocks);
}
```

```cpp
#include <hip/hip_runtime.h>
#include <hip/hip_cooperative_groups.h>
#include <cstdio>
#include <cmath>
#include <cstring>
namespace cg = cooperative_groups;

#define DI __device__ __forceinline__
typedef unsigned short u16;
typedef __attribute__((ext_vector_type(8))) short bf16x8;
typedef __attribute__((ext_vector_type(4))) short s16x4;
typedef __attribute__((ext_vector_type(16))) float f32x16;
typedef __attribute__((ext_vector_type(2))) float f32x2;
typedef __attribute__((ext_vector_type(2))) __bf16 bf16x2_t;
typedef __attribute__((ext_vector_type(4))) unsigned u32x4;
typedef __attribute__((ext_vector_type(2))) unsigned u32x2;
#define PH_IDS const int tid = ltid(); const int lane = tid & 63, w = tid >> 6; const int gwave = blockIdx.x * 4 + w; (void)lane; (void)gwave; \
  char* ws = lws(p); char* u = ws + OFF_UNION; u16* xbf = (u16*)(ws + OFF_XBF); float* xf = (float*)(ws + OFF_XF); float* y = (float*)(ws + OFF_Y); int* ctr = (int*)(ws + OFF_CTR); float* lnstats = (float*)(ws + OFF_STATS); (void)lnstats; (void)u; (void)xbf; (void)xf; (void)y; (void)ctr;
#ifndef PROBE_PHASE
#define PROBE_PHASE -1
#endif
#define REP(k) ((PROBE_PHASE == (k)) ? 2 : 1)
#define MFMA32(a, b, c) __builtin_amdgcn_mfma_f32_32x32x16_bf16((a), (b), (c), 0, 0, 0)

constexpr int NTHR = 256;
constexpr int MTOK = 16384, SEQ = 2048, DM = 1024;
constexpr int INP = 3200;
constexpr int FD = 2816, FM = 3584;
constexpr float ALPHA = 1.41421356237309515f;
constexpr float LOG2E = 1.44269504088896341f;
constexpr float LN2 = 0.69314718055994531f;
constexpr float LN_EPS = 1e-5f;

constexpr size_t al256(size_t x) { return (x + 255) & ~(size_t)255; }
constexpr size_t OFF_WT_IN = 0;
constexpr size_t OFF_WT_OUT = OFF_WT_IN + al256((size_t)2 * INP * 1024 * 2);
constexpr size_t OFF_WT_Q = OFF_WT_OUT + al256((size_t)2 * 1024 * 1024 * 2);
constexpr size_t OFF_WT_KV = OFF_WT_Q + al256((size_t)2 * 1024 * 1024 * 2);
constexpr size_t OFF_WT_O = OFF_WT_KV + al256((size_t)2 * 2048 * 1024 * 2);
constexpr size_t OFF_WT_F13 = OFF_WT_O + al256((size_t)2 * 1024 * 1024 * 2);
constexpr size_t OFF_WT_F2 = OFF_WT_F13 + al256((size_t)2 * FD * 1024 * 2);
constexpr size_t OFF_WT_M13 = OFF_WT_F2 + al256((size_t)1024 * FD * 2);
constexpr size_t OFF_WT_M2 = OFF_WT_M13 + al256((size_t)8 * 2 * FM * 1024 * 2);
constexpr size_t OFF_XBF = OFF_WT_M2 + al256((size_t)8 * 1024 * FM * 2);
constexpr size_t OFF_XF = OFF_XBF + al256((size_t)MTOK * 1024 * 2);
constexpr size_t OFF_Y = OFF_XF + al256((size_t)MTOK * 1024 * 4);
constexpr size_t OFF_MEMBF = OFF_Y + al256((size_t)MTOK * 1024 * 4);
constexpr size_t OFF_ROPE = OFF_MEMBF + al256((size_t)2048 * 1024 * 2);
constexpr size_t OFF_KXA = OFF_ROPE + al256((size_t)MTOK * 24 * 4);
constexpr size_t OFF_VXAT = OFF_KXA + al256((size_t)2 * 2048 * 1024 * 2);
constexpr size_t OFF_RC = OFF_VXAT + al256((size_t)2 * 2048 * 1024 * 2);
constexpr size_t OFF_LSE = OFF_RC + al256((size_t)MTOK * 16 * 4);
constexpr size_t OFF_MOEOUT = OFF_LSE + al256((size_t)3 * MTOK * 8 * 4);
constexpr size_t OFF_LIST = OFF_MOEOUT + al256((size_t)2 * MTOK * 1024 * 2);
constexpr size_t OFF_GLIST = OFF_LIST + al256((size_t)8 * MTOK * 4);
constexpr size_t OFF_CTR = OFF_GLIST + al256((size_t)8 * MTOK * 4);
constexpr size_t OFF_BAR = OFF_CTR + 256;
constexpr size_t OFF_STATS = OFF_BAR + 8192;
constexpr size_t OFF_UNION = OFF_STATS + al256((size_t)MTOK * 2 * 4);
constexpr size_t U_QA = 0;
constexpr size_t U_KA = U_QA + (size_t)MTOK * 256 * 2;
constexpr size_t U_VAT = U_KA + (size_t)MTOK * 256 * 2;
constexpr size_t U_QB = U_VAT + (size_t)MTOK * 256 * 2;
constexpr size_t U_KB = U_QB + (size_t)MTOK * 384 * 2;
constexpr size_t U_VBT = U_KB + (size_t)MTOK * 384 * 2;
constexpr size_t U_HC = U_VBT + (size_t)3 * MTOK * 384 * 2;
constexpr size_t U_PBO = U_HC + (size_t)MTOK * 1152 * 2;
constexpr size_t U_GLAO = U_PBO + (size_t)3 * MTOK * 384 * 2;
constexpr size_t U_OMIX = U_GLAO + (size_t)MTOK * 384 * 4;
constexpr size_t U_QXA = U_OMIX + (size_t)MTOK * 1024 * 2;
constexpr size_t U_MIX_END = U_QXA + (size_t)MTOK * 1024 * 2;
constexpr size_t HID_ROWS_MOE = 2 * MTOK + 8 * 128;
constexpr size_t U_HID_END = HID_ROWS_MOE * FM * 2;
constexpr size_t UNION_SIZE = al256(U_MIX_END > U_HID_END ? U_MIX_END : U_HID_END);
constexpr size_t WS_NEED = OFF_UNION + UNION_SIZE;

struct Job { const float* src; u16* dst; int K, N, Npad, mode; };

struct Params {
  const float* x; const float* mem; const int* pos;
  const float *w_in, *lam_q1, *lam_k1, *lam_q2, *lam_k2, *diff_g, *gla_wa2, *gla_ba, *gla_g, *w_out, *ln_mix_g, *ln_mix_b;
  const float *xa_wq, *xa_wkv, *xa_wo, *ln_xa_g, *ln_xa_b, *ffd_w13, *ffd_w2, *moe_router, *moe_w13, *moe_w2, *ln_ffn_g, *ln_ffn_b;
  float* out; char* ws;
  float invfA[4]; float invfB[8]; float lam_init[2];
};

DI int ltid() { int t = threadIdx.x; asm volatile("" : "+v"(t)); return t; }
typedef __attribute__((address_space(1))) char gchar_t;
template <class P_> DI char* lws(const P_& p) {
  unsigned long long a_ = (unsigned long long)p.ws; unsigned lo_ = (unsigned)a_, hi_ = (unsigned)(a_ >> 32);
  asm volatile("" : "+v"(lo_), "+v"(hi_));
  lo_ = __builtin_amdgcn_readfirstlane(lo_); hi_ = __builtin_amdgcn_readfirstlane(hi_);
  gchar_t* g_ = (gchar_t*)(((unsigned long long)hi_ << 32) | lo_);
  return (char*)g_;
}
DI float bf2f(u16 v) { return __uint_as_float(((unsigned)v) << 16); }
DI unsigned pack2(float a, float b) { f32x2 v = {a, b}; return __builtin_bit_cast(unsigned, __builtin_convertvector(v, bf16x2_t)); }
DI u16 f2bf(float a) { return (u16)(pack2(a, 0.f) & 0xffffu); }
DI int crow(int i, int hh) { return (i & 3) + 8 * (i >> 2) + 4 * hh; }
DI float wave_sum(float v) { for (int o = 32; o > 0; o >>= 1) v += __shfl_xor(v, o); return v; }
DI float ex2(float x) { return __builtin_amdgcn_exp2f(x); }
DI bf16x8 pack8(float a0, float a1, float a2, float a3, float a4, float a5, float a6, float a7) {
  u32x4 u = {pack2(a0, a1), pack2(a2, a3), pack2(a4, a5), pack2(a6, a7)};
  return __builtin_bit_cast(bf16x8, u);
}
DI void store4bf(u16* dst, float a, float b, float c, float d) { u32x2 u = {pack2(a, b), pack2(c, d)}; *(u32x2*)dst = u; }
DI bf16x8 ld8(const u16* p) { return *(const bf16x8*)p; }
DI bf16x8 ld44(const u16* p) {
  s16x4 lo = *(const s16x4*)p; s16x4 hi = *(const s16x4*)(p + 8);
  return __builtin_shufflevector(lo, hi, 0, 1, 2, 3, 4, 5, 6, 7);
}
DI float row16_allsum(float v) {
  v += __int_as_float(__builtin_amdgcn_update_dpp(0, __float_as_int(v), 0x128, 0xf, 0xf, false));
  v += __int_as_float(__builtin_amdgcn_update_dpp(0, __float_as_int(v), 0x124, 0xf, 0xf, false));
  v += __int_as_float(__builtin_amdgcn_update_dpp(0, __float_as_int(v), 0x122, 0xf, 0xf, false));
  v += __int_as_float(__builtin_amdgcn_update_dpp(0, __float_as_int(v), 0x121, 0xf, 0xf, false));
  return v;
}

constexpr int BK = 64, LDP = BK + 8;
constexpr int BK2 = 32, LDP2 = BK2 + 8;
constexpr int SMEM_BYTES = 2 * 2 * 128 * LDP * 2;

struct RowPlain { const u16* base; int ld; DI unsigned off(int r) const { return (unsigned)(r * ld) * 2u; } };
struct RowGather {
  const u16* base; const int* list; int cnt;
  DI unsigned off(int r) const { int rr = r < cnt ? r : cnt - 1; return (unsigned)(list[rr] >> 1) * 2048u; }
};

template <bool SWAP, class RowA, class Epi>
DI void gemm_tile_t(const RowA& rowA, const u16* __restrict__ Bt, int ldb, int K, int m0, int n0, u16* sm, const Epi& epi) {
  const int tid = ltid(), lane = tid & 63, w = tid >> 6, wm = w >> 1, wn = w & 1;
  const int lr = tid >> 3, lc = tid & 7;
  u16* sa = sm; u16* sb = sm + 2 * 128 * LDP;
  const char* abase = (const char*)rowA.base; const char* bbase = (const char*)Bt;
  unsigned ao[4], bo[4];
#pragma unroll
  for (int i = 0; i < 4; ++i) { ao[i] = rowA.off(m0 + lr + 32 * i) + lc * 16; bo[i] = (unsigned)((n0 + lr + 32 * i) * ldb + lc * 8) * 2u; }
  f32x16 acc[2][2];
#pragma unroll
  for (int a = 0; a < 2; ++a)
#pragma unroll
    for (int b = 0; b < 2; ++b)
#pragma unroll
      for (int i = 0; i < 16; ++i) acc[a][b][i] = 0.f;
  u32x4 ra0[4], rb0[4], ra1[4], rb1[4];
  const int KT = K / BK;
#define G_LOAD(RA, RB, k0) { _Pragma("unroll") for (int i = 0; i < 4; ++i) { RA[i] = *(const u32x4*)(abase + (ao[i] + (unsigned)(k0) * 2u)); RB[i] = *(const u32x4*)(bbase + (bo[i] + (unsigned)(k0) * 2u)); } }
#define S_WRITE(RA, RB, buf) { u16* sa2 = sa + (buf) * 128 * LDP; u16* sb2 = sb + (buf) * 128 * LDP; _Pragma("unroll") for (int i = 0; i < 4; ++i) { *(u32x4*)(sa2 + (lr + 32 * i) * LDP + lc * 8) = RA[i]; *(u32x4*)(sb2 + (lr + 32 * i) * LDP + lc * 8) = RB[i]; } }
#define COMPUTE(buf) { __builtin_amdgcn_iglp_opt(0); const u16* A_ = sa + (buf) * 128 * LDP + (wm * 64 + (lane & 31)) * LDP + (lane >> 5) * 8; const u16* B_ = sb + (buf) * 128 * LDP + (wn * 64 + (lane & 31)) * LDP + (lane >> 5) * 8; \
    _Pragma("unroll") for (int s = 0; s < BK / 16; ++s) { bf16x8 a0 = ld8(A_ + s * 16), a1 = ld8(A_ + 32 * LDP + s * 16); bf16x8 b0 = ld8(B_ + s * 16), b1 = ld8(B_ + 32 * LDP + s * 16); \
      if (SWAP) { acc[0][0] = MFMA32(b0, a0, acc[0][0]); acc[0][1] = MFMA32(b0, a1, acc[0][1]); acc[1][0] = MFMA32(b1, a0, acc[1][0]); acc[1][1] = MFMA32(b1, a1, acc[1][1]); } \
      else { acc[0][0] = MFMA32(a0, b0, acc[0][0]); acc[0][1] = MFMA32(a0, b1, acc[0][1]); acc[1][0] = MFMA32(a1, b0, acc[1][0]); acc[1][1] = MFMA32(a1, b1, acc[1][1]); } } }
  G_LOAD(ra0, rb0, 0);
  S_WRITE(ra0, rb0, 0);
  if (KT > 1) G_LOAD(ra1, rb1, BK);
  __syncthreads();
  for (int kt = 0; kt < KT; kt += 2) {
    if (kt + 2 < KT) G_LOAD(ra0, rb0, (kt + 2) * BK);
    __builtin_amdgcn_sched_barrier(0);
    __builtin_amdgcn_s_setprio(1);
    COMPUTE(0);
    __builtin_amdgcn_s_setprio(0);
    if (kt + 1 < KT) S_WRITE(ra1, rb1, 1);
    __syncthreads();
    if (kt + 1 >= KT) break;
    if (kt + 3 < KT) G_LOAD(ra1, rb1, (kt + 3) * BK);
    __builtin_amdgcn_sched_barrier(0);
    __builtin_amdgcn_s_setprio(1);
    COMPUTE(1);
    __builtin_amdgcn_s_setprio(0);
    if (kt + 2 < KT) S_WRITE(ra0, rb0, 0);
    __syncthreads();
  }
#undef G_LOAD
#undef S_WRITE
#undef COMPUTE
  epi(acc, m0 + wm * 64, n0 + wn * 64, lane);
}

template <class RowA, class Epi>
DI void gemm_tile(const RowA& rowA, const u16* __restrict__ Bt, int ldb, int K, int m0, int n0, u16* sm, const Epi& epi) { gemm_tile_t<false>(rowA, Bt, ldb, K, m0, n0, sm, epi); }
template <class RowA, class Epi>
DI void gemm_tile_sw(const RowA& rowA, const u16* __restrict__ Bt, int ldb, int K, int m0, int n0, u16* sm, const Epi& epi) { gemm_tile_t<true>(rowA, Bt, ldb, K, m0, n0, sm, epi); }

template <class RowA, class Epi>
DI void gemm_tile256(const RowA& rowA, const u16* __restrict__ Bt, int ldb, int K, int m0, int n0, u16* sm, const Epi& epi) {
  const int tid = ltid(), lane = tid & 63, w = tid >> 6, wm = w >> 1, wn = w & 1;
  const int lr = tid >> 2, lc = tid & 3;
  u16* sa = sm; u16* sb = sm + 2 * 128 * LDP2;
  const char* abase = (const char*)rowA.base; const char* bbase = (const char*)Bt;
  unsigned ao[2], bo[4];
#pragma unroll
  for (int i = 0; i < 2; ++i) ao[i] = rowA.off(m0 + lr + 64 * i) + lc * 16;
#pragma unroll
  for (int i = 0; i < 4; ++i) bo[i] = (unsigned)((n0 + lr + 64 * i) * ldb + lc * 8) * 2u;
  f32x16 acc[2][4];
#pragma unroll
  for (int a = 0; a < 2; ++a)
#pragma unroll
    for (int b = 0; b < 4; ++b)
#pragma unroll
      for (int i = 0; i < 16; ++i) acc[a][b][i] = 0.f;
  u32x4 ra0[2], rb0[4], ra1[2], rb1[4];
  const int KT = K / BK2;
#define G_LOAD(RA, RB, k0) { _Pragma("unroll") for (int i = 0; i < 2; ++i) RA[i] = *(const u32x4*)(abase + (ao[i] + (unsigned)(k0) * 2u)); \
    _Pragma("unroll") for (int i = 0; i < 4; ++i) RB[i] = *(const u32x4*)(bbase + (bo[i] + (unsigned)(k0) * 2u)); }
#define S_WRITE(RA, RB, buf) { u16* sa2 = sa + (buf) * 128 * LDP2; u16* sb2 = sb + (buf) * 256 * LDP2; \
    _Pragma("unroll") for (int i = 0; i < 2; ++i) *(u32x4*)(sa2 + (lr + 64 * i) * LDP2 + lc * 8) = RA[i]; \
    _Pragma("unroll") for (int i = 0; i < 4; ++i) *(u32x4*)(sb2 + (lr + 64 * i) * LDP2 + lc * 8) = RB[i]; }
#define COMPUTE(buf) { __builtin_amdgcn_iglp_opt(0); const u16* A_ = sa + (buf) * 128 * LDP2 + (wm * 64 + (lane & 31)) * LDP2 + (lane >> 5) * 8; const u16* B_ = sb + (buf) * 256 * LDP2 + (wn * 128 + (lane & 31)) * LDP2 + (lane >> 5) * 8; \
    _Pragma("unroll") for (int s = 0; s < BK2 / 16; ++s) { bf16x8 a0 = ld8(A_ + s * 16), a1 = ld8(A_ + 32 * LDP2 + s * 16); \
      _Pragma("unroll") for (int nt = 0; nt < 4; ++nt) { bf16x8 bq = ld8(B_ + nt * 32 * LDP2 + s * 16); acc[0][nt] = MFMA32(a0, bq, acc[0][nt]); acc[1][nt] = MFMA32(a1, bq, acc[1][nt]); } } }
  G_LOAD(ra0, rb0, 0);
  S_WRITE(ra0, rb0, 0);
  if (KT > 1) G_LOAD(ra1, rb1, BK2);
  __syncthreads();
  for (int kt = 0; kt < KT; kt += 2) {
    if (kt + 2 < KT) G_LOAD(ra0, rb0, (kt + 2) * BK2);
    __builtin_amdgcn_sched_barrier(0);
    __builtin_amdgcn_s_setprio(1);
    COMPUTE(0);
    __builtin_amdgcn_s_setprio(0);
    if (kt + 1 < KT) S_WRITE(ra1, rb1, 1);
    __syncthreads();
    if (kt + 1 >= KT) break;
    if (kt + 3 < KT) G_LOAD(ra1, rb1, (kt + 3) * BK2);
    __builtin_amdgcn_sched_barrier(0);
    __builtin_amdgcn_s_setprio(1);
    COMPUTE(1);
    __builtin_amdgcn_s_setprio(0);
    if (kt + 2 < KT) S_WRITE(ra0, rb0, 0);
    __syncthreads();
  }
#undef G_LOAD
#undef S_WRITE
#undef COMPUTE
#pragma unroll
  for (int hf = 0; hf < 2; ++hf) {
    f32x16 sub[2][2];
#pragma unroll
    for (int a = 0; a < 2; ++a)
#pragma unroll
      for (int b = 0; b < 2; ++b) sub[a][b] = acc[a][2 * hf + b];
    epi(sub, m0 + wm * 64, n0 + wn * 128 + hf * 64, lane);
  }
}

struct EpiIn {
  char* u; const float* rope; float* rc;
  DI void operator()(f32x16 (&acc)[2][2], int mbase, int nbase, int lane) const {
    const int cgp = nbase >> 6, l32 = lane & 31, hh = lane >> 5;
    if (cgp < 8) {
      u16* dst = (u16*)(u + (cgp < 4 ? U_QA : U_KA)); const int c0 = (cgp & 3) * 64;
#pragma unroll
      for (int mt = 0; mt < 2; ++mt)
#pragma unroll
        for (int nt = 0; nt < 2; ++nt)
#pragma unroll
          for (int i = 0; i < 16; ++i) {
            const int row = mbase + mt * 32 + crow(i, hh);
            float v = acc[mt][nt][i]; float pv = __shfl_xor(v, 4);
            if (l32 < 8) { const int fi = l32 & 3; float c = rope[row * 24 + fi], s = rope[row * 24 + 4 + fi]; v = (l32 < 4) ? v * c - pv * s : v * c + pv * s; }
            dst[(size_t)row * 256 + c0 + nt * 32 + l32] = f2bf(v);
          }
    } else if (cgp < 12) {
      u16* dst = (u16*)(u + U_VAT); const int head = cgp - 8;
#pragma unroll
      for (int mt = 0; mt < 2; ++mt)
#pragma unroll
        for (int nt = 0; nt < 2; ++nt)
#pragma unroll
          for (int g = 0; g < 4; ++g) {
            const int row = mbase + mt * 32 + 8 * g + 4 * hh; const int b = row >> 11, t = row & 2047; const int dv = nt * 32 + l32;
            store4bf(dst + ((size_t)((b * 4 + head) * 64 + dv)) * SEQ + t, acc[mt][nt][4 * g], acc[mt][nt][4 * g + 1], acc[mt][nt][4 * g + 2], acc[mt][nt][4 * g + 3]);
          }
    } else if (cgp < 24) {
      const bool isq = cgp < 18;
      u16* dst = (u16*)(u + (isq ? U_QB : U_KB)); const int c0 = (cgp - (isq ? 12 : 18)) * 64;
#pragma unroll
      for (int mt = 0; mt < 2; ++mt)
#pragma unroll
        for (int nt = 0; nt < 2; ++nt)
#pragma unroll
          for (int i = 0; i < 16; ++i) {
            const int row = mbase + mt * 32 + crow(i, hh);
            float v = acc[mt][nt][i];
            if (nt == 0) {
              float pv = __shfl_xor(v, 8);
              if (l32 < 16) { const int fi = l32 & 7; float c = rope[row * 24 + 8 + fi], s = rope[row * 24 + 16 + fi]; v = (l32 < 8) ? v * c - pv * s : v * c + pv * s; }
            }
            dst[(size_t)row * 384 + c0 + nt * 32 + l32] = f2bf(v);
          }
    } else if (cgp < 30) {
      u16* d0 = (u16*)(u + U_VBT); u16* d1 = d0 + (size_t)MTOK * 384; u16* d2 = d1 + (size_t)MTOK * 384; const int head = cgp - 24;
#pragma unroll
      for (int mt = 0; mt < 2; ++mt)
#pragma unroll
        for (int nt = 0; nt < 2; ++nt)
#pragma unroll
          for (int g = 0; g < 4; ++g) {
            const int row = mbase + mt * 32 + 8 * g + 4 * hh; const int b = row >> 11, t = row & 2047; const int dv = nt * 32 + l32;
            const size_t rb_ = ((size_t)((b * 6 + head) * 64 + dv)) * SEQ;
            store4bf(d0 + rb_ + t, acc[mt][nt][4 * g], acc[mt][nt][4 * g + 1], acc[mt][nt][4 * g + 2], acc[mt][nt][4 * g + 3]);
#pragma unroll
            for (int j = 0; j < 4; ++j) {
              const int tt = t + j; const u16 bv = f2bf(acc[mt][nt][4 * g + j]);
              d1[rb_ + (tt & 3) * 512 + (tt >> 2)] = bv;
              d2[rb_ + (tt & 15) * 128 + (tt >> 4)] = bv;
            }
          }
    } else if (cgp < 48) {
      u16* dst = (u16*)(u + U_HC); const int c0 = (cgp - 30) * 64;
#pragma unroll
      for (int mt = 0; mt < 2; ++mt)
#pragma unroll
        for (int nt = 0; nt < 2; ++nt)
#pragma unroll
          for (int i = 0; i < 16; ++i) {
            const int row = mbase + mt * 32 + crow(i, hh);
            dst[(size_t)row * 1152 + c0 + nt * 32 + l32] = f2bf(acc[mt][nt][i]);
          }
    } else if (cgp == 48) {
      if (l32 < 16) {
#pragma unroll
        for (int mt = 0; mt < 2; ++mt)
#pragma unroll
          for (int i = 0; i < 16; ++i) { const int row = mbase + mt * 32 + crow(i, hh); rc[(size_t)row * 16 + l32] = acc[mt][0][i]; }
      }
    }
  }
};

struct EpiKV {
  u16* kx; u16* vt;
  DI void operator()(f32x16 (&acc)[2][2], int mbase, int nbase, int lane) const {
    const int l32 = lane & 31, hh = lane >> 5;
    if (nbase < 1024) {
#pragma unroll
      for (int mt = 0; mt < 2; ++mt)
#pragma unroll
        for (int nt = 0; nt < 2; ++nt)
#pragma unroll
          for (int i = 0; i < 16; ++i) { const int row = mbase + mt * 32 + crow(i, hh); kx[(size_t)row * 1024 + nbase + nt * 32 + l32] = f2bf(acc[mt][nt][i]); }
    } else {
#pragma unroll
      for (int mt = 0; mt < 2; ++mt)
#pragma unroll
        for (int nt = 0; nt < 2; ++nt)
#pragma unroll
          for (int g = 0; g < 4; ++g) {
            const int row = mbase + mt * 32 + 8 * g + 4 * hh; const int b = row >> 8, key = row & 255; const int c = nbase - 1024 + nt * 32 + l32;
            store4bf(vt + ((size_t)(b * 1024 + c)) * 256 + key, acc[mt][nt][4 * g], acc[mt][nt][4 * g + 1], acc[mt][nt][4 * g + 2], acc[mt][nt][4 * g + 3]);
          }
    }
  }
};

struct EpiResid {
  const float* src; const float* stats; const float* g; const float* b; float* y; int mode;
  DI void operator()(f32x16 (&acc)[2][2], int mbase, int nbase, int lane) const {
    const int l32 = lane & 31, hh = lane >> 5;
    float gg[2] = {1.f, 1.f}, bb[2] = {0.f, 0.f};
    if (mode) { gg[0] = g[nbase + l32]; gg[1] = g[nbase + 32 + l32]; bb[0] = b[nbase + l32]; bb[1] = b[nbase + 32 + l32]; }
#pragma unroll
    for (int mt = 0; mt < 2; ++mt)
#pragma unroll
      for (int i = 0; i < 16; ++i) {
        const int row = mbase + mt * 32 + crow(i, hh);
        float mean = 0.f, rstd = 1.f;
        if (mode) { const float2 st = *(const float2*)(stats + (size_t)row * 2); mean = st.x; rstd = st.y; }
#pragma unroll
        for (int nt = 0; nt < 2; ++nt) {
          const size_t o = (size_t)row * 1024 + nbase + nt * 32 + l32;
          const float r = (src[o] - mean) * rstd * gg[nt] + bb[nt];
          y[o] = ALPHA * r + acc[mt][nt][i];
        }
      }
  }
};

struct EpiResidT {
  const float* src; const float* stats; const float* g; const float* b; float* y; int mode;
  DI void operator()(f32x16 (&acc)[2][2], int mbase, int nbase, int lane) const {
    const int l32 = lane & 31, hh = lane >> 5;
#pragma unroll
    for (int mt = 0; mt < 2; ++mt) {
      const int row = mbase + mt * 32 + l32;
      float mean = 0.f, rstd = 1.f;
      if (mode) { const float2 st = *(const float2*)(stats + (size_t)row * 2); mean = st.x; rstd = st.y; }
#pragma unroll
      for (int nt = 0; nt < 2; ++nt)
#pragma unroll
        for (int gq = 0; gq < 4; ++gq) {
          const int c0 = nbase + nt * 32 + 8 * gq + 4 * hh;
          const size_t o = (size_t)row * 1024 + c0;
          float4 r = *(const float4*)(src + o);
          if (mode) {
            const float4 gv = *(const float4*)(g + c0), bv = *(const float4*)(b + c0);
            r.x = (r.x - mean) * rstd * gv.x + bv.x; r.y = (r.y - mean) * rstd * gv.y + bv.y; r.z = (r.z - mean) * rstd * gv.z + bv.z; r.w = (r.w - mean) * rstd * gv.w + bv.w;
          }
          float4 ov;
          ov.x = ALPHA * r.x + acc[nt][mt][4 * gq]; ov.y = ALPHA * r.y + acc[nt][mt][4 * gq + 1]; ov.z = ALPHA * r.z + acc[nt][mt][4 * gq + 2]; ov.w = ALPHA * r.w + acc[nt][mt][4 * gq + 3];
          *(float4*)(y + o) = ov;
        }
    }
  }
};

struct EpiBfT {
  u16* dst; int ld;
  DI void operator()(f32x16 (&acc)[2][2], int mbase, int nbase, int lane) const {
    const int l32 = lane & 31, hh = lane >> 5;
#pragma unroll
    for (int mt = 0; mt < 2; ++mt)
#pragma unroll
      for (int nt = 0; nt < 2; ++nt)
#pragma unroll
        for (int gq = 0; gq < 4; ++gq)
          store4bf(dst + (size_t)(mbase + mt * 32 + l32) * ld + nbase + nt * 32 + 8 * gq + 4 * hh, acc[nt][mt][4 * gq], acc[nt][mt][4 * gq + 1], acc[nt][mt][4 * gq + 2], acc[nt][mt][4 * gq + 3]);
  }
};

struct EpiMoe2T {
  u16* mo; const int* list; const float* gl; int cnt;
  DI void operator()(f32x16 (&acc)[2][2], int mbase, int nbase, int lane) const {
    const int l32 = lane & 31, hh = lane >> 5;
#pragma unroll
    for (int mt = 0; mt < 2; ++mt) {
      const int r = mbase + mt * 32 + l32;
      if (r < cnt) {
        const int tk = list[r]; const float gw = gl[r];
#pragma unroll
        for (int nt = 0; nt < 2; ++nt)
#pragma unroll
          for (int gq = 0; gq < 4; ++gq)
            store4bf(mo + (size_t)tk * 1024 + nbase + nt * 32 + 8 * gq + 4 * hh, gw * acc[nt][mt][4 * gq], gw * acc[nt][mt][4 * gq + 1], gw * acc[nt][mt][4 * gq + 2], gw * acc[nt][mt][4 * gq + 3]);
      }
    }
  }
};

struct EpiBf {
  u16* dst; int ld;
  DI void operator()(f32x16 (&acc)[2][2], int mbase, int nbase, int lane) const {
    const int l32 = lane & 31, hh = lane >> 5;
#pragma unroll
    for (int mt = 0; mt < 2; ++mt)
#pragma unroll
      for (int nt = 0; nt < 2; ++nt)
#pragma unroll
        for (int i = 0; i < 16; ++i) dst[(size_t)(mbase + mt * 32 + crow(i, hh)) * ld + nbase + nt * 32 + l32] = f2bf(acc[mt][nt][i]);
  }
};

struct EpiSwiglu {
  u16* hid; int ld; int rowoff;
  DI void operator()(f32x16 (&acc)[2][2], int mbase, int nbase, int lane) const {
    const int l32 = lane & 31, hh = lane >> 5; const int hc = (nbase >> 6) * 32 + l32;
#pragma unroll
    for (int mt = 0; mt < 2; ++mt)
#pragma unroll
      for (int i = 0; i < 16; ++i) {
        const float g = acc[mt][0][i], up = acc[mt][1][i];
        const float h = g * __builtin_amdgcn_rcpf(1.f + __expf(-g)) * up;
        hid[(size_t)(rowoff + mbase + mt * 32 + crow(i, hh)) * ld + hc] = f2bf(h);
      }
  }
};

struct EpiMoe2 {
  u16* mo; const int* list; const float* gl; int cnt;
  DI void operator()(f32x16 (&acc)[2][2], int mbase, int nbase, int lane) const {
    const int l32 = lane & 31, hh = lane >> 5;
#pragma unroll
    for (int mt = 0; mt < 2; ++mt)
#pragma unroll
      for (int i = 0; i < 16; ++i) {
        const int r = mbase + mt * 32 + crow(i, hh);
        if (r < cnt) {
          const int tk = list[r]; const float gw = gl[r];
#pragma unroll
          for (int nt = 0; nt < 2; ++nt) mo[(size_t)tk * 1024 + nbase + nt * 32 + l32] = f2bf(gw * acc[mt][nt][i]);
        }
      }
  }
};

DI int dst_row(int n, int mode, int N) {
  if (mode == 0) return n;
  const int F = N >> 1;
  return n < F ? ((n >> 5) * 64 + (n & 31)) : (((n - F) >> 5) * 64 + 32 + ((n - F) & 31));
}
constexpr int TR_TILES = 2 * 2080 + 1408 + 704 + 8 * 1792 + 8 * 896;
DI void get_job(const Params& p, int t, Job& jb, int& lt) {
  char* ws = lws(p);
  if (t < 4160) {
    const int l = t / 2080, r = t % 2080;
    if (r < 800) { jb.src = p.w_in + (size_t)l * 1024 * 3088; jb.dst = (u16*)(ws + OFF_WT_IN) + (size_t)l * INP * 1024; jb.K = 1024; jb.N = 3088; jb.Npad = INP; jb.mode = 0; lt = r; }
    else if (r < 1056) { jb.src = p.w_out + (size_t)l * 1024 * 1024; jb.dst = (u16*)(ws + OFF_WT_OUT) + (size_t)l * 1024 * 1024; jb.K = 1024; jb.N = 1024; jb.Npad = 1024; jb.mode = 0; lt = r - 800; }
    else if (r < 1312) { jb.src = p.xa_wq + (size_t)l * 1024 * 1024; jb.dst = (u16*)(ws + OFF_WT_Q) + (size_t)l * 1024 * 1024; jb.K = 1024; jb.N = 1024; jb.Npad = 1024; jb.mode = 0; lt = r - 1056; }
    else if (r < 1824) { jb.src = p.xa_wkv + (size_t)l * 1024 * 2048; jb.dst = (u16*)(ws + OFF_WT_KV) + (size_t)l * 2048 * 1024; jb.K = 1024; jb.N = 2048; jb.Npad = 2048; jb.mode = 0; lt = r - 1312; }
    else { jb.src = p.xa_wo + (size_t)l * 1024 * 1024; jb.dst = (u16*)(ws + OFF_WT_O) + (size_t)l * 1024 * 1024; jb.K = 1024; jb.N = 1024; jb.Npad = 1024; jb.mode = 0; lt = r - 1824; }
  } else if (t < 5568) { jb.src = p.ffd_w13; jb.dst = (u16*)(ws + OFF_WT_F13); jb.K = 1024; jb.N = 2 * FD; jb.Npad = 2 * FD; jb.mode = 1; lt = t - 4160; }
  else if (t < 6272) { jb.src = p.ffd_w2; jb.dst = (u16*)(ws + OFF_WT_F2); jb.K = FD; jb.N = 1024; jb.Npad = 1024; jb.mode = 0; lt = t - 5568; }
  else if (t < 20608) { const int e = (t - 6272) / 1792; jb.src = p.moe_w13 + (size_t)e * 1024 * 2 * FM; jb.dst = (u16*)(ws + OFF_WT_M13) + (size_t)e * 2 * FM * 1024; jb.K = 1024; jb.N = 2 * FM; jb.Npad = 2 * FM; jb.mode = 1; lt = (t - 6272) % 1792; }
  else { const int e = (t - 20608) / 896; jb.src = p.moe_w2 + (size_t)e * FM * 1024; jb.dst = (u16*)(ws + OFF_WT_M2) + (size_t)e * 1024 * FM; jb.K = FM; jb.N = 1024; jb.Npad = 1024; jb.mode = 0; lt = (t - 20608) % 896; }
}
DI void tr_load(const Job& jb, int lt, float (&v)[16]) {
  const int tid = ltid(); const int tn = jb.Npad >> 6; const int tk = lt / tn, tnn = lt % tn; const int k0 = tk * 64, n0 = tnn * 64;
  const int j = tid & 63;
#pragma unroll
  for (int i = 0; i < 16; ++i) {
    const int k = i * 4 + (tid >> 6);
    v[i] = (n0 + j < jb.N) ? jb.src[(size_t)(k0 + k) * jb.N + n0 + j] : 0.f;
  }
}
DI void tr_store(const Job& jb, int lt, const float (&v)[16], float* ts) {
  const int tid = ltid(); const int tn = jb.Npad >> 6; const int tk = lt / tn, tnn = lt % tn; const int k0 = tk * 64, n0 = tnn * 64;
  const int j = tid & 63;
#pragma unroll
  for (int i = 0; i < 16; ++i) ts[(i * 4 + (tid >> 6)) * 65 + j] = v[i];
  __syncthreads();
  const int nr = tid >> 2; const int drow = (n0 + nr < jb.N) ? dst_row(n0 + nr, jb.mode, jb.N) : (n0 + nr);
#pragma unroll
  for (int cc = 0; cc < 2; ++cc) {
    const int c = (tid & 3) + 4 * cc; const float* t0 = ts + (c * 8) * 65 + nr;
    u32x4 u = {pack2(t0[0], t0[65]), pack2(t0[130], t0[195]), pack2(t0[260], t0[325]), pack2(t0[390], t0[455])};
    *(u32x4*)(jb.dst + (size_t)drow * jb.K + k0 + c * 8) = u;
  }
  __syncthreads();
}
DI void sincos_acc(float ang, float& c, float& s) {
  const double x = (double)ang;
  const double n = rint(x * 0.63661977236758134308);
  double r = fma(-n, 1.57079632679489655800e+00, x);
  r = fma(-n, 6.12323399573676603587e-17, r);
  const double r2 = r * r;
  double sp = -7.6471637318198164759e-13; sp = fma(sp, r2, 1.6059043836821614599e-10); sp = fma(sp, r2, -2.5052108385441718775e-8);
  sp = fma(sp, r2, 2.7557319223985890653e-6); sp = fma(sp, r2, -1.9841269841269841270e-4); sp = fma(sp, r2, 8.3333333333333333333e-3);
  sp = fma(sp, r2, -1.6666666666666666667e-1); const double sv = fma(sp * r2, r, r);
  double cp = 4.7794773323873852974e-14; cp = fma(cp, r2, -1.1470745597729724714e-11); cp = fma(cp, r2, 2.0876756987868098979e-9);
  cp = fma(cp, r2, -2.7557319223985890653e-7); cp = fma(cp, r2, 2.4801587301587301587e-5); cp = fma(cp, r2, -1.3888888888888888889e-3);
  cp = fma(cp, r2, 4.1666666666666666667e-2); cp = fma(cp, r2, -0.5); const double cv = fma(cp, r2, 1.0);
  const int q = ((int)n) & 3;
  const double so = (q == 0) ? sv : (q == 1) ? cv : (q == 2) ? -sv : -cv;
  const double co = (q == 0) ? cv : (q == 1) ? -sv : (q == 2) ? -cv : sv;
  c = (float)co; s = (float)so;
}

DI void softmax_tile(f32x16& S, float& mrun, float& lrun, float& corr, bf16x8& p0, bf16x8& p1) {
  float tmax = S[0];
#pragma unroll
  for (int i = 1; i < 16; ++i) tmax = fmaxf(tmax, S[i]);
  tmax = fmaxf(tmax, __shfl_xor(tmax, 32));
  const float mnew = fmaxf(mrun, tmax);
  corr = ex2(mrun - mnew);
  float ps = 0.f;
#pragma unroll
  for (int i = 0; i < 16; ++i) { S[i] = ex2(S[i] - mnew); ps += S[i]; }
  lrun = lrun * corr + ps; mrun = mnew;
  p0 = pack8(S[0], S[1], S[2], S[3], S[4], S[5], S[6], S[7]);
  p1 = pack8(S[8], S[9], S[10], S[11], S[12], S[13], S[14], S[15]);
}

DI void vperm_store(u16* row, int ch, u32x4 v) {
  const int s = ch >> 1, c = ch & 1;
  u32x2 lo = {v[0], v[1]}, hi = {v[2], v[3]};
  *(u32x2*)(row + 16 * s + 4 * c) = lo;
  *(u32x2*)(row + 16 * s + 8 + 4 * c) = hi;
}

DI void mixA_block(const Params& p, int L, int b, int h, int qblk, float lam, float lam_init, char* smem) {
  const int tid = ltid(), lane = tid & 63, w = tid >> 6, l32 = lane & 31, hh = lane >> 5;
  char* wsl_ = lws(p);
  char* u = wsl_ + OFF_UNION;
  const int q0 = qblk * 128 + w * 32;
  const u16* Q = (const u16*)(u + U_QA) + (size_t)(b * SEQ) * 256 + h * 64;
  const u16* Kg = (const u16*)(u + U_KA) + (size_t)(b * SEQ) * 256 + h * 64;
  const u16* Vg = (const u16*)(u + U_VAT) + (size_t)((b * 4 + h) * 64) * SEQ;
  u16* Ks = (u16*)smem; u16* Vs = Ks + 2 * 64 * 72;
  bf16x8 qf[2][2];
#pragma unroll
  for (int mp = 0; mp < 2; ++mp)
#pragma unroll
    for (int s = 0; s < 2; ++s) qf[mp][s] = ld8(Q + (size_t)(q0 + l32) * 256 + mp * 32 + s * 16 + hh * 8);
  f32x16 O[2][2];
#pragma unroll
  for (int a = 0; a < 2; ++a)
#pragma unroll
    for (int c = 0; c < 2; ++c)
#pragma unroll
      for (int i = 0; i < 16; ++i) O[a][c][i] = 0.f;
  float mrun[2] = {-1e30f, -1e30f}, lrun[2] = {0.f, 0.f};
  const float sc = 0.17677669529663687f * LOG2E;
  const int nkt = 2 * (qblk + 1);
  const int r0 = tid >> 3, ch = tid & 7;
  u32x4 rk[2], rv[2];
#pragma unroll
  for (int i = 0; i < 2; ++i) {
    rk[i] = *(const u32x4*)(Kg + (size_t)(r0 + 32 * i) * 256 + ch * 8);
    rv[i] = *(const u32x4*)(Vg + (size_t)(r0 + 32 * i) * SEQ + ch * 8);
  }
#pragma unroll
  for (int i = 0; i < 2; ++i) { *(u32x4*)(Ks + (r0 + 32 * i) * 72 + ch * 8) = rk[i]; vperm_store(Vs + (r0 + 32 * i) * 72, ch, rv[i]); }
  __syncthreads();
  for (int kt = 0; kt < nkt; ++kt) {
    const int buf = kt & 1;
    if (kt + 1 < nkt) {
      const int k1 = (kt + 1) * 64;
#pragma unroll
      for (int i = 0; i < 2; ++i) {
        rk[i] = *(const u32x4*)(Kg + (size_t)(k1 + r0 + 32 * i) * 256 + ch * 8);
        rv[i] = *(const u32x4*)(Vg + (size_t)(r0 + 32 * i) * SEQ + k1 + ch * 8);
      }
    }
    __builtin_amdgcn_sched_barrier(0);
    const u16* Kb = Ks + buf * 64 * 72; const u16* Vb = Vs + buf * 64 * 72;
#pragma unroll
    for (int ks = 0; ks < 2; ++ks) {
      const int kb = kt * 64 + ks * 32;
      if (kb <= q0) {
        const bool diag = (kb == q0);
        bf16x8 vf[2][2];
#pragma unroll
        for (int mt = 0; mt < 2; ++mt)
#pragma unroll
          for (int s2 = 0; s2 < 2; ++s2) vf[mt][s2] = ld8(Vb + (mt * 32 + l32) * 72 + (ks * 2 + s2) * 16 + hh * 8);
#pragma unroll
        for (int mp = 0; mp < 2; ++mp) {
          f32x16 S;
#pragma unroll
          for (int i = 0; i < 16; ++i) S[i] = 0.f;
          S = MFMA32(ld8(Kb + (ks * 32 + l32) * 72 + mp * 32 + hh * 8), qf[mp][0], S);
          S = MFMA32(ld8(Kb + (ks * 32 + l32) * 72 + mp * 32 + 16 + hh * 8), qf[mp][1], S);
#pragma unroll
          for (int i = 0; i < 16; ++i) { const float v = S[i] * sc; S[i] = (diag && crow(i, hh) > l32) ? -1e30f : v; }
          float corr; bf16x8 pf0, pf1;
          softmax_tile(S, mrun[mp], lrun[mp], corr, pf0, pf1);
#pragma unroll
          for (int mt = 0; mt < 2; ++mt) {
#pragma unroll
            for (int i = 0; i < 16; ++i) O[mp][mt][i] *= corr;
            O[mp][mt] = MFMA32(vf[mt][0], pf0, O[mp][mt]);
            O[mp][mt] = MFMA32(vf[mt][1], pf1, O[mp][mt]);
          }
        }
      }
    }
    if (kt + 1 < nkt) {
      u16* Kn = Ks + (buf ^ 1) * 64 * 72; u16* Vn = Vs + (buf ^ 1) * 64 * 72;
#pragma unroll
      for (int i = 0; i < 2; ++i) { *(u32x4*)(Kn + (r0 + 32 * i) * 72 + ch * 8) = rk[i]; vperm_store(Vn + (r0 + 32 * i) * 72, ch, rv[i]); }
    }
    __syncthreads();
  }
  const float l0 = lrun[0] + __shfl_xor(lrun[0], 32), l1 = lrun[1] + __shfl_xor(lrun[1], 32);
  const float i0 = 1.f / l0, i1 = lam / l1;
  float ssq = 0.f;
#pragma unroll
  for (int mt = 0; mt < 2; ++mt)
#pragma unroll
    for (int i = 0; i < 16; ++i) { const float o = O[0][mt][i] * i0 - O[1][mt][i] * i1; O[0][mt][i] = o; ssq += o * o; }
  ssq += __shfl_xor(ssq, 32);
  const float rs = rsqrtf(ssq * (1.f / 64.f) + LN_EPS) * (1.f - lam_init);
  const float* gg = p.diff_g + L * 64;
  u16* om = (u16*)(u + U_OMIX) + (size_t)(b * SEQ + q0 + l32) * 1024 + h * 64;
#pragma unroll
  for (int mt = 0; mt < 2; ++mt)
#pragma unroll
    for (int g = 0; g < 4; ++g) {
      const int dv = mt * 32 + 8 * g + 4 * hh;
      store4bf(om + dv, O[0][mt][4 * g] * rs * gg[dv], O[0][mt][4 * g + 1] * rs * gg[dv + 1], O[0][mt][4 * g + 2] * rs * gg[dv + 2], O[0][mt][4 * g + 3] * rs * gg[dv + 3]);
    }
}

DI void mixB_block(const Params& p, int b, int h, int g, int sb, char* smem) {
  const int tid = ltid(), lane = tid & 63, w = tid >> 6, l32 = lane & 31, hh = lane >> 5;
  char* wsl_ = lws(p);
  char* u = wsl_ + OFF_UNION;
  const int rsh = 2 * g; const int r = 1 << rsh; const int sub_len = SEQ >> rsh; const int tpr = sub_len >> 5;
  const int rho = (sb * 4) / tpr, it0 = (sb * 4) % tpr; const int i0 = it0 * 32;
  const u16* Q = (const u16*)(u + U_QB) + (size_t)(b * SEQ) * 384 + h * 64;
  const u16* Kg = (const u16*)(u + U_KB) + (size_t)(b * SEQ) * 384 + h * 64;
  const u16* Vg = (const u16*)(u + U_VBT) + (size_t)g * MTOK * 384 + (size_t)((b * 6 + h) * 64) * SEQ + rho * sub_len;
  u16* Ks = (u16*)smem; u16* Vs = Ks + 256 * 72;
  const int kbase = i0 - 128;
#pragma unroll
  for (int i = 0; i < 8; ++i) {
    const int c = tid + 256 * i;
    { const int row = c >> 3, ch = c & 7; const int ki = kbase + row;
      if (ki >= 0) *(u32x4*)(Ks + row * 72 + ch * 8) = *(const u32x4*)(Kg + (size_t)(ki * r + rho) * 384 + ch * 8); }
    { const int dv = c >> 5, ch = c & 31; const int ki = kbase + ch * 8;
      if (ki >= 0) vperm_store(Vs + dv * 264, ch, *(const u32x4*)(Vg + (size_t)dv * SEQ + ki)); }
  }
  const int iq = i0 + w * 32;
  const int tq = (iq + l32) * r + rho;
  bf16x8 qf[4];
#pragma unroll
  for (int s = 0; s < 4; ++s) qf[s] = ld8(Q + (size_t)tq * 384 + s * 16 + hh * 8);
  __syncthreads();
  f32x16 O[2];
#pragma unroll
  for (int a = 0; a < 2; ++a)
#pragma unroll
    for (int i = 0; i < 16; ++i) O[a][i] = 0.f;
  float mrun = -1e30f, lrun = 0.f;
  const float sc = 0.125f * LOG2E;
  for (int kt = 0; kt < 5; ++kt) {
    const int lb = 32 * w + 32 * kt;
    if (kbase + lb < 0) continue;
    f32x16 S;
#pragma unroll
    for (int i = 0; i < 16; ++i) S[i] = 0.f;
#pragma unroll
    for (int s = 0; s < 4; ++s) S = MFMA32(ld8(Ks + (lb + l32) * 72 + s * 16 + hh * 8), qf[s], S);
#pragma unroll
    for (int i = 0; i < 16; ++i) {
      const float v = S[i] * sc; const int kk = crow(i, hh);
      const bool bad = (kt == 0 && kk < l32) || (kt == 4 && kk > l32);
      S[i] = bad ? -1e30f : v;
    }
    float corr; bf16x8 pf0, pf1;
    softmax_tile(S, mrun, lrun, corr, pf0, pf1);
#pragma unroll
    for (int mt = 0; mt < 2; ++mt) {
#pragma unroll
      for (int i = 0; i < 16; ++i) O[mt][i] *= corr;
      O[mt] = MFMA32(ld8(Vs + (mt * 32 + l32) * 264 + lb + hh * 8), pf0, O[mt]);
      O[mt] = MFMA32(ld8(Vs + (mt * 32 + l32) * 264 + lb + 16 + hh * 8), pf1, O[mt]);
    }
  }
  const float lt = lrun + __shfl_xor(lrun, 32);
  const float inv = 1.f / lt;
  const size_t tok = (size_t)b * SEQ + tq;
  u16* po = (u16*)(u + U_PBO) + (size_t)g * MTOK * 384 + tok * 384 + h * 64;
#pragma unroll
  for (int mt = 0; mt < 2; ++mt)
#pragma unroll
    for (int gq = 0; gq < 4; ++gq) {
      const int dv = mt * 32 + 8 * gq + 4 * hh;
      store4bf(po + dv, O[mt][4 * gq] * inv, O[mt][4 * gq + 1] * inv, O[mt][4 * gq + 2] * inv, O[mt][4 * gq + 3] * inv);
    }
  if (hh == 0) {
    float* lse = (float*)(wsl_ + OFF_LSE) + (size_t)g * MTOK * 8;
    lse[tok * 8 + h] = (mrun + __builtin_amdgcn_logf(lt)) * LN2;
  }
  __syncthreads();
}

DI void gla_item(const Params& p, int L, int b, int h, int vg, char* smem) {
  const int tid = ltid(), lane = tid & 63, w = tid >> 6;
  char* wsl_ = lws(p);
  const int kg = lane & 15, vl = lane >> 4;
  char* u = wsl_ + OFF_UNION;
  const u16* hc = (const u16*)(u + U_HC);
  const float* rc = (const float*)(wsl_ + OFF_RC);
  float* go = (float*)(u + U_GLAO);
  float* a_s = (float*)smem;
  float* k_s = a_s + 64 * 48;
  float* q_s = k_s + 64 * 48;
  float* vs = q_s + 64 * 48;
  float* os = vs + 64 * 16;
  float* rcs = os + 64 * 16;
  float wcol[16]; float ba = 0.f;
  const int sd = tid % 48, stg = tid / 48;
  if (tid < 192) {
#pragma unroll
    for (int j = 0; j < 16; ++j) wcol[j] = p.gla_wa2[(size_t)L * 16 * 192 + j * 192 + h * 48 + sd];
    ba = p.gla_ba[L * 192 + h * 48 + sd];
  } else {
#pragma unroll
    for (int j = 0; j < 16; ++j) wcol[j] = 0.f;
  }
  float S0 = 0.f, S1 = 0.f, S2 = 0.f;
  const float qsc = 0.14433756729740643f;
  float4 rcv; u32x2 qv[3], kv[3], vv;
  const int t4 = tid >> 2, p4 = tid & 3;
  {
    const size_t rowb = (size_t)b * SEQ;
    rcv = *(const float4*)(rc + (rowb + t4) * 16 + p4 * 4);
#pragma unroll
    for (int i = 0; i < 3; ++i) { const int c = tid + 256 * i; const int tk = c / 12, pt = c % 12; qv[i] = *(const u32x2*)(hc + (rowb + tk) * 1152 + h * 48 + pt * 4); kv[i] = *(const u32x2*)(hc + (rowb + tk) * 1152 + 192 + h * 48 + pt * 4); }
    vv = *(const u32x2*)(hc + (rowb + t4) * 1152 + 384 + h * 96 + vg * 16 + p4 * 4);
  }
  for (int seg = 0; seg < SEQ / 64; ++seg) {
    const size_t rowb = (size_t)b * SEQ + seg * 64;
    *(float4*)(rcs + t4 * 16 + p4 * 4) = rcv;
#pragma unroll
    for (int i = 0; i < 3; ++i) {
      const int c = tid + 256 * i; const int tk = c / 12, pt = c % 12; const int o = tk * 48 + pt * 4;
      *(float4*)(k_s + o) = make_float4(__uint_as_float(kv[i][0] << 16), __uint_as_float(kv[i][0] & 0xffff0000u), __uint_as_float(kv[i][1] << 16), __uint_as_float(kv[i][1] & 0xffff0000u));
      *(float4*)(q_s + o) = make_float4(__uint_as_float(qv[i][0] << 16) * qsc, __uint_as_float(qv[i][0] & 0xffff0000u) * qsc, __uint_as_float(qv[i][1] << 16) * qsc, __uint_as_float(qv[i][1] & 0xffff0000u) * qsc);
    }
    {
      float4 vf4 = make_float4(__uint_as_float(vv[0] << 16), __uint_as_float(vv[0] & 0xffff0000u), __uint_as_float(vv[1] << 16), __uint_as_float(vv[1] & 0xffff0000u));
      *(float4*)(vs + t4 * 16 + p4 * 4) = vf4;
    }
    __syncthreads();
    if (seg + 1 < SEQ / 64) {
      const size_t rn = rowb + 64;
      rcv = *(const float4*)(rc + (rn + t4) * 16 + p4 * 4);
#pragma unroll
      for (int i = 0; i < 3; ++i) { const int c = tid + 256 * i; const int tk = c / 12, pt = c % 12; qv[i] = *(const u32x2*)(hc + (rn + tk) * 1152 + h * 48 + pt * 4); kv[i] = *(const u32x2*)(hc + (rn + tk) * 1152 + 192 + h * 48 + pt * 4); }
      vv = *(const u32x2*)(hc + (rn + t4) * 1152 + 384 + h * 96 + vg * 16 + p4 * 4);
    }
    __builtin_amdgcn_sched_barrier(0);
    if (tid < 192) {
#pragma unroll 4
      for (int tt = 0; tt < 16; ++tt) {
        const int tl = stg * 16 + tt;
        const float4* r4 = (const float4*)(rcs + tl * 16);
        float z = ba;
#pragma unroll
        for (int j4 = 0; j4 < 4; ++j4) { const float4 rv = r4[j4]; z += rv.x * wcol[4 * j4] + rv.y * wcol[4 * j4 + 1] + rv.z * wcol[4 * j4 + 2] + rv.w * wcol[4 * j4 + 3]; }
        const float a = ex2(-0.0625f * __builtin_amdgcn_logf(1.f + ex2(-z * LOG2E)));
        a_s[tl * 48 + sd] = a;
      }
    }
    __syncthreads();
#pragma unroll 1
    for (int tb = 0; tb < 64; tb += 16) {
      float okeep = 0.f;
#pragma unroll
      for (int tt = 0; tt < 16; ++tt) {
        const int tl = tb + tt;
        const int o3 = tl * 48 + kg * 3;
        const float a0 = a_s[o3], a1 = a_s[o3 + 1], a2 = a_s[o3 + 2];
        const float k0_ = k_s[o3], k1_ = k_s[o3 + 1], k2_ = k_s[o3 + 2];
        const float q0_ = q_s[o3], q1_ = q_s[o3 + 1], q2_ = q_s[o3 + 2];
        const float v = vs[tl * 16 + w * 4 + vl];
        S0 = a0 * S0 + k0_ * v; S1 = a1 * S1 + k1_ * v; S2 = a2 * S2 + k2_ * v;
        float o = q0_ * S0 + q1_ * S1 + q2_ * S2;
        o = row16_allsum(o);
        okeep = (kg == tt) ? o : okeep;
      }
      os[(tb + kg) * 16 + w * 4 + vl] = okeep;
    }
    __syncthreads();
    {
      const float4 ov = *(const float4*)(os + t4 * 16 + p4 * 4);
      *(float4*)(go + (rowb + t4) * 384 + h * 96 + vg * 16 + p4 * 4) = ov;
    }
  }
  __syncthreads();
}

DI int perm16(int t) { return (t & ~12) | ((t & 4) << 1) | ((t & 8) >> 1); }
DI void gla_mfma_item(const Params& p, int L, int b, int h, char* smem) {
  const int tid = ltid(), lane = tid & 63, w = tid >> 6, l32 = lane & 31, hh = lane >> 5;
  char* wsl_ = lws(p);
  char* u = wsl_ + OFF_UNION;
  const u16* hc = (const u16*)(u + U_HC);
  const float* rc = (const float*)(wsl_ + OFF_RC);
  float* go = (float*)(u + U_GLAO);
  u16* Qb = (u16*)smem;
  u16* QbP = Qb + 32 * 56;
  u16* Kb = QbP + 32 * 56;
  u16* KlT = Kb + 32 * 56;
  u16* Vt = KlT + 64 * 40;
  float* ebl = (float*)(Vt + 96 * 40);
  float* tot = ebl + 64;
  float* rcs = tot + 4 * 48;
  const int sd = tid % 48, stg = tid / 48;
  float wcol[16]; float ba = 0.f;
#pragma unroll
  for (int j = 0; j < 16; ++j) wcol[j] = (tid < 192) ? p.gla_wa2[(size_t)L * 16 * 192 + j * 192 + h * 48 + sd] : 0.f;
  if (tid < 192) ba = p.gla_ba[L * 192 + h * 48 + sd];
  for (int i = tid; i < 16 * 40; i += NTHR) KlT[48 * 40 + i] = 0;
  if (tid < 64) ebl[tid] = 0.f;
  f32x16 S0, S1;
#pragma unroll
  for (int i = 0; i < 16; ++i) { S0[i] = 0.f; S1[i] = 0.f; }
  const float qsc = 0.14433756729740643f;
  const int sdc = sd < 48 ? sd : 0;
  u16 rq[8], rk[8], rvv[12]; float rr[2];
  const size_t row00 = (size_t)b * SEQ;
  const unsigned oqk = (unsigned)((stg & 3) * 8) * 1152u + (unsigned)(h * 48 + sdc);
#define GL_LOAD(rowb) { const u16* hcb_ = hc + (rowb) * 1152; const float* rcb_ = rc + (rowb) * 16; \
    _Pragma("unroll") for (int tt = 0; tt < 8; ++tt) { rq[tt] = hcb_[oqk + (unsigned)tt * 1152u]; rk[tt] = hcb_[oqk + (unsigned)tt * 1152u + 192u]; } \
    _Pragma("unroll") for (int i = 0; i < 12; ++i) { const unsigned e_ = (unsigned)(tid + 256 * i); rvv[i] = hcb_[(e_ / 96u) * 1152u + 384u + (unsigned)(h * 96) + e_ % 96u]; } \
    _Pragma("unroll") for (int i = 0; i < 2; ++i) rr[i] = rcb_[tid + 256 * i]; }
  GL_LOAD(row00)
  for (int ch = 0; ch < SEQ / 32; ++ch) {
    const size_t rowb = row00 + ch * 32;
    rcs[tid] = rr[0]; rcs[tid + 256] = rr[1];
#pragma unroll
    for (int i = 0; i < 12; ++i) { const int e_ = tid + 256 * i; Vt[(e_ % 96) * 40 + perm16(e_ / 96)] = rvv[i]; }
    __syncthreads();
    float c2[8]; float run = 0.f;
    if (tid < 192) {
#pragma unroll
      for (int tt = 0; tt < 8; ++tt) {
        const float4* r4 = (const float4*)(rcs + (stg * 8 + tt) * 16);
        float z = ba;
#pragma unroll
        for (int j4 = 0; j4 < 4; ++j4) { const float4 rv = r4[j4]; z += rv.x * wcol[4 * j4] + rv.y * wcol[4 * j4 + 1] + rv.z * wcol[4 * j4 + 2] + rv.w * wcol[4 * j4 + 3]; }
        run += -0.0625f * __builtin_amdgcn_logf(1.f + ex2(-z * LOG2E));
        c2[tt] = run;
      }
      tot[stg * 48 + sd] = run;
    } else {
#pragma unroll
      for (int tt = 0; tt < 8; ++tt) c2[tt] = 0.f;
    }
    __syncthreads();
    if (tid < 192) {
      const float t0 = tot[sd], t1 = tot[48 + sd], t2 = tot[96 + sd], t3 = tot[144 + sd];
      const float pre = (stg > 0 ? t0 : 0.f) + (stg > 1 ? t1 : 0.f) + (stg > 2 ? t2 : 0.f);
      const float blast = (t0 + t1) + (t2 + t3);
      if (stg == 0) ebl[sd] = ex2(blast);
#pragma unroll
      for (int tt = 0; tt < 8; ++tt) {
        const int t = stg * 8 + tt; const float b2 = pre + c2[tt];
        const float q = bf2f(rq[tt]) * qsc, k = bf2f(rk[tt]);
        const u16 qb = f2bf(q * ex2(b2));
        Qb[t * 56 + sd] = qb; QbP[t * 56 + perm16(sd)] = qb;
        Kb[t * 56 + sd] = f2bf(k * ex2(-b2));
        KlT[sd * 40 + perm16(t)] = f2bf(k * ex2(blast - b2));
      }
    }
    __syncthreads();
    {
      const size_t rn = row00 + (ch + 1 < SEQ / 32 ? ch + 1 : ch) * 32;
      GL_LOAD(rn)
    }
    __builtin_amdgcn_sched_barrier(0);
    if (w < 3) {
      f32x16 AT;
#pragma unroll
      for (int i = 0; i < 16; ++i) AT[i] = 0.f;
#pragma unroll
      for (int s3 = 0; s3 < 3; ++s3) AT = MFMA32(ld8(Kb + l32 * 56 + s3 * 16 + hh * 8), ld8(Qb + l32 * 56 + s3 * 16 + hh * 8), AT);
#pragma unroll
      for (int i = 0; i < 16; ++i) AT[i] = (crow(i, hh) <= l32) ? AT[i] : 0.f;
      const bf16x8 pA0 = pack8(AT[0], AT[1], AT[2], AT[3], AT[4], AT[5], AT[6], AT[7]);
      const bf16x8 pA1 = pack8(AT[8], AT[9], AT[10], AT[11], AT[12], AT[13], AT[14], AT[15]);
      const bf16x8 vf0 = ld8(Vt + (32 * w + l32) * 40 + hh * 8), vf1 = ld8(Vt + (32 * w + l32) * 40 + 16 + hh * 8);
      f32x16 OT;
#pragma unroll
      for (int i = 0; i < 16; ++i) OT[i] = 0.f;
      OT = MFMA32(vf0, pA0, OT);
      OT = MFMA32(vf1, pA1, OT);
      const bf16x8 sa0 = pack8(S0[0], S0[1], S0[2], S0[3], S0[4], S0[5], S0[6], S0[7]);
      const bf16x8 sa1 = pack8(S0[8], S0[9], S0[10], S0[11], S0[12], S0[13], S0[14], S0[15]);
      const bf16x8 sa2 = pack8(S1[0], S1[1], S1[2], S1[3], S1[4], S1[5], S1[6], S1[7]);
      OT = MFMA32(sa0, ld8(QbP + l32 * 56 + hh * 8), OT);
      OT = MFMA32(sa1, ld8(QbP + l32 * 56 + 16 + hh * 8), OT);
      OT = MFMA32(sa2, ld8(QbP + l32 * 56 + 32 + hh * 8), OT);
      float* od = go + (rowb + l32) * 384 + h * 96 + 32 * w + 4 * hh;
#pragma unroll
      for (int g = 0; g < 4; ++g) *(float4*)(od + 8 * g) = make_float4(OT[4 * g], OT[4 * g + 1], OT[4 * g + 2], OT[4 * g + 3]);
#pragma unroll
      for (int i = 0; i < 16; ++i) { S0[i] *= ebl[crow(i, hh)]; S1[i] *= ebl[32 + crow(i, hh)]; }
      S0 = MFMA32(ld8(KlT + l32 * 40 + hh * 8), vf0, S0);
      S0 = MFMA32(ld8(KlT + l32 * 40 + 16 + hh * 8), vf1, S0);
      S1 = MFMA32(ld8(KlT + (32 + l32) * 40 + hh * 8), vf0, S1);
      S1 = MFMA32(ld8(KlT + (32 + l32) * 40 + 16 + hh * 8), vf1, S1);
    }
    __syncthreads();
  }
#undef GL_LOAD
}

DI void xattn_block(const Params& p, int L, int b, int h, int qb64, char* smem) {
  const int tid = ltid(), lane = tid & 63, w = tid >> 6, l32 = lane & 31, hh = lane >> 5;
  char* wsl_ = lws(p);
  const int qt2 = w >> 1, dvh = w & 1;
  char* u = wsl_ + OFF_UNION;
  const u16* Qg = (const u16*)(u + U_QXA) + (size_t)(b * SEQ + qb64 * 64) * 1024 + h * 256;
  const u16* Kg = (const u16*)(wsl_ + OFF_KXA) + (size_t)L * 2048 * 1024 + (size_t)(b * 256) * 1024 + h * 256;
  const u16* Vg = (const u16*)(wsl_ + OFF_VXAT) + (size_t)L * 2048 * 1024 + (size_t)(b * 1024 + h * 256) * 256;
  u16* Qs = (u16*)smem; u16* Ks = Qs + 64 * 264; u16* Vs = Ks + 32 * 264;
  {
    u32x4 t8[8];
#pragma unroll
    for (int i = 0; i < 8; ++i) { const int c = tid + 256 * i; t8[i] = *(const u32x4*)(Qg + (size_t)(c >> 5) * 1024 + (c & 31) * 8); }
#pragma unroll
    for (int i = 0; i < 8; ++i) { const int c = tid + 256 * i; *(u32x4*)(Qs + (c >> 5) * 264 + (c & 31) * 8) = t8[i]; }
  }
  u32x4 rk[4], rk2[4], rv[4];
#pragma unroll
  for (int i = 0; i < 4; ++i) {
    const int c = tid + 256 * i;
    rk[i] = *(const u32x4*)(Kg + (size_t)(c >> 5) * 1024 + (c & 31) * 8);
    rv[i] = *(const u32x4*)(Vg + (size_t)(c >> 2) * 256 + (c & 3) * 8);
    rk2[i] = *(const u32x4*)(Kg + (size_t)(32 + (c >> 5)) * 1024 + (c & 31) * 8);
  }
  f32x16 O[4];
#pragma unroll
  for (int a = 0; a < 4; ++a)
#pragma unroll
    for (int i = 0; i < 16; ++i) O[a][i] = 0.f;
  float mrun = -1e30f, lrun = 0.f;
  const float sc = 0.0625f * LOG2E;
#pragma unroll 1
  for (int kt = 0; kt < 8; ++kt) {
#pragma unroll
    for (int i = 0; i < 4; ++i) {
      const int c = tid + 256 * i;
      *(u32x4*)(Ks + (c >> 5) * 264 + (c & 31) * 8) = rk[i];
      vperm_store(Vs + (c >> 2) * 40, c & 3, rv[i]);
    }
    __syncthreads();
    {
      const int k1 = (kt < 7 ? kt + 1 : 7) * 32, k2 = (kt < 6 ? kt + 2 : 7) * 32;
#pragma unroll
      for (int i = 0; i < 4; ++i) {
        const int c = tid + 256 * i;
        rk[i] = rk2[i];
        rk2[i] = *(const u32x4*)(Kg + (size_t)(k2 + (c >> 5)) * 1024 + (c & 31) * 8);
        rv[i] = *(const u32x4*)(Vg + (size_t)(c >> 2) * 256 + k1 + (c & 3) * 8);
      }
    }
    __builtin_amdgcn_sched_barrier(0);
    f32x16 S;
#pragma unroll
    for (int i = 0; i < 16; ++i) S[i] = 0.f;
#pragma unroll
    for (int s = 0; s < 16; ++s) S = MFMA32(ld8(Ks + l32 * 264 + s * 16 + hh * 8), ld8(Qs + (qt2 * 32 + l32) * 264 + s * 16 + hh * 8), S);
#pragma unroll
    for (int i = 0; i < 16; ++i) S[i] *= sc;
    float corr; bf16x8 pf0, pf1;
    softmax_tile(S, mrun, lrun, corr, pf0, pf1);
#pragma unroll
    for (int mt = 0; mt < 4; ++mt) {
#pragma unroll
      for (int i = 0; i < 16; ++i) O[mt][i] *= corr;
      O[mt] = MFMA32(ld8(Vs + (dvh * 128 + mt * 32 + l32) * 40 + hh * 8), pf0, O[mt]);
      O[mt] = MFMA32(ld8(Vs + (dvh * 128 + mt * 32 + l32) * 40 + 16 + hh * 8), pf1, O[mt]);
    }
    __syncthreads();
  }
  const float lt = lrun + __shfl_xor(lrun, 32);
  const float inv = 1.f / lt;
  u16* od = (u16*)(u + U_OMIX) + (size_t)(b * SEQ + qb64 * 64 + qt2 * 32 + l32) * 1024 + h * 256 + dvh * 128;
#pragma unroll
  for (int mt = 0; mt < 4; ++mt)
#pragma unroll
    for (int g = 0; g < 4; ++g) store4bf(od + mt * 32 + 8 * g + 4 * hh, O[mt][4 * g] * inv, O[mt][4 * g + 1] * inv, O[mt][4 * g + 2] * inv, O[mt][4 * g + 3] * inv);
}

DI void ln_row(float4 (&v)[4], const float4 (&gv)[4], const float4 (&bv)[4], float& mean_o, float& rstd_o) {
  float s = 0.f, q = 0.f;
#pragma unroll
  for (int j = 0; j < 4; ++j) { s += v[j].x + v[j].y + v[j].z + v[j].w; q += v[j].x * v[j].x + v[j].y * v[j].y + v[j].z * v[j].z + v[j].w * v[j].w; }
#pragma unroll
  for (int o = 32; o > 0; o >>= 1) { s += __shfl_xor(s, o); q += __shfl_xor(q, o); }
  const float mean = s * (1.f / 1024.f);
  const float var = fmaxf(q * (1.f / 1024.f) - mean * mean, 0.f);
  const float rstd = rsqrtf(var + LN_EPS);
  mean_o = mean; rstd_o = rstd;
#pragma unroll
  for (int j = 0; j < 4; ++j) {
    v[j].x = (v[j].x - mean) * rstd * gv[j].x + bv[j].x; v[j].y = (v[j].y - mean) * rstd * gv[j].y + bv[j].y;
    v[j].z = (v[j].z - mean) * rstd * gv[j].z + bv[j].z; v[j].w = (v[j].w - mean) * rstd * gv[j].w + bv[j].w;
  }
}
#define LN_LOAD_GB(g, bb) float4 gv[4], bv[4]; _Pragma("unroll") for (int j = 0; j < 4; ++j) { gv[j] = *(const float4*)((g) + j * 256 + lane * 4); bv[j] = *(const float4*)((bb) + j * 256 + lane * 4); }
#define LN_LOAD_ROW(dst, row) { _Pragma("unroll") for (int j = 0; j < 4; ++j) dst[j] = *(const float4*)(y + (size_t)(row) * 1024 + j * 256 + lane * 4); }
#define LN_STORE_ROW(v, row) { _Pragma("unroll") for (int j = 0; j < 4; ++j) { \
    u32x2 o_ = {pack2(v[j].x, v[j].y), pack2(v[j].z, v[j].w)}; *(u32x2*)(xbf + (size_t)(row) * 1024 + j * 256 + lane * 4) = o_; } \
    if (lane == 0) *(float2*)(lnstats + (size_t)(row) * 2) = make_float2(mean_, rstd_); }

DI unsigned bar_ld(unsigned* q) { return __hip_atomic_load(q, __ATOMIC_RELAXED, __HIP_MEMORY_SCOPE_AGENT); }
DI unsigned bar_add(unsigned* q, unsigned v) { return __hip_atomic_fetch_add(q, v, __ATOMIC_RELAXED, __HIP_MEMORY_SCOPE_AGENT); }
template <class P_> DI void gbar(const P_& p, unsigned round) {
  asm volatile("s_waitcnt vmcnt(0)" ::: "memory");
  __syncthreads();
  if (threadIdx.x == 0) {
    unsigned* bar = (unsigned*)(lws(p) + OFF_BAR);
    __builtin_amdgcn_fence(__ATOMIC_RELEASE, "agent");
    asm volatile("s_waitcnt vmcnt(0)" ::: "memory");
    const unsigned g = blockIdx.x & 7u, nloc = gridDim.x >> 3;
    const unsigned old = bar_add(bar + 64 * g, 1u);
    if (old + 1u == round * nloc) {
      const unsigned o2 = bar_add(bar + 64 * 8, 1u);
      if (o2 + 1u == round * 8u) {
#pragma unroll
        for (int j = 0; j < 8; ++j) bar_add(bar + 64 * (9 + j), 1u);
      }
    }
    while (bar_ld(bar + 64 * (9 + g)) < round) __builtin_amdgcn_s_sleep(1);
    __builtin_amdgcn_fence(__ATOMIC_ACQUIRE, "agent");
    asm volatile("s_waitcnt vmcnt(0)" ::: "memory");
  }
  __syncthreads();
}

DI bool st_tile(int i, int xcd, int nM, int nN, int NB, int& mt, int& nt) {
  const int T = 8 * NB; const int sl = i / T, within = i % T; const int st = sl * 8 + xcd;
  const int SM = nM >> 3; const int S = SM * (nN / NB);
  if (st >= S) return false;
  const int sm = st % SM, sn = st / SM;
  mt = sm * 8 + (within & 7); nt = sn * NB + (within >> 3);
  return true;
}

__global__ void __launch_bounds__(NTHR, 2) mega(Params p) {
  cg::grid_group grid = cg::this_grid();
  __shared__ __attribute__((aligned(16))) char smem[SMEM_BYTES];
  __shared__ int s_item;
  __shared__ int s_cnt[8];
  __shared__ int s_base[8];
  const int nblk = gridDim.x, blk = blockIdx.x;
  const int nwave = nblk * 4;

#ifdef PROBE_SYNCS
  for (int q_ = 0; q_ < PROBE_SYNCS; ++q_) grid.sync();
#endif
  for (int rep_ = 0; rep_ < REP(0); ++rep_) {
    PH_IDS
    {
      Job jb; int lt; float v[16];
      int t = blk;
      get_job(p, t < TR_TILES ? t : TR_TILES - 1, jb, lt);
      tr_load(jb, lt, v);
      while (t < TR_TILES) {
        const int t2 = t + nblk;
        Job jb2; int lt2; float v2[16];
        get_job(p, t2 < TR_TILES ? t2 : TR_TILES - 1, jb2, lt2);
        tr_load(jb2, lt2, v2);
        __builtin_amdgcn_sched_barrier(0);
        tr_store(jb, lt, v, (float*)smem);
        jb = jb2; lt = lt2;
#pragma unroll
        for (int i = 0; i < 16; ++i) v[i] = v2[i];
        t = t2;
      }
    }
    const size_t gt = (size_t)blk * NTHR + tid, gn = (size_t)nblk * NTHR;
    for (size_t i = gt; i < (size_t)MTOK * 1024 / 4; i += gn) {
      const float4 v = ((const float4*)p.x)[i]; u32x2 o = {pack2(v.x, v.y), pack2(v.z, v.w)}; ((u32x2*)xbf)[i] = o;
    }
    u16* membf = (u16*)(ws + OFF_MEMBF);
    for (size_t i = gt; i < (size_t)2048 * 1024 / 4; i += gn) {
      const float4 v = ((const float4*)p.mem)[i]; u32x2 o = {pack2(v.x, v.y), pack2(v.z, v.w)}; ((u32x2*)membf)[i] = o;
    }
    float* rope = (float*)(ws + OFF_ROPE);
    for (size_t i = gt; i < (size_t)MTOK * 12; i += gn) {
      const int tok = (int)(i / 12), f = (int)(i % 12);
      const float ps = (float)p.pos[tok];
      const float ang = ps * (f < 4 ? p.invfA[f] : p.invfB[f - 4]);
      float c, s; sincos_acc(ang, c, s);
      if (f < 4) { rope[tok * 24 + f] = c; rope[tok * 24 + 4 + f] = s; }
      else { rope[tok * 24 + 8 + (f - 4)] = c; rope[tok * 24 + 16 + (f - 4)] = s; }
    }
    if (blk == 0 && tid < 64) ctr[tid] = 0;
    if (blk == 0) { unsigned* bw = (unsigned*)(ws + OFF_BAR); for (int i = tid; i < 2048; i += NTHR) bw[i] = 0u; }
    if (rep_ + 1 < REP(0)) grid.sync();
  }
  grid.sync();
  unsigned bar_round = 0;
#ifdef PROBE_GBAR
  for (int q_ = 0; q_ < PROBE_GBAR; ++q_) gbar(p, ++bar_round);
#endif

  for (int L = 0; L < 2; ++L) {
    for (int rep_ = 0; rep_ < REP(1); ++rep_) {
      PH_IDS
      const int nin = 128 * 25; const int ntot = nin + (L == 0 ? 512 : 0);
      EpiIn ein{u, (const float*)(ws + OFF_ROPE), (float*)(ws + OFF_RC)};
      (void)nin; (void)ntot;
      const int xcd = blk & 7, jb = blk >> 3, nb8 = nblk >> 3;
      for (int i = jb; ; i += nb8) {
        int mt, nt;
        if (i < 400) {
          if (!st_tile(i, xcd, 128, 25, 5, mt, nt)) break;
          gemm_tile(RowPlain{xbf, 1024}, (const u16*)(ws + OFF_WT_IN) + (size_t)L * INP * 1024, 1024, 1024, mt * 128, nt * 128, (u16*)smem, ein);
        } else {
          if (L != 0 || i >= 432) break;
          const int l2 = (i - 400) >> 4;
          if (!st_tile((i - 400) & 15, xcd, 16, 8, 1, mt, nt)) break;
          EpiKV ekv{(u16*)(ws + OFF_KXA) + (size_t)l2 * 2048 * 1024, (u16*)(ws + OFF_VXAT) + (size_t)l2 * 2048 * 1024};
          gemm_tile256(RowPlain{(const u16*)(ws + OFF_MEMBF), 1024}, (const u16*)(ws + OFF_WT_KV) + (size_t)l2 * 2048 * 1024, 1024, 1024, mt * 128, nt * 256, (u16*)smem, ekv);
        }
      }
      if (rep_ + 1 < REP(1)) gbar(p, ++bar_round);
    }
    gbar(p, ++bar_round);
    for (int rep_ = 0; rep_ < REP(2); ++rep_) {
      PH_IDS
      float lam;
      {
        float a1 = 0.f, a2 = 0.f;
        for (int i = 0; i < 32; ++i) { a1 += p.lam_q1[L * 32 + i] * p.lam_k1[L * 32 + i]; a2 += p.lam_q2[L * 32 + i] * p.lam_k2[L * 32 + i]; }
        lam = expf(a1) - expf(a2) + p.lam_init[L];
      }
      const int total = 32 + 512 + 2304;
      while (true) {
        if (tid == 0) s_item = atomicAdd(&ctr[L + 2 * rep_], 1);
        __syncthreads();
        const int item = s_item;
        __syncthreads();
        if (item >= total) break;
#ifdef PROBE_SUB
        if (rep_ == 1) { const int kind = item < 32 ? 1 : (item < 544 ? 2 : 3); if (kind != PROBE_SUB) continue; }
#endif
        if (item < 32) {
          __builtin_amdgcn_s_setprio(3);
          gla_mfma_item(p, L, item >> 2, item & 3, smem);
          __builtin_amdgcn_s_setprio(0);
        } else if (item < 544) {
          const int a = item - 32; const int qblk = 15 - (a >> 5), bh = a & 31;
          mixA_block(p, L, bh >> 2, bh & 3, qblk, lam, p.lam_init[L], smem);
        } else {
          const int bi = item - 544; const int g = bi / 768, rem = bi % 768; const int bh = rem >> 4, sb = rem & 15;
          mixB_block(p, bh / 6, bh % 6, g, sb, smem);
        }
      }
      if (rep_ + 1 < REP(2)) gbar(p, ++bar_round);
    }
    gbar(p, ++bar_round);
    for (int rep_ = 0; rep_ < REP(3); ++rep_) {
      PH_IDS
      const float* lse = (const float*)(ws + OFF_LSE);
      const u16* pbo = (const u16*)(u + U_PBO); const float* go = (const float*)(u + U_GLAO); const u16* hc = (const u16*)(u + U_HC);
      u16* om = (u16*)(u + U_OMIX);
      const float* gg = p.gla_g + L * 96;
      for (int tok0 = gwave; tok0 < MTOK; tok0 += nwave) {
        int tok = tok0; asm volatile("" : "+v"(tok));
#pragma unroll
        for (int hd = 0; hd < 6; ++hd) {
          const float l0 = lse[(size_t)tok * 8 + hd], l1 = lse[(size_t)MTOK * 8 + (size_t)tok * 8 + hd], l2 = lse[(size_t)2 * MTOK * 8 + (size_t)tok * 8 + hd];
          const float mx = fmaxf(l0, fmaxf(l1, l2));
          const float w0 = __expf(l0 - mx), w1 = __expf(l1 - mx), w2 = __expf(l2 - mx);
          const float inv = 1.f / (w0 + w1 + w2);
          const size_t o = (size_t)tok * 384 + hd * 64 + lane;
          const float v = (w0 * bf2f(pbo[o]) + w1 * bf2f(pbo[(size_t)MTOK * 384 + o]) + w2 * bf2f(pbo[(size_t)2 * MTOK * 384 + o])) * inv;
          om[(size_t)tok * 1024 + 256 + hd * 64 + lane] = f2bf(v);
        }
#pragma unroll
        for (int hd = 0; hd < 4; ++hd) {
          const float o0 = go[(size_t)tok * 384 + hd * 96 + lane];
          const float o1 = lane < 32 ? go[(size_t)tok * 384 + hd * 96 + 64 + lane] : 0.f;
          const float ssq = wave_sum(o0 * o0 + o1 * o1);
          const float rs = rsqrtf(ssq * (1.f / 96.f) + LN_EPS);
          const float g0 = bf2f(hc[(size_t)tok * 1152 + 768 + hd * 96 + lane]);
          om[(size_t)tok * 1024 + 640 + hd * 96 + lane] = f2bf(o0 * rs * gg[lane] * (g0 / (1.f + __expf(-g0))));
          if (lane < 32) {
            const float g1 = bf2f(hc[(size_t)tok * 1152 + 768 + hd * 96 + 64 + lane]);
            om[(size_t)tok * 1024 + 640 + hd * 96 + 64 + lane] = f2bf(o1 * rs * gg[64 + lane] * (g1 / (1.f + __expf(-g1))));
          }
        }
      }
      if (rep_ + 1 < REP(3)) gbar(p, ++bar_round);
    }
    gbar(p, ++bar_round);
    for (int rep_ = 0; rep_ < REP(4); ++rep_) {
      PH_IDS
      EpiResidT er{L == 0 ? p.x : (const float*)y, lnstats, p.ln_ffn_g, p.ln_ffn_b, y, L};
      for (int i = blk >> 3; ; i += nblk >> 3) {
        int mt, nt; if (!st_tile(i, blk & 7, 128, 8, 8, mt, nt)) break;
        gemm_tile_sw(RowPlain{(const u16*)(u + U_OMIX), 1024}, (const u16*)(ws + OFF_WT_OUT) + (size_t)L * 1024 * 1024, 1024, 1024, mt * 128, nt * 128, (u16*)smem, er);
      }
      if (rep_ + 1 < REP(4)) gbar(p, ++bar_round);
    }
    gbar(p, ++bar_round);
    for (int rep_ = 0; rep_ < REP(5); ++rep_) {
      PH_IDS
      const float* g = p.ln_mix_g + L * 1024; const float* bb = p.ln_mix_b + L * 1024;
      LN_LOAD_GB(g, bb)
      float4 v[4], nx[4];
      int row = gwave;
      LN_LOAD_ROW(v, (row < MTOK ? row : MTOK - 1))
      while (row < MTOK) {
        const int r2 = row + nwave;
        LN_LOAD_ROW(nx, (r2 < MTOK ? r2 : MTOK - 1))
        __builtin_amdgcn_sched_barrier(0);
        float mean_, rstd_; ln_row(v, gv, bv, mean_, rstd_);
        LN_STORE_ROW(v, row)
#pragma unroll
        for (int j = 0; j < 4; ++j) v[j] = nx[j];
        row = r2;
      }
      if (rep_ + 1 < REP(5)) gbar(p, ++bar_round);
    }
    gbar(p, ++bar_round);
    for (int rep_ = 0; rep_ < REP(6); ++rep_) {
      PH_IDS
      EpiBfT eq{(u16*)(u + U_QXA), 1024};
      for (int i = blk >> 3; ; i += nblk >> 3) {
        int mt, hd; if (!st_tile(i, blk & 7, 128, 4, 4, mt, hd)) break;
        gemm_tile_sw(RowPlain{xbf, 1024}, (const u16*)(ws + OFF_WT_Q) + (size_t)L * 1024 * 1024, 1024, 1024, mt * 128, hd * 256, (u16*)smem, eq);
        gemm_tile_sw(RowPlain{xbf, 1024}, (const u16*)(ws + OFF_WT_Q) + (size_t)L * 1024 * 1024, 1024, 1024, mt * 128, hd * 256 + 128, (u16*)smem, eq);
        asm volatile("s_waitcnt vmcnt(0)" ::: "memory");
        __syncthreads();
        xattn_block(p, L, mt >> 4, hd, (mt & 15) * 2, smem);
        xattn_block(p, L, mt >> 4, hd, (mt & 15) * 2 + 1, smem);
      }
      if (rep_ + 1 < REP(6)) gbar(p, ++bar_round);
    }
    gbar(p, ++bar_round);
    for (int rep_ = 0; rep_ < REP(8); ++rep_) {
      PH_IDS
      EpiResidT er{y, lnstats, p.ln_mix_g + L * 1024, p.ln_mix_b + L * 1024, y, 1};
      for (int i = blk >> 3; ; i += nblk >> 3) {
        int mt, nt; if (!st_tile(i, blk & 7, 128, 8, 8, mt, nt)) break;
        gemm_tile_sw(RowPlain{(const u16*)(u + U_OMIX), 1024}, (const u16*)(ws + OFF_WT_O) + (size_t)L * 1024 * 1024, 1024, 1024, mt * 128, nt * 128, (u16*)smem, er);
      }
      if (rep_ + 1 < REP(8)) gbar(p, ++bar_round);
    }
    gbar(p, ++bar_round);
    for (int rep_ = 0; rep_ < REP(9); ++rep_) {
      PH_IDS
      const float* g = p.ln_xa_g + L * 1024; const float* bb = p.ln_xa_b + L * 1024;
      const int rpb = (MTOK + nblk - 1) / nblk;
      const int r0 = blk * rpb, r1 = (r0 + rpb < MTOK) ? r0 + rpb : MTOK;
      float* rt = (float*)smem;
      int* ent = (int*)(smem + 32768);
      if (L == 1) {
        for (int i = tid; i < 8192; i += NTHR) { const int e = i & 7, c = i >> 3; rt[e * 1024 + c] = p.moe_router[i]; }
        if (tid < 8) s_cnt[tid] = 0;
        __syncthreads();
      }
      LN_LOAD_GB(g, bb)
      float4 v[4], nx[4];
      int row = r0 + w;
      LN_LOAD_ROW(v, (row < MTOK ? row : MTOK - 1))
      for (; row < r1; row += 4) {
        LN_LOAD_ROW(nx, (row + 4 < MTOK ? row + 4 : MTOK - 1))
        __builtin_amdgcn_sched_barrier(0);
        float mean_, rstd_; ln_row(v, gv, bv, mean_, rstd_);
        LN_STORE_ROW(v, row)
        if (L == 1) {
          float lg[8];
#pragma unroll
          for (int e = 0; e < 8; ++e) {
            float a = 0.f;
#pragma unroll
            for (int j = 0; j < 4; ++j) { const float4 rv = *(const float4*)(rt + e * 1024 + j * 256 + lane * 4); a += v[j].x * rv.x + v[j].y * rv.y + v[j].z * rv.z + v[j].w * rv.w; }
            lg[e] = wave_sum(a);
          }
          if (lane == 0) {
            int e1 = 0; float v1 = lg[0];
#pragma unroll
            for (int e = 1; e < 8; ++e) if (lg[e] > v1) { v1 = lg[e]; e1 = e; }
            int e2 = -1; float v2 = -3.0e38f;
#pragma unroll
            for (int e = 0; e < 8; ++e) if (e != e1 && lg[e] > v2) { v2 = lg[e]; e2 = e; }
            const float ee = expf(v2 - v1); const float w1 = 1.f / (1.f + ee), w2 = ee / (1.f + ee);
            const int li = (row - r0) * 2;
            const int s1 = atomicAdd(&s_cnt[e1], 1); const int s2 = atomicAdd(&s_cnt[e2], 1);
            ent[li * 4 + 0] = row * 2; ent[li * 4 + 1] = e1; ent[li * 4 + 2] = s1; ent[li * 4 + 3] = __float_as_int(w1);
            ent[li * 4 + 4] = row * 2 + 1; ent[li * 4 + 5] = e2; ent[li * 4 + 6] = s2; ent[li * 4 + 7] = __float_as_int(w2);
          }
        }
#pragma unroll
        for (int j = 0; j < 4; ++j) v[j] = nx[j];
      }
      if (L == 1) {
        __syncthreads();
        if (tid < 8) s_base[tid] = atomicAdd(&ctr[8 + tid], s_cnt[tid]);
        __syncthreads();
        int* list = (int*)(ws + OFF_LIST); float* gl = (float*)(ws + OFF_GLIST);
        const int ne = (r1 - r0) * 2;
        for (int i = tid; i < ne; i += NTHR) {
          const int e = ent[i * 4 + 1]; const int pos = s_base[e] + ent[i * 4 + 2];
          list[e * MTOK + pos] = ent[i * 4 + 0]; gl[e * MTOK + pos] = __int_as_float(ent[i * 4 + 3]);
        }
        __syncthreads();
      }
      if (rep_ + 1 < REP(9)) gbar(p, ++bar_round);
    }
    gbar(p, ++bar_round);
    if (L == 0) {
      for (int rep_ = 0; rep_ < REP(10); ++rep_) {
        PH_IDS
        EpiSwiglu es{(u16*)u, FD, 0};
        {
          const int nb8 = nblk >> 3, jb = blk >> 3, tot = 352; const int full = (tot / nb8) * nb8;
          for (int i = jb; i < full; i += nb8) {
            int mt, nt; st_tile(i, blk & 7, 128, 22, 2, mt, nt);
            gemm_tile256(RowPlain{xbf, 1024}, (const u16*)(ws + OFF_WT_F13), 1024, 1024, mt * 128, nt * 256, (u16*)smem, es);
          }
          for (int hq = jb; hq < 2 * (tot - full); hq += nb8) {
            int mt, nt; st_tile(full + (hq >> 1), blk & 7, 128, 22, 2, mt, nt);
            gemm_tile(RowPlain{xbf, 1024}, (const u16*)(ws + OFF_WT_F13), 1024, 1024, mt * 128, nt * 256 + (hq & 1) * 128, (u16*)smem, es);
          }
        }
        if (rep_ + 1 < REP(10)) gbar(p, ++bar_round);
      }
      gbar(p, ++bar_round);
      for (int rep_ = 0; rep_ < REP(11); ++rep_) {
        PH_IDS
        EpiResidT er{y, lnstats, p.ln_xa_g, p.ln_xa_b, y, 1};
        for (int i = blk >> 3; ; i += nblk >> 3) {
          int mt, nt; if (!st_tile(i, blk & 7, 128, 8, 8, mt, nt)) break;
          gemm_tile_sw(RowPlain{(const u16*)u, FD}, (const u16*)(ws + OFF_WT_F2), FD, FD, mt * 128, nt * 128, (u16*)smem, er);
        }
        if (rep_ + 1 < REP(11)) gbar(p, ++bar_round);
      }
      gbar(p, ++bar_round);
      for (int rep_ = 0; rep_ < REP(12); ++rep_) {
        PH_IDS
        const float* g = p.ln_ffn_g; const float* bb = p.ln_ffn_b;
        LN_LOAD_GB(g, bb)
        float4 v[4], nx[4];
        int row = gwave;
        LN_LOAD_ROW(v, (row < MTOK ? row : MTOK - 1))
        while (row < MTOK) {
          const int r2 = row + nwave;
          LN_LOAD_ROW(nx, (r2 < MTOK ? r2 : MTOK - 1))
        __builtin_amdgcn_sched_barrier(0);
          float mean_, rstd_; ln_row(v, gv, bv, mean_, rstd_);
          LN_STORE_ROW(v, row)
#pragma unroll
          for (int j = 0; j < 4; ++j) v[j] = nx[j];
          row = r2;
        }
        if (rep_ + 1 < REP(12)) gbar(p, ++bar_round);
      }
      gbar(p, ++bar_round);
    } else {
      char* ws0 = lws(p); const int* ctr0 = (const int*)(ws0 + OFF_CTR);
      int cnt[8], mts[8], offp[8]; int tot_mt = 0;
#pragma unroll
      for (int e = 0; e < 8; ++e) { cnt[e] = ctr0[8 + e]; mts[e] = (cnt[e] + 127) >> 7; offp[e] = tot_mt * 128; tot_mt += mts[e]; }
      for (int rep_ = 0; rep_ < REP(13); ++rep_) {
        PH_IDS
        const int* list = (const int*)(ws + OFF_LIST); const float* gl = (const float*)(ws + OFF_GLIST); (void)gl;
        const int e = blk & 7;
        int ce = 0, me = 0, oe = 0;
#pragma unroll
        for (int q = 0; q < 8; ++q) if (e == q) { ce = cnt[q]; me = mts[q]; oe = offp[q]; }
        EpiSwiglu es{(u16*)u, FM, oe};
        if (me > 0) {
          const int nb8 = nblk >> 3, jb = blk >> 3, tot = me * 28, grp = me * 4; const int full = (tot / nb8) * nb8;
          const u16* wB = (const u16*)(ws + OFF_WT_M13) + (size_t)e * 2 * FM * 1024;
          for (int v = jb; v < full; v += nb8) {
            const int sn = v / grp, r = v % grp; const int mt = r >> 2, nt = sn * 4 + (r & 3);
            gemm_tile256(RowGather{xbf, list + (size_t)e * MTOK, ce}, wB, 1024, 1024, mt * 128, nt * 256, (u16*)smem, es);
          }
          for (int hq = jb; hq < 2 * (tot - full); hq += nb8) {
            const int v = full + (hq >> 1); const int sn = v / grp, r = v % grp; const int mt = r >> 2, nt = sn * 4 + (r & 3);
            gemm_tile(RowGather{xbf, list + (size_t)e * MTOK, ce}, wB, 1024, 1024, mt * 128, nt * 256 + (hq & 1) * 128, (u16*)smem, es);
          }
        }
        if (rep_ + 1 < REP(13)) gbar(p, ++bar_round);
      }
      gbar(p, ++bar_round);
      for (int rep_ = 0; rep_ < REP(14); ++rep_) {
        PH_IDS
        const int* list = (const int*)(ws + OFF_LIST); const float* gl = (const float*)(ws + OFF_GLIST); (void)gl;
        const int e = blk & 7;
        int ce = 0, me = 0, oe = 0;
#pragma unroll
        for (int q = 0; q < 8; ++q) if (e == q) { ce = cnt[q]; me = mts[q]; oe = offp[q]; }
        EpiMoe2T em{(u16*)(ws + OFF_MOEOUT), list + (size_t)e * MTOK, gl + (size_t)e * MTOK, ce};
        for (int i = blk >> 3; i < ((me + 7) >> 3) * 64; i += nblk >> 3) {
          const int sl = i >> 6, within = i & 63;
          const int mt = sl * 8 + (within & 7), nt = within >> 3;
          if (mt >= me) continue;
          gemm_tile_sw(RowPlain{(const u16*)u + (size_t)oe * FM, FM}, (const u16*)(ws + OFF_WT_M2) + (size_t)e * 1024 * FM, FM, FM, mt * 128, nt * 128, (u16*)smem, em);
        }
        if (rep_ + 1 < REP(14)) gbar(p, ++bar_round);
      }
      gbar(p, ++bar_round);
      for (int rep_ = 0; rep_ < REP(15); ++rep_) {
        PH_IDS
        const float* g = p.ln_ffn_g + 1024; const float* bb = p.ln_ffn_b + 1024;
        const u16* mo = (const u16*)(ws + OFF_MOEOUT);
        LN_LOAD_GB(g, bb)
        float4 xv[4], nxv[4]; u32x2 ma[4], mc[4], nma[4], nmc[4];
#define FIN_LOAD(XV, MA, MC, row) { _Pragma("unroll") for (int j = 0; j < 4; ++j) { XV[j] = *(const float4*)(y + (size_t)(row) * 1024 + j * 256 + lane * 4); \
          MA[j] = *(const u32x2*)(mo + (size_t)(2 * (row)) * 1024 + j * 256 + lane * 4); MC[j] = *(const u32x2*)(mo + (size_t)(2 * (row) + 1) * 1024 + j * 256 + lane * 4); } }
        int row = gwave;
        FIN_LOAD(xv, ma, mc, (row < MTOK ? row : MTOK - 1))
        while (row < MTOK) {
          const int r2 = row + nwave;
          FIN_LOAD(nxv, nma, nmc, (r2 < MTOK ? r2 : MTOK - 1))
          __builtin_amdgcn_sched_barrier(0);
          float4 v[4];
          const float2 st_ = *(const float2*)(lnstats + (size_t)row * 2);
#pragma unroll
          for (int j = 0; j < 4; ++j) {
            const u32x2 a = ma[j], c = mc[j];
            const float4 gx = *(const float4*)(p.ln_xa_g + 1024 + j * 256 + lane * 4), bx = *(const float4*)(p.ln_xa_b + 1024 + j * 256 + lane * 4);
            const float x0 = (xv[j].x - st_.x) * st_.y * gx.x + bx.x, x1 = (xv[j].y - st_.x) * st_.y * gx.y + bx.y;
            const float x2 = (xv[j].z - st_.x) * st_.y * gx.z + bx.z, x3 = (xv[j].w - st_.x) * st_.y * gx.w + bx.w;
            v[j].x = ALPHA * x0 + (__uint_as_float(a[0] << 16) + __uint_as_float(c[0] << 16));
            v[j].y = ALPHA * x1 + (__uint_as_float(a[0] & 0xffff0000u) + __uint_as_float(c[0] & 0xffff0000u));
            v[j].z = ALPHA * x2 + (__uint_as_float(a[1] << 16) + __uint_as_float(c[1] << 16));
            v[j].w = ALPHA * x3 + (__uint_as_float(a[1] & 0xffff0000u) + __uint_as_float(c[1] & 0xffff0000u));
          }
          float mean_, rstd_; ln_row(v, gv, bv, mean_, rstd_);
#pragma unroll
          for (int j = 0; j < 4; ++j) *(float4*)(p.out + (size_t)row * 1024 + j * 256 + lane * 4) = v[j];
#pragma unroll
          for (int j = 0; j < 4; ++j) { xv[j] = nxv[j]; ma[j] = nma[j]; mc[j] = nmc[j]; }
          row = r2;
        }
#undef FIN_LOAD
        if (rep_ + 1 < REP(15)) gbar(p, ++bar_round);
      }
    }
  }
}

extern "C" void kernel_launch(void* const* d_in, const int* in_sizes, int n_in, void* d_out, int out_size, void* d_ws, size_t ws_size, hipStream_t stream) {
  static int grid_blocks = 0;
  if (!grid_blocks) {
    int dev = 0, cus = 0, per_cu = 0;
    hipGetDevice(&dev);
    hipDeviceGetAttribute(&cus, hipDeviceAttributeMultiprocessorCount, dev);
    hipOccupancyMaxActiveBlocksPerMultiprocessor(&per_cu, mega, NTHR, 0);
    if (per_cu > 2) per_cu = 2;
    if (per_cu < 1) per_cu = 1;
    grid_blocks = cus * per_cu;
  }
  if (ws_size < WS_NEED) { fprintf(stderr, "workspace too small: %zu < %zu\n", ws_size, (size_t)WS_NEED); return; }
  Params p;
  memset(&p, 0, sizeof(p));
  p.x = (const float*)d_in[0]; p.mem = (const float*)d_in[1]; p.pos = (const int*)d_in[2];
  p.w_in = (const float*)d_in[3]; p.lam_q1 = (const float*)d_in[4]; p.lam_k1 = (const float*)d_in[5]; p.lam_q2 = (const float*)d_in[6]; p.lam_k2 = (const float*)d_in[7];
  p.diff_g = (const float*)d_in[8]; p.gla_wa2 = (const float*)d_in[9]; p.gla_ba = (const float*)d_in[10]; p.gla_g = (const float*)d_in[11];
  p.w_out = (const float*)d_in[12]; p.ln_mix_g = (const float*)d_in[13]; p.ln_mix_b = (const float*)d_in[14];
  p.xa_wq = (const float*)d_in[15]; p.xa_wkv = (const float*)d_in[16]; p.xa_wo = (const float*)d_in[17]; p.ln_xa_g = (const float*)d_in[18]; p.ln_xa_b = (const float*)d_in[19];
  p.ffd_w13 = (const float*)d_in[20]; p.ffd_w2 = (const float*)d_in[21]; p.moe_router = (const float*)d_in[22]; p.moe_w13 = (const float*)d_in[23]; p.moe_w2 = (const float*)d_in[24];
  p.ln_ffn_g = (const float*)d_in[25]; p.ln_ffn_b = (const float*)d_in[26];
  p.out = (float*)d_out; p.ws = (char*)d_ws;
  for (int i = 0; i < 4; ++i) p.invfA[i] = (float)pow(500000.0, -(double)(2 * i) / 8.0);
  for (int i = 0; i < 8; ++i) p.invfB[i] = (float)pow(500000.0, -(double)(2 * i) / 16.0);
  for (int l = 0; l < 2; ++l) p.lam_init[l] = (float)(0.8 - 0.6 * exp(-0.3 * l));
  void* args[] = {&p};
  hipError_t e = hipLaunchCooperativeKernel((void*)mega, dim3(grid_blocks), dim3(NTHR), args, 0, stream);
  if (e != hipSuccess) fprintf(stderr, "cooperative launch failed: %s (grid %d)\n", hipGetErrorString(e), grid_blocks);
}
```

```cpp
#include <hip/hip_runtime.h>
#include <hip/hip_cooperative_groups.h>
#include <cstdio>
#include <cmath>
#include <cstring>
namespace cg = cooperative_groups;

#define DI __device__ __forceinline__
typedef unsigned short u16;
typedef __attribute__((ext_vector_type(8))) short bf16x8;
typedef __attribute__((ext_vector_type(4))) short s16x4;
typedef __attribute__((ext_vector_type(16))) float f32x16;
typedef __attribute__((ext_vector_type(2))) float f32x2;
typedef __attribute__((ext_vector_type(2))) __bf16 bf16x2_t;
typedef __attribute__((ext_vector_type(4))) unsigned u32x4;
typedef __attribute__((ext_vector_type(2))) unsigned u32x2;
#define PH_IDS const int tid = ltid(); const int lane = tid & 63, w = tid >> 6; const int gwave = blockIdx.x * 4 + w; (void)lane; (void)gwave; \
  char* ws = lws(p); char* u = ws + OFF_UNION; u16* xbf = (u16*)(ws + OFF_XBF); float* xf = (float*)(ws + OFF_XF); float* y = (float*)(ws + OFF_Y); int* ctr = (int*)(ws + OFF_CTR); float* lnstats = (float*)(ws + OFF_STATS); (void)lnstats; (void)u; (void)xbf; (void)xf; (void)y; (void)ctr;
#ifndef PROBE_PHASE
#define PROBE_PHASE -1
#endif
#define REP(k) ((PROBE_PHASE == (k)) ? 2 : 1)
#define MFMA32(a, b, c) __builtin_amdgcn_mfma_f32_32x32x16_bf16((a), (b), (c), 0, 0, 0)

constexpr int NTHR = 256;
constexpr int MTOK = 16384, SEQ = 2048, DM = 1024;
constexpr int INP = 3200;
constexpr int FD = 2816, FM = 3584;
constexpr float ALPHA = 1.41421356237309515f;
constexpr float LOG2E = 1.44269504088896341f;
constexpr float LN2 = 0.69314718055994531f;
constexpr float LN_EPS = 1e-5f;

constexpr size_t al256(size_t x) { return (x + 255) & ~(size_t)255; }
constexpr size_t OFF_WT_IN = 0;
constexpr size_t OFF_WT_OUT = OFF_WT_IN + al256((size_t)2 * INP * 1024 * 2);
constexpr size_t OFF_WT_Q = OFF_WT_OUT + al256((size_t)2 * 1024 * 1024 * 2);
constexpr size_t OFF_WT_KV = OFF_WT_Q + al256((size_t)2 * 1024 * 1024 * 2);
constexpr size_t OFF_WT_O = OFF_WT_KV + al256((size_t)2 * 2048 * 1024 * 2);
constexpr size_t OFF_WT_F13 = OFF_WT_O + al256((size_t)2 * 1024 * 1024 * 2);
constexpr size_t OFF_WT_F2 = OFF_WT_F13 + al256((size_t)2 * FD * 1024 * 2);
constexpr size_t OFF_WT_M13 = OFF_WT_F2 + al256((size_t)1024 * FD * 2);
constexpr size_t OFF_WT_M2 = OFF_WT_M13 + al256((size_t)8 * 2 * FM * 1024 * 2);
constexpr size_t OFF_XBF = OFF_WT_M2 + al256((size_t)8 * 1024 * FM * 2);
constexpr size_t OFF_XF = OFF_XBF + al256((size_t)MTOK * 1024 * 2);
constexpr size_t OFF_Y = OFF_XF + al256((size_t)MTOK * 1024 * 4);
constexpr size_t OFF_MEMBF = OFF_Y + al256((size_t)MTOK * 1024 * 4);
constexpr size_t OFF_ROPE = OFF_MEMBF + al256((size_t)2048 * 1024 * 2);
constexpr size_t OFF_KXA = OFF_ROPE + al256((size_t)MTOK * 24 * 4);
constexpr size_t OFF_VXAT = OFF_KXA + al256((size_t)2 * 2048 * 1024 * 2);
constexpr size_t OFF_RC = OFF_VXAT + al256((size_t)2 * 2048 * 1024 * 2);
constexpr size_t OFF_LSE = OFF_RC + al256((size_t)MTOK * 16 * 4);
constexpr size_t OFF_MOEOUT = OFF_LSE + al256((size_t)3 * MTOK * 8 * 4);
constexpr size_t OFF_LIST = OFF_MOEOUT + al256((size_t)2 * MTOK * 1024 * 2);
constexpr size_t OFF_GLIST = OFF_LIST + al256((size_t)8 * MTOK * 4);
constexpr size_t OFF_CTR = OFF_GLIST + al256((size_t)8 * MTOK * 4);
constexpr size_t OFF_BAR = OFF_CTR + 256;
constexpr size_t OFF_STATS = OFF_BAR + 8192;
constexpr size_t OFF_UNION = OFF_STATS + al256((size_t)MTOK * 2 * 4);
constexpr size_t U_QA = 0;
constexpr size_t U_KA = U_QA + (size_t)MTOK * 256 * 2;
constexpr size_t U_VAT = U_KA + (size_t)MTOK * 256 * 2;
constexpr size_t U_QB = U_VAT + (size_t)MTOK * 256 * 2;
constexpr size_t U_KB = U_QB + (size_t)MTOK * 384 * 2;
constexpr size_t U_VBT = U_KB + (size_t)MTOK * 384 * 2;
constexpr size_t U_HC = U_VBT + (size_t)3 * MTOK * 384 * 2;
constexpr size_t U_PBO = U_HC + (size_t)MTOK * 1152 * 2;
constexpr size_t U_GLAO = U_PBO + (size_t)3 * MTOK * 384 * 2;
constexpr size_t U_OMIX = U_GLAO + (size_t)MTOK * 384 * 4;
constexpr size_t U_QXA = U_OMIX + (size_t)MTOK * 1024 * 2;
constexpr size_t U_MIX_END = U_QXA + (size_t)MTOK * 1024 * 2;
constexpr size_t HID_ROWS_MOE = 2 * MTOK + 8 * 128;
constexpr size_t U_HID_END = HID_ROWS_MOE * FM * 2;
constexpr size_t UNION_SIZE = al256(U_MIX_END > U_HID_END ? U_MIX_END : U_HID_END);
constexpr size_t WS_NEED = OFF_UNION + UNION_SIZE;

struct Job { const float* src; u16* dst; int K, N, Npad, mode; };

struct Params {
  const float* x; const float* mem; const int* pos;
  const float *w_in, *lam_q1, *lam_k1, *lam_q2, *lam_k2, *diff_g, *gla_wa2, *gla_ba, *gla_g, *w_out, *ln_mix_g, *ln_mix_b;
  const float *xa_wq, *xa_wkv, *xa_wo, *ln_xa_g, *ln_xa_b, *ffd_w13, *ffd_w2, *moe_router, *moe_w13, *moe_w2, *ln_ffn_g, *ln_ffn_b;
  float* out; char* ws;
  float invfA[4]; float invfB[8]; float lam_init[2];
};

DI int ltid() { int t = threadIdx.x; asm volatile("" : "+v"(t)); return t; }
typedef __attribute__((address_space(1))) char gchar_t;
template <class P_> DI char* lws(const P_& p) {
  unsigned long long a_ = (unsigned long long)p.ws; unsigned lo_ = (unsigned)a_, hi_ = (unsigned)(a_ >> 32);
  asm volatile("" : "+v"(lo_), "+v"(hi_));
  lo_ = __builtin_amdgcn_readfirstlane(lo_); hi_ = __builtin_amdgcn_readfirstlane(hi_);
  gchar_t* g_ = (gchar_t*)(((unsigned long long)hi_ << 32) | lo_);
  return (char*)g_;
}
DI float bf2f(u16 v) { return __uint_as_float(((unsigned)v) << 16); }
DI unsigned pack2(float a, float b) { f32x2 v = {a, b}; return __builtin_bit_cast(unsigned, __builtin_convertvector(v, bf16x2_t)); }
DI u16 f2bf(float a) { return (u16)(pack2(a, 0.f) & 0xffffu); }
DI int crow(int i, int hh) { return (i & 3) + 8 * (i >> 2) + 4 * hh; }
DI float wave_sum(float v) { for (int o = 32; o > 0; o >>= 1) v += __shfl_xor(v, o); return v; }
DI float ex2(float x) { return __builtin_amdgcn_exp2f(x); }
DI bf16x8 pack8(float a0, float a1, float a2, float a3, float a4, float a5, float a6, float a7) {
  u32x4 u = {pack2(a0, a1), pack2(a2, a3), pack2(a4, a5), pack2(a6, a7)};
  return __builtin_bit_cast(bf16x8, u);
}
DI void store4bf(u16* dst, float a, float b, float c, float d) { u32x2 u = {pack2(a, b), pack2(c, d)}; *(u32x2*)dst = u; }
DI bf16x8 ld8(const u16* p) { return *(const bf16x8*)p; }
DI bf16x8 ld44(const u16* p) {
  s16x4 lo = *(const s16x4*)p; s16x4 hi = *(const s16x4*)(p + 8);
  return __builtin_shufflevector(lo, hi, 0, 1, 2, 3, 4, 5, 6, 7);
}
DI float row16_allsum(float v) {
  v += __int_as_float(__builtin_amdgcn_update_dpp(0, __float_as_int(v), 0x128, 0xf, 0xf, false));
  v += __int_as_float(__builtin_amdgcn_update_dpp(0, __float_as_int(v), 0x124, 0xf, 0xf, false));
  v += __int_as_float(__builtin_amdgcn_update_dpp(0, __float_as_int(v), 0x122, 0xf, 0xf, false));
  v += __int_as_float(__builtin_amdgcn_update_dpp(0, __float_as_int(v), 0x121, 0xf, 0xf, false));
  return v;
}

constexpr int BK = 64, LDP = BK + 8;
constexpr int BK2 = 32, LDP2 = BK2 + 8;
constexpr int SMEM_BYTES = 2 * 2 * 128 * LDP * 2;

struct RowPlain { const u16* base; int ld; DI unsigned off(int r) const { return (unsigned)(r * ld) * 2u; } };
struct RowGather {
  const u16* base; const int* list; int cnt;
  DI unsigned off(int r) const { int rr = r < cnt ? r : cnt - 1; return (unsigned)(list[rr] >> 1) * 2048u; }
};

template <bool SWAP, class RowA, class Epi>
DI void gemm_tile_t(const RowA& rowA, const u16* __restrict__ Bt, int ldb, int K, int m0, int n0, u16* sm, const Epi& epi) {
  const int tid = ltid(), lane = tid & 63, w = tid >> 6, wm = w >> 1, wn = w & 1;
  const int lr = tid >> 3, lc = tid & 7;
  u16* sa = sm; u16* sb = sm + 2 * 128 * LDP;
  const char* abase = (const char*)rowA.base; const char* bbase = (const char*)Bt;
  unsigned ao[4], bo[4];
#pragma unroll
  for (int i = 0; i < 4; ++i) { ao[i] = rowA.off(m0 + lr + 32 * i) + lc * 16; bo[i] = (unsigned)((n0 + lr + 32 * i) * ldb + lc * 8) * 2u; }
  f32x16 acc[2][2];
#pragma unroll
  for (int a = 0; a < 2; ++a)
#pragma unroll
    for (int b = 0; b < 2; ++b)
#pragma unroll
      for (int i = 0; i < 16; ++i) acc[a][b][i] = 0.f;
  u32x4 ra0[4], rb0[4], ra1[4], rb1[4];
  const int KT = K / BK;
#define G_LOAD(RA, RB, k0) { _Pragma("unroll") for (int i = 0; i < 4; ++i) { RA[i] = *(const u32x4*)(abase + (ao[i] + (unsigned)(k0) * 2u)); RB[i] = *(const u32x4*)(bbase + (bo[i] + (unsigned)(k0) * 2u)); } }
#define S_WRITE(RA, RB, buf) { u16* sa2 = sa + (buf) * 128 * LDP; u16* sb2 = sb + (buf) * 128 * LDP; _Pragma("unroll") for (int i = 0; i < 4; ++i) { *(u32x4*)(sa2 + (lr + 32 * i) * LDP + lc * 8) = RA[i]; *(u32x4*)(sb2 + (lr + 32 * i) * LDP + lc * 8) = RB[i]; } }
#define COMPUTE(buf) { __builtin_amdgcn_iglp_opt(0); const u16* A_ = sa + (buf) * 128 * LDP + (wm * 64 + (lane & 31)) * LDP + (lane >> 5) * 8; const u16* B_ = sb + (buf) * 128 * LDP + (wn * 64 + (lane & 31)) * LDP + (lane >> 5) * 8; \
    _Pragma("unroll") for (int s = 0; s < BK / 16; ++s) { bf16x8 a0 = ld8(A_ + s * 16), a1 = ld8(A_ + 32 * LDP + s * 16); bf16x8 b0 = ld8(B_ + s * 16), b1 = ld8(B_ + 32 * LDP + s * 16); \
      if (SWAP) { acc[0][0] = MFMA32(b0, a0, acc[0][0]); acc[0][1] = MFMA32(b0, a1, acc[0][1]); acc[1][0] = MFMA32(b1, a0, acc[1][0]); acc[1][1] = MFMA32(b1, a1, acc[1][1]); } \
      else { acc[0][0] = MFMA32(a0, b0, acc[0][0]); acc[0][1] = MFMA32(a0, b1, acc[0][1]); acc[1][0] = MFMA32(a1, b0, acc[1][0]); acc[1][1] = MFMA32(a1, b1, acc[1][1]); } } }
  G_LOAD(ra0, rb0, 0);
  S_WRITE(ra0, rb0, 0);
  if (KT > 1) G_LOAD(ra1, rb1, BK);
  __syncthreads();
  for (int kt = 0; kt < KT; kt += 2) {
    if (kt + 2 < KT) G_LOAD(ra0, rb0, (kt + 2) * BK);
    __builtin_amdgcn_sched_barrier(0);
    __builtin_amdgcn_s_setprio(1);
    COMPUTE(0);
    __builtin_amdgcn_s_setprio(0);
    if (kt + 1 < KT) S_WRITE(ra1, rb1, 1);
    __syncthreads();
    if (kt + 1 >= KT) break;
    if (kt + 3 < KT) G_LOAD(ra1, rb1, (kt + 3) * BK);
    __builtin_amdgcn_sched_barrier(0);
    __builtin_amdgcn_s_setprio(1);
    COMPUTE(1);
    __builtin_amdgcn_s_setprio(0);
    if (kt + 2 < KT) S_WRITE(ra0, rb0, 0);
    __syncthreads();
  }
#undef G_LOAD
#undef S_WRITE
#undef COMPUTE
  epi(acc, m0 + wm * 64, n0 + wn * 64, lane);
}

template <class RowA, class Epi>
DI void gemm_tile(const RowA& rowA, const u16* __restrict__ Bt, int ldb, int K, int m0, int n0, u16* sm, const Epi& epi) { gemm_tile_t<false>(rowA, Bt, ldb, K, m0, n0, sm, epi); }
template <class RowA, class Epi>
DI void gemm_tile_sw(const RowA& rowA, const u16* __restrict__ Bt, int ldb, int K, int m0, int n0, u16* sm, const Epi& epi) { gemm_tile_t<true>(rowA, Bt, ldb, K, m0, n0, sm, epi); }

template <class RowA, class Epi>
DI void gemm_tile256(const RowA& rowA, const u16* __restrict__ Bt, int ldb, int K, int m0, int n0, u16* sm, const Epi& epi) {
  const int tid = ltid(), lane = tid & 63, w = tid >> 6, wm = w >> 1, wn = w & 1;
  const int lr = tid >> 2, lc = tid & 3;
  u16* sa = sm; u16* sb = sm + 2 * 128 * LDP2;
  const char* abase = (const char*)rowA.base; const char* bbase = (const char*)Bt;
  unsigned ao[2], bo[4];
#pragma unroll
  for (int i = 0; i < 2; ++i) ao[i] = rowA.off(m0 + lr + 64 * i) + lc * 16;
#pragma unroll
  for (int i = 0; i < 4; ++i) bo[i] = (unsigned)((n0 + lr + 64 * i) * ldb + lc * 8) * 2u;
  f32x16 acc[2][4];
#pragma unroll
  for (int a = 0; a < 2; ++a)
#pragma unroll
    for (int b = 0; b < 4; ++b)
#pragma unroll
      for (int i = 0; i < 16; ++i) acc[a][b][i] = 0.f;
  u32x4 ra0[2], rb0[4], ra1[2], rb1[4];
  const int KT = K / BK2;
#define G_LOAD(RA, RB, k0) { _Pragma("unroll") for (int i = 0; i < 2; ++i) RA[i] = *(const u32x4*)(abase + (ao[i] + (unsigned)(k0) * 2u)); \
    _Pragma("unroll") for (int i = 0; i < 4; ++i) RB[i] = *(const u32x4*)(bbase + (bo[i] + (unsigned)(k0) * 2u)); }
#define S_WRITE(RA, RB, buf) { u16* sa2 = sa + (buf) * 128 * LDP2; u16* sb2 = sb + (buf) * 256 * LDP2; \
    _Pragma("unroll") for (int i = 0; i < 2; ++i) *(u32x4*)(sa2 + (lr + 64 * i) * LDP2 + lc * 8) = RA[i]; \
    _Pragma("unroll") for (int i = 0; i < 4; ++i) *(u32x4*)(sb2 + (lr + 64 * i) * LDP2 + lc * 8) = RB[i]; }
#define COMPUTE(buf) { __builtin_amdgcn_iglp_opt(0); const u16* A_ = sa + (buf) * 128 * LDP2 + (wm * 64 + (lane & 31)) * LDP2 + (lane >> 5) * 8; const u16* B_ = sb + (buf) * 256 * LDP2 + (wn * 128 + (lane & 31)) * LDP2 + (lane >> 5) * 8; \
    _Pragma("unroll") for (int s = 0; s < BK2 / 16; ++s) { bf16x8 a0 = ld8(A_ + s * 16), a1 = ld8(A_ + 32 * LDP2 + s * 16); \
      _Pragma("unroll") for (int nt = 0; nt < 4; ++nt) { bf16x8 bq = ld8(B_ + nt * 32 * LDP2 + s * 16); acc[0][nt] = MFMA32(a0, bq, acc[0][nt]); acc[1][nt] = MFMA32(a1, bq, acc[1][nt]); } } }
  G_LOAD(ra0, rb0, 0);
  S_WRITE(ra0, rb0, 0);
  if (KT > 1) G_LOAD(ra1, rb1, BK2);
  __syncthreads();
  for (int kt = 0; kt < KT; kt += 2) {
    if (kt + 2 < KT) G_LOAD(ra0, rb0, (kt + 2) * BK2);
    __builtin_amdgcn_sched_barrier(0);
    __builtin_amdgcn_s_setprio(1);
    COMPUTE(0);
    __builtin_amdgcn_s_setprio(0);
    if (kt + 1 < KT) S_WRITE(ra1, rb1, 1);
    __syncthreads();
    if (kt + 1 >= KT) break;
    if (kt + 3 < KT) G_LOAD(ra1, rb1, (kt + 3) * BK2);
    __builtin_amdgcn_sched_barrier(0);
    __builtin_amdgcn_s_setprio(1);
    COMPUTE(1);
    __builtin_amdgcn_s_setprio(0);
    if (kt + 2 < KT) S_WRITE(ra0, rb0, 0);
    __syncthreads();
  }
#undef G_LOAD
#undef S_WRITE
#undef COMPUTE
#pragma unroll
  for (int hf = 0; hf < 2; ++hf) {
    f32x16 sub[2][2];
#pragma unroll
    for (int a = 0; a < 2; ++a)
#pragma unroll
      for (int b = 0; b < 2; ++b) sub[a][b] = acc[a][2 * hf + b];
    epi(sub, m0 + wm * 64, n0 + wn * 128 + hf * 64, lane);
  }
}

struct EpiIn {
  char* u; const float* rope; float* rc;
  DI void operator()(f32x16 (&acc)[2][2], int mbase, int nbase, int lane) const {
    const int cgp = nbase >> 6, l32 = lane & 31, hh = lane >> 5;
    if (cgp < 8) {
      u16* dst = (u16*)(u + (cgp < 4 ? U_QA : U_KA)); const int c0 = (cgp & 3) * 64;
#pragma unroll
      for (int mt = 0; mt < 2; ++mt)
#pragma unroll
        for (int nt = 0; nt < 2; ++nt)
#pragma unroll
          for (int i = 0; i < 16; ++i) {
            const int row = mbase + mt * 32 + crow(i, hh);
            float v = acc[mt][nt][i]; float pv = __shfl_xor(v, 4);
            if (l32 < 8) { const int fi = l32 & 3; float c = rope[row * 24 + fi], s = rope[row * 24 + 4 + fi]; v = (l32 < 4) ? v * c - pv * s : v * c + pv * s; }
            dst[(size_t)row * 256 + c0 + nt * 32 + l32] = f2bf(v);
          }
    } else if (cgp < 12) {
      u16* dst = (u16*)(u + U_VAT); const int head = cgp - 8;
#pragma unroll
      for (int mt = 0; mt < 2; ++mt)
#pragma unroll
        for (int nt = 0; nt < 2; ++nt)
#pragma unroll
          for (int g = 0; g < 4; ++g) {
            const int row = mbase + mt * 32 + 8 * g + 4 * hh; const int b = row >> 11, t = row & 2047; const int dv = nt * 32 + l32;
            store4bf(dst + ((size_t)((b * 4 + head) * 64 + dv)) * SEQ + t, acc[mt][nt][4 * g], acc[mt][nt][4 * g + 1], acc[mt][nt][4 * g + 2], acc[mt][nt][4 * g + 3]);
          }
    } else if (cgp < 24) {
      const bool isq = cgp < 18;
      u16* dst = (u16*)(u + (isq ? U_QB : U_KB)); const int c0 = (cgp - (isq ? 12 : 18)) * 64;
#pragma unroll
      for (int mt = 0; mt < 2; ++mt)
#pragma unroll
        for (int nt = 0; nt < 2; ++nt)
#pragma unroll
          for (int i = 0; i < 16; ++i) {
            const int row = mbase + mt * 32 + crow(i, hh);
            float v = acc[mt][nt][i];
            if (nt == 0) {
              float pv = __shfl_xor(v, 8);
              if (l32 < 16) { const int fi = l32 & 7; float c = rope[row * 24 + 8 + fi], s = rope[row * 24 + 16 + fi]; v = (l32 < 8) ? v * c - pv * s : v * c + pv * s; }
            }
            dst[(size_t)row * 384 + c0 + nt * 32 + l32] = f2bf(v);
          }
    } else if (cgp < 30) {
      u16* d0 = (u16*)(u + U_VBT); u16* d1 = d0 + (size_t)MTOK * 384; u16* d2 = d1 + (size_t)MTOK * 384; const int head = cgp - 24;
#pragma unroll
      for (int mt = 0; mt < 2; ++mt)
#pragma unroll
        for (int nt = 0; nt < 2; ++nt)
#pragma unroll
          for (int g = 0; g < 4; ++g) {
            const int row = mbase + mt * 32 + 8 * g + 4 * hh; const int b = row >> 11, t = row & 2047; const int dv = nt * 32 + l32;
            const size_t rb_ = ((size_t)((b * 6 + head) * 64 + dv)) * SEQ;
            store4bf(d0 + rb_ + t, acc[mt][nt][4 * g], acc[mt][nt][4 * g + 1], acc[mt][nt][4 * g + 2], acc[mt][nt][4 * g + 3]);
#pragma unroll
            for (int j = 0; j < 4; ++j) {
              const int tt = t + j; const u16 bv = f2bf(acc[mt][nt][4 * g + j]);
              d1[rb_ + (tt & 3) * 512 + (tt >> 2)] = bv;
              d2[rb_ + (tt & 15) * 128 + (tt >> 4)] = bv;
            }
          }
    } else if (cgp < 48) {
      u16* dst = (u16*)(u + U_HC); const int c0 = (cgp - 30) * 64;
#pragma unroll
      for (int mt = 0; mt < 2; ++mt)
#pragma unroll
        for (int nt = 0; nt < 2; ++nt)
#pragma unroll
          for (int i = 0; i < 16; ++i) {
            const int row = mbase + mt * 32 + crow(i, hh);
            dst[(size_t)row * 1152 + c0 + nt * 32 + l32] = f2bf(acc[mt][nt][i]);
          }
    } else if (cgp == 48) {
      if (l32 < 16) {
#pragma unroll
        for (int mt = 0; mt < 2; ++mt)
#pragma unroll
          for (int i = 0; i < 16; ++i) { const int row = mbase + mt * 32 + crow(i, hh); rc[(size_t)row * 16 + l32] = acc[mt][0][i]; }
      }
    }
  }
};

struct EpiKV {
  u16* kx; u16* vt;
  DI void operator()(f32x16 (&acc)[2][2], int mbase, int nbase, int lane) const {
    const int l32 = lane & 31, hh = lane >> 5;
    if (nbase < 1024) {
#pragma unroll
      for (int mt = 0; mt < 2; ++mt)
#pragma unroll
        for (int nt = 0; nt < 2; ++nt)
#pragma unroll
          for (int i = 0; i < 16; ++i) { const int row = mbase + mt * 32 + crow(i, hh); kx[(size_t)row * 1024 + nbase + nt * 32 + l32] = f2bf(acc[mt][nt][i]); }
    } else {
#pragma unroll
      for (int mt = 0; mt < 2; ++mt)
#pragma unroll
        for (int nt = 0; nt < 2; ++nt)
#pragma unroll
          for (int g = 0; g < 4; ++g) {
            const int row = mbase + mt * 32 + 8 * g + 4 * hh; const int b = row >> 8, key = row & 255; const int c = nbase - 1024 + nt * 32 + l32;
            store4bf(vt + ((size_t)(b * 1024 + c)) * 256 + key, acc[mt][nt][4 * g], acc[mt][nt][4 * g + 1], acc[mt][nt][4 * g + 2], acc[mt][nt][4 * g + 3]);
          }
    }
  }
};

struct EpiResid {
  const float* src; const float* stats; const float* g; const float* b; float* y; int mode;
  DI void operator()(f32x16 (&acc)[2][2], int mbase, int nbase, int lane) const {
    const int l32 = lane & 31, hh = lane >> 5;
    float gg[2] = {1.f, 1.f}, bb[2] = {0.f, 0.f};
    if (mode) { gg[0] = g[nbase + l32]; gg[1] = g[nbase + 32 + l32]; bb[0] = b[nbase + l32]; bb[1] = b[nbase + 32 + l32]; }
#pragma unroll
    for (int mt = 0; mt < 2; ++mt)
#pragma unroll
      for (int i = 0; i < 16; ++i) {
        const int row = mbase + mt * 32 + crow(i, hh);
        float mean = 0.f, rstd = 1.f;
        if (mode) { const float2 st = *(const float2*)(stats + (size_t)row * 2); mean = st.x; rstd = st.y; }
#pragma unroll
        for (int nt = 0; nt < 2; ++nt) {
          const size_t o = (size_t)row * 1024 + nbase + nt * 32 + l32;
          const float r = (src[o] - mean) * rstd * gg[nt] + bb[nt];
          y[o] = ALPHA * r + acc[mt][nt][i];
        }
      }
  }
};

struct EpiResidT {
  const float* src; const float* stats; const float* g; const float* b; float* y; int mode;
  DI void operator()(f32x16 (&acc)[2][2], int mbase, int nbase, int lane) const {
    const int l32 = lane & 31, hh = lane >> 5;
#pragma unroll
    for (int mt = 0; mt < 2; ++mt) {
      const int row = mbase + mt * 32 + l32;
      float mean = 0.f, rstd = 1.f;
      if (mode) { const float2 st = *(const float2*)(stats + (size_t)row * 2); mean = st.x; rstd = st.y; }
#pragma unroll
      for (int nt = 0; nt < 2; ++nt)
#pragma unroll
        for (int gq = 0; gq < 4; ++gq) {
          const int c0 = nbase + nt * 32 + 8 * gq + 4 * hh;
          const size_t o = (size_t)row * 1024 + c0;
          float4 r = *(const float4*)(src + o);
          if (mode) {
            const float4 gv = *(const float4*)(g + c0), bv = *(const float4*)(b + c0);
            r.x = (r.x - mean) * rstd * gv.x + bv.x; r.y = (r.y - mean) * rstd * gv.y + bv.y; r.z = (r.z - mean) * rstd * gv.z + bv.z; r.w = (r.w - mean) * rstd * gv.w + bv.w;
          }
          float4 ov;
          ov.x = ALPHA * r.x + acc[nt][mt][4 * gq]; ov.y = ALPHA * r.y + acc[nt][mt][4 * gq + 1]; ov.z = ALPHA * r.z + acc[nt][mt][4 * gq + 2]; ov.w = ALPHA * r.w + acc[nt][mt][4 * gq + 3];
          *(float4*)(y + o) = ov;
        }
    }
  }
};

struct EpiBfT {
  u16* dst; int ld;
  DI void operator()(f32x16 (&acc)[2][2], int mbase, int nbase, int lane) const {
    const int l32 = lane & 31, hh = lane >> 5;
#pragma unroll
    for (int mt = 0; mt < 2; ++mt)
#pragma unroll
      for (int nt = 0; nt < 2; ++nt)
#pragma unroll
        for (int gq = 0; gq < 4; ++gq)
          store4bf(dst + (size_t)(mbase + mt * 32 + l32) * ld + nbase + nt * 32 + 8 * gq + 4 * hh, acc[nt][mt][4 * gq], acc[nt][mt][4 * gq + 1], acc[nt][mt][4 * gq + 2], acc[nt][mt][4 * gq + 3]);
  }
};

struct EpiMoe2T {
  u16* mo; const int* list; const float* gl; int cnt;
  DI void operator()(f32x16 (&acc)[2][2], int mbase, int nbase, int lane) const {
    const int l32 = lane & 31, hh = lane >> 5;
#pragma unroll
    for (int mt = 0; mt < 2; ++mt) {
      const int r = mbase + mt * 32 + l32;
      if (r < cnt) {
        const int tk = list[r]; const float gw = gl[r];
#pragma unroll
        for (int nt = 0; nt < 2; ++nt)
#pragma unroll
          for (int gq = 0; gq < 4; ++gq)
            store4bf(mo + (size_t)tk * 1024 + nbase + nt * 32 + 8 * gq + 4 * hh, gw * acc[nt][mt][4 * gq], gw * acc[nt][mt][4 * gq + 1], gw * acc[nt][mt][4 * gq + 2], gw * acc[nt][mt][4 * gq + 3]);
      }
    }
  }
};

struct EpiBf {
  u16* dst; int ld;
  DI void operator()(f32x16 (&acc)[2][2], int mbase, int nbase, int lane) const {
    const int l32 = lane & 31, hh = lane >> 5;
#pragma unroll
    for (int mt = 0; mt < 2; ++mt)
#pragma unroll
      for (int nt = 0; nt < 2; ++nt)
#pragma unroll
        for (int i = 0; i < 16; ++i) dst[(size_t)(mbase + mt * 32 + crow(i, hh)) * ld + nbase + nt * 32 + l32] = f2bf(acc[mt][nt][i]);
  }
};

struct EpiSwiglu {
  u16* hid; int ld; int rowoff;
  DI void operator()(f32x16 (&acc)[2][2], int mbase, int nbase, int lane) const {
    const int l32 = lane & 31, hh = lane >> 5; const int hc = (nbase >> 6) * 32 + l32;
#pragma unroll
    for (int mt = 0; mt < 2; ++mt)
#pragma unroll
      for (int i = 0; i < 16; ++i) {
        const float g = acc[mt][0][i], up = acc[mt][1][i];
        const float h = g * __builtin_amdgcn_rcpf(1.f + __expf(-g)) * up;
        hid[(size_t)(rowoff + mbase + mt * 32 + crow(i, hh)) * ld + hc] = f2bf(h);
      }
  }
};

struct EpiMoe2 {
  u16* mo; const int* list; const float* gl; int cnt;
  DI void operator()(f32x16 (&acc)[2][2], int mbase, int nbase, int lane) const {
    const int l32 = lane & 31, hh = lane >> 5;
#pragma unroll
    for (int mt = 0; mt < 2; ++mt)
#pragma unroll
      for (int i = 0; i < 16; ++i) {
        const int r = mbase + mt * 32 + crow(i, hh);
        if (r < cnt) {
          const int tk = list[r]; const float gw = gl[r];
#pragma unroll
          for (int nt = 0; nt < 2; ++nt) mo[(size_t)tk * 1024 + nbase + nt * 32 + l32] = f2bf(gw * acc[mt][nt][i]);
        }
      }
  }
};

DI int dst_row(int n, int mode, int N) {
  if (mode == 0) return n;
  const int F = N >> 1;
  return n < F ? ((n >> 5) * 64 + (n & 31)) : (((n - F) >> 5) * 64 + 32 + ((n - F) & 31));
}
constexpr int TR_TILES = 2 * 2080 + 1408 + 704 + 8 * 1792 + 8 * 896;
DI void get_job(const Params& p, int t, Job& jb, int& lt) {
  char* ws = lws(p);
  if (t < 4160) {
    const int l = t / 2080, r = t % 2080;
    if (r < 800) { jb.src = p.w_in + (size_t)l * 1024 * 3088; jb.dst = (u16*)(ws + OFF_WT_IN) + (size_t)l * INP * 1024; jb.K = 1024; jb.N = 3088; jb.Npad = INP; jb.mode = 0; lt = r; }
    else if (r < 1056) { jb.src = p.w_out + (size_t)l * 1024 * 1024; jb.dst = (u16*)(ws + OFF_WT_OUT) + (size_t)l * 1024 * 1024; jb.K = 1024; jb.N = 1024; jb.Npad = 1024; jb.mode = 0; lt = r - 800; }
    else if (r < 1312) { jb.src = p.xa_wq + (size_t)l * 1024 * 1024; jb.dst = (u16*)(ws + OFF_WT_Q) + (size_t)l * 1024 * 1024; jb.K = 1024; jb.N = 1024; jb.Npad = 1024; jb.mode = 0; lt = r - 1056; }
    else if (r < 1824) { jb.src = p.xa_wkv + (size_t)l * 1024 * 2048; jb.dst = (u16*)(ws + OFF_WT_KV) + (size_t)l * 2048 * 1024; jb.K = 1024; jb.N = 2048; jb.Npad = 2048; jb.mode = 0; lt = r - 1312; }
    else { jb.src = p.xa_wo + (size_t)l * 1024 * 1024; jb.dst = (u16*)(ws + OFF_WT_O) + (size_t)l * 1024 * 1024; jb.K = 1024; jb.N = 1024; jb.Npad = 1024; jb.mode = 0; lt = r - 1824; }
  } else if (t < 5568) { jb.src = p.ffd_w13; jb.dst = (u16*)(ws + OFF_WT_F13); jb.K = 1024; jb.N = 2 * FD; jb.Npad = 2 * FD; jb.mode = 1; lt = t - 4160; }
  else if (t < 6272) { jb.src = p.ffd_w2; jb.dst = (u16*)(ws + OFF_WT_F2); jb.K = FD; jb.N = 1024; jb.Npad = 1024; jb.mode = 0; lt = t - 5568; }
  else if (t < 20608) { const int e = (t - 6272) / 1792; jb.src = p.moe_w13 + (size_t)e * 1024 * 2 * FM; jb.dst = (u16*)(ws + OFF_WT_M13) + (size_t)e * 2 * FM * 1024; jb.K = 1024; jb.N = 2 * FM; jb.Npad = 2 * FM; jb.mode = 1; lt = (t - 6272) % 1792; }
  else { const int e = (t - 20608) / 896; jb.src = p.moe_w2 + (size_t)e * FM * 1024; jb.dst = (u16*)(ws + OFF_WT_M2) + (size_t)e * 1024 * FM; jb.K = FM; jb.N = 1024; jb.Npad = 1024; jb.mode = 0; lt = (t - 20608) % 896; }
}
DI void tr_load(const Job& jb, int lt, float (&v)[16]) {
  const int tid = ltid(); const int tn = jb.Npad >> 6; const int tk = lt / tn, tnn = lt % tn; const int k0 = tk * 64, n0 = tnn * 64;
  const int j = tid & 63;
#pragma unroll
  for (int i = 0; i < 16; ++i) {
    const int k = i * 4 + (tid >> 6);
    v[i] = (n0 + j < jb.N) ? jb.src[(size_t)(k0 + k) * jb.N + n0 + j] : 0.f;
  }
}
DI void tr_store(const Job& jb, int lt, const float (&v)[16], float* ts) {
  const int tid = ltid(); const int tn = jb.Npad >> 6; const int tk = lt / tn, tnn = lt % tn; const int k0 = tk * 64, n0 = tnn * 64;
  const int j = tid & 63;
#pragma unroll
  for (int i = 0; i < 16; ++i) ts[(i * 4 + (tid >> 6)) * 65 + j] = v[i];
  __syncthreads();
  const int nr = tid >> 2; const int drow = (n0 + nr < jb.N) ? dst_row(n0 + nr, jb.mode, jb.N) : (n0 + nr);
#pragma unroll
  for (int cc = 0; cc < 2; ++cc) {
    const int c = (tid & 3) + 4 * cc; const float* t0 = ts + (c * 8) * 65 + nr;
    u32x4 u = {pack2(t0[0], t0[65]), pack2(t0[130], t0[195]), pack2(t0[260], t0[325]), pack2(t0[390], t0[455])};
    *(u32x4*)(jb.dst + (size_t)drow * jb.K + k0 + c * 8) = u;
  }
  __syncthreads();
}
DI void sincos_acc(float ang, float& c, float& s) {
  const double x = (double)ang;
  const double n = rint(x * 0.63661977236758134308);
  double r = fma(-n, 1.57079632679489655800e+00, x);
  r = fma(-n, 6.12323399573676603587e-17, r);
  const double r2 = r * r;
  double sp = -7.6471637318198164759e-13; sp = fma(sp, r2, 1.6059043836821614599e-10); sp = fma(sp, r2, -2.5052108385441718775e-8);
  sp = fma(sp, r2, 2.7557319223985890653e-6); sp = fma(sp, r2, -1.9841269841269841270e-4); sp = fma(sp, r2, 8.3333333333333333333e-3);
  sp = fma(sp, r2, -1.6666666666666666667e-1); const double sv = fma(sp * r2, r, r);
  double cp = 4.7794773323873852974e-14; cp = fma(cp, r2, -1.1470745597729724714e-11); cp = fma(cp, r2, 2.0876756987868098979e-9);
  cp = fma(cp, r2, -2.7557319223985890653e-7); cp = fma(cp, r2, 2.4801587301587301587e-5); cp = fma(cp, r2, -1.3888888888888888889e-3);
  cp = fma(cp, r2, 4.1666666666666666667e-2); cp = fma(cp, r2, -0.5); const double cv = fma(cp, r2, 1.0);
  const int q = ((int)n) & 3;
  const double so = (q == 0) ? sv : (q == 1) ? cv : (q == 2) ? -sv : -cv;
  const double co = (q == 0) ? cv : (q == 1) ? -sv : (q == 2) ? -cv : sv;
  c = (float)co; s = (float)so;
}

DI void softmax_tile(f32x16& S, float& mrun, float& lrun, float& corr, bf16x8& p0, bf16x8& p1) {
  float tmax = S[0];
#pragma unroll
  for (int i = 1; i < 16; ++i) tmax = fmaxf(tmax, S[i]);
  tmax = fmaxf(tmax, __shfl_xor(tmax, 32));
  const float mnew = fmaxf(mrun, tmax);
  corr = ex2(mrun - mnew);
  float ps = 0.f;
#pragma unroll
  for (int i = 0; i < 16; ++i) { S[i] = ex2(S[i] - mnew); ps += S[i]; }
  lrun = lrun * corr + ps; mrun = mnew;
  p0 = pack8(S[0], S[1], S[2], S[3], S[4], S[5], S[6], S[7]);
  p1 = pack8(S[8], S[9], S[10], S[11], S[12], S[13], S[14], S[15]);
}

DI void vperm_store(u16* row, int ch, u32x4 v) {
  const int s = ch >> 1, c = ch & 1;
  u32x2 lo = {v[0], v[1]}, hi = {v[2], v[3]};
  *(u32x2*)(row + 16 * s + 4 * c) = lo;
  *(u32x2*)(row + 16 * s + 8 + 4 * c) = hi;
}

DI void mixA_block(const Params& p, int L, int b, int h, int qblk, float lam, float lam_init, char* smem) {
  const int tid = ltid(), lane = tid & 63, w = tid >> 6, l32 = lane & 31, hh = lane >> 5;
  char* wsl_ = lws(p);
  char* u = wsl_ + OFF_UNION;
  const int q0 = qblk * 128 + w * 32;
  const u16* Q = (const u16*)(u + U_QA) + (size_t)(b * SEQ) * 256 + h * 64;
  const u16* Kg = (const u16*)(u + U_KA) + (size_t)(b * SEQ) * 256 + h * 64;
  const u16* Vg = (const u16*)(u + U_VAT) + (size_t)((b * 4 + h) * 64) * SEQ;
  u16* Ks = (u16*)smem; u16* Vs = Ks + 2 * 64 * 72;
  bf16x8 qf[2][2];
#pragma unroll
  for (int mp = 0; mp < 2; ++mp)
#pragma unroll
    for (int s = 0; s < 2; ++s) qf[mp][s] = ld8(Q + (size_t)(q0 + l32) * 256 + mp * 32 + s * 16 + hh * 8);
  f32x16 O[2][2];
#pragma unroll
  for (int a = 0; a < 2; ++a)
#pragma unroll
    for (int c = 0; c < 2; ++c)
#pragma unroll
      for (int i = 0; i < 16; ++i) O[a][c][i] = 0.f;
  float mrun[2] = {-1e30f, -1e30f}, lrun[2] = {0.f, 0.f};
  const float sc = 0.17677669529663687f * LOG2E;
  const int nkt = 2 * (qblk + 1);
  const int r0 = tid >> 3, ch = tid & 7;
  u32x4 rk[2], rv[2];
#pragma unroll
  for (int i = 0; i < 2; ++i) {
    rk[i] = *(const u32x4*)(Kg + (size_t)(r0 + 32 * i) * 256 + ch * 8);
    rv[i] = *(const u32x4*)(Vg + (size_t)(r0 + 32 * i) * SEQ + ch * 8);
  }
#pragma unroll
  for (int i = 0; i < 2; ++i) { *(u32x4*)(Ks + (r0 + 32 * i) * 72 + ch * 8) = rk[i]; vperm_store(Vs + (r0 + 32 * i) * 72, ch, rv[i]); }
  __syncthreads();
  for (int kt = 0; kt < nkt; ++kt) {
    const int buf = kt & 1;
    if (kt + 1 < nkt) {
      const int k1 = (kt + 1) * 64;
#pragma unroll
      for (int i = 0; i < 2; ++i) {
        rk[i] = *(const u32x4*)(Kg + (size_t)(k1 + r0 + 32 * i) * 256 + ch * 8);
        rv[i] = *(const u32x4*)(Vg + (size_t)(r0 + 32 * i) * SEQ + k1 + ch * 8);
      }
    }
    __builtin_amdgcn_sched_barrier(0);
    const u16* Kb = Ks + buf * 64 * 72; const u16* Vb = Vs + buf * 64 * 72;
#pragma unroll
    for (int ks = 0; ks < 2; ++ks) {
      const int kb = kt * 64 + ks * 32;
      if (kb <= q0) {
        const bool diag = (kb == q0);
        bf16x8 vf[2][2];
#pragma unroll
        for (int mt = 0; mt < 2; ++mt)
#pragma unroll
          for (int s2 = 0; s2 < 2; ++s2) vf[mt][s2] = ld8(Vb + (mt * 32 + l32) * 72 + (ks * 2 + s2) * 16 + hh * 8);
#pragma unroll
        for (int mp = 0; mp < 2; ++mp) {
          f32x16 S;
#pragma unroll
          for (int i = 0; i < 16; ++i) S[i] = 0.f;
          S = MFMA32(ld8(Kb + (ks * 32 + l32) * 72 + mp * 32 + hh * 8), qf[mp][0], S);
          S = MFMA32(ld8(Kb + (ks * 32 + l32) * 72 + mp * 32 + 16 + hh * 8), qf[mp][1], S);
#pragma unroll
          for (int i = 0; i < 16; ++i) { const float v = S[i] * sc; S[i] = (diag && crow(i, hh) > l32) ? -1e30f : v; }
          float corr; bf16x8 pf0, pf1;
          softmax_tile(S, mrun[mp], lrun[mp], corr, pf0, pf1);
#pragma unroll
          for (int mt = 0; mt < 2; ++mt) {
#pragma unroll
            for (int i = 0; i < 16; ++i) O[mp][mt][i] *= corr;
            O[mp][mt] = MFMA32(vf[mt][0], pf0, O[mp][mt]);
            O[mp][mt] = MFMA32(vf[mt][1], pf1, O[mp][mt]);
          }
        }
      }
    }
    if (kt + 1 < nkt) {
      u16* Kn = Ks + (buf ^ 1) * 64 * 72; u16* Vn = Vs + (buf ^ 1) * 64 * 72;
#pragma unroll
      for (int i = 0; i < 2; ++i) { *(u32x4*)(Kn + (r0 + 32 * i) * 72 + ch * 8) = rk[i]; vperm_store(Vn + (r0 + 32 * i) * 72, ch, rv[i]); }
    }
    __syncthreads();
  }
  const float l0 = lrun[0] + __shfl_xor(lrun[0], 32), l1 = lrun[1] + __shfl_xor(lrun[1], 32);
  const float i0 = 1.f / l0, i1 = lam / l1;
  float ssq = 0.f;
#pragma unroll
  for (int mt = 0; mt < 2; ++mt)
#pragma unroll
    for (int i = 0; i < 16; ++i) { const float o = O[0][mt][i] * i0 - O[1][mt][i] * i1; O[0][mt][i] = o; ssq += o * o; }
  ssq += __shfl_xor(ssq, 32);
  const float rs = rsqrtf(ssq * (1.f / 64.f) + LN_EPS) * (1.f - lam_init);
  const float* gg = p.diff_g + L * 64;
  u16* om = (u16*)(u + U_OMIX) + (size_t)(b * SEQ + q0 + l32) * 1024 + h * 64;
#pragma unroll
  for (int mt = 0; mt < 2; ++mt)
#pragma unroll
    for (int g = 0; g < 4; ++g) {
      const int dv = mt * 32 + 8 * g + 4 * hh;
      store4bf(om + dv, O[0][mt][4 * g] * rs * gg[dv], O[0][mt][4 * g + 1] * rs * gg[dv + 1], O[0][mt][4 * g + 2] * rs * gg[dv + 2], O[0][mt][4 * g + 3] * rs * gg[dv + 3]);
    }
}

DI void mixB_block(const Params& p, int b, int h, int g, int sb, char* smem) {
  const int tid = ltid(), lane = tid & 63, w = tid >> 6, l32 = lane & 31, hh = lane >> 5;
  char* wsl_ = lws(p);
  char* u = wsl_ + OFF_UNION;
  const int rsh = 2 * g; const int r = 1 << rsh; const int sub_len = SEQ >> rsh; const int tpr = sub_len >> 5;
  const int rho = (sb * 4) / tpr, it0 = (sb * 4) % tpr; const int i0 = it0 * 32;
  const u16* Q = (const u16*)(u + U_QB) + (size_t)(b * SEQ) * 384 + h * 64;
  const u16* Kg = (const u16*)(u + U_KB) + (size_t)(b * SEQ) * 384 + h * 64;
  const u16* Vg = (const u16*)(u + U_VBT) + (size_t)g * MTOK * 384 + (size_t)((b * 6 + h) * 64) * SEQ + rho * sub_len;
  u16* Ks = (u16*)smem; u16* Vs = Ks + 256 * 72;
  const int kbase = i0 - 128;
#pragma unroll
  for (int i = 0; i < 8; ++i) {
    const int c = tid + 256 * i;
    { const int row = c >> 3, ch = c & 7; const int ki = kbase + row;
      if (ki >= 0) *(u32x4*)(Ks + row * 72 + ch * 8) = *(const u32x4*)(Kg + (size_t)(ki * r + rho) * 384 + ch * 8); }
    { const int dv = c >> 5, ch = c & 31; const int ki = kbase + ch * 8;
      if (ki >= 0) vperm_store(Vs + dv * 264, ch, *(const u32x4*)(Vg + (size_t)dv * SEQ + ki)); }
  }
  const int iq = i0 + w * 32;
  const int tq = (iq + l32) * r + rho;
  bf16x8 qf[4];
#pragma unroll
  for (int s = 0; s < 4; ++s) qf[s] = ld8(Q + (size_t)tq * 384 + s * 16 + hh * 8);
  __syncthreads();
  f32x16 O[2];
#pragma unroll
  for (int a = 0; a < 2; ++a)
#pragma unroll
    for (int i = 0; i < 16; ++i) O[a][i] = 0.f;
  float mrun = -1e30f, lrun = 0.f;
  const float sc = 0.125f * LOG2E;
  for (int kt = 0; kt < 5; ++kt) {
    const int lb = 32 * w + 32 * kt;
    if (kbase + lb < 0) continue;
    f32x16 S;
#pragma unroll
    for (int i = 0; i < 16; ++i) S[i] = 0.f;
#pragma unroll
    for (int s = 0; s < 4; ++s) S = MFMA32(ld8(Ks + (lb + l32) * 72 + s * 16 + hh * 8), qf[s], S);
#pragma unroll
    for (int i = 0; i < 16; ++i) {
      const float v = S[i] * sc; const int kk = crow(i, hh);
      const bool bad = (kt == 0 && kk < l32) || (kt == 4 && kk > l32);
      S[i] = bad ? -1e30f : v;
    }
    float corr; bf16x8 pf0, pf1;
    softmax_tile(S, mrun, lrun, corr, pf0, pf1);
#pragma unroll
    for (int mt = 0; mt < 2; ++mt) {
#pragma unroll
      for (int i = 0; i < 16; ++i) O[mt][i] *= corr;
      O[mt] = MFMA32(ld8(Vs + (mt * 32 + l32) * 264 + lb + hh * 8), pf0, O[mt]);
      O[mt] = MFMA32(ld8(Vs + (mt * 32 + l32) * 264 + lb + 16 + hh * 8), pf1, O[mt]);
    }
  }
  const float lt = lrun + __shfl_xor(lrun, 32);
  const float inv = 1.f / lt;
  const size_t tok = (size_t)b * SEQ + tq;
  u16* po = (u16*)(u + U_PBO) + (size_t)g * MTOK * 384 + tok * 384 + h * 64;
#pragma unroll
  for (int mt = 0; mt < 2; ++mt)
#pragma unroll
    for (int gq = 0; gq < 4; ++gq) {
      const int dv = mt * 32 + 8 * gq + 4 * hh;
      store4bf(po + dv, O[mt][4 * gq] * inv, O[mt][4 * gq + 1] * inv, O[mt][4 * gq + 2] * inv, O[mt][4 * gq + 3] * inv);
    }
  if (hh == 0) {
    float* lse = (float*)(wsl_ + OFF_LSE) + (size_t)g * MTOK * 8;
    lse[tok * 8 + h] = (mrun + __builtin_amdgcn_logf(lt)) * LN2;
  }
  __syncthreads();
}

DI void gla_item(const Params& p, int L, int b, int h, int vg, char* smem) {
  const int tid = ltid(), lane = tid & 63, w = tid >> 6;
  char* wsl_ = lws(p);
  const int kg = lane & 15, vl = lane >> 4;
  char* u = wsl_ + OFF_UNION;
  const u16* hc = (const u16*)(u + U_HC);
  const float* rc = (const float*)(wsl_ + OFF_RC);
  float* go = (float*)(u + U_GLAO);
  float* a_s = (float*)smem;
  float* k_s = a_s + 64 * 48;
  float* q_s = k_s + 64 * 48;
  float* vs = q_s + 64 * 48;
  float* os = vs + 64 * 16;
  float* rcs = os + 64 * 16;
  float wcol[16]; float ba = 0.f;
  const int sd = tid % 48, stg = tid / 48;
  if (tid < 192) {
#pragma unroll
    for (int j = 0; j < 16; ++j) wcol[j] = p.gla_wa2[(size_t)L * 16 * 192 + j * 192 + h * 48 + sd];
    ba = p.gla_ba[L * 192 + h * 48 + sd];
  } else {
#pragma unroll
    for (int j = 0; j < 16; ++j) wcol[j] = 0.f;
  }
  float S0 = 0.f, S1 = 0.f, S2 = 0.f;
  const float qsc = 0.14433756729740643f;
  float4 rcv; u32x2 qv[3], kv[3], vv;
  const int t4 = tid >> 2, p4 = tid & 3;
  {
    const size_t rowb = (size_t)b * SEQ;
    rcv = *(const float4*)(rc + (rowb + t4) * 16 + p4 * 4);
#pragma unroll
    for (int i = 0; i < 3; ++i) { const int c = tid + 256 * i; const int tk = c / 12, pt = c % 12; qv[i] = *(const u32x2*)(hc + (rowb + tk) * 1152 + h * 48 + pt * 4); kv[i] = *(const u32x2*)(hc + (rowb + tk) * 1152 + 192 + h * 48 + pt * 4); }
    vv = *(const u32x2*)(hc + (rowb + t4) * 1152 + 384 + h * 96 + vg * 16 + p4 * 4);
  }
  for (int seg = 0; seg < SEQ / 64; ++seg) {
    const size_t rowb = (size_t)b * SEQ + seg * 64;
    *(float4*)(rcs + t4 * 16 + p4 * 4) = rcv;
#pragma unroll
    for (int i = 0; i < 3; ++i) {
      const int c = tid + 256 * i; const int tk = c / 12, pt = c % 12; const int o = tk * 48 + pt * 4;
      *(float4*)(k_s + o) = make_float4(__uint_as_float(kv[i][0] << 16), __uint_as_float(kv[i][0] & 0xffff0000u), __uint_as_float(kv[i][1] << 16), __uint_as_float(kv[i][1] & 0xffff0000u));
      *(float4*)(q_s + o) = make_float4(__uint_as_float(qv[i][0] << 16) * qsc, __uint_as_float(qv[i][0] & 0xffff0000u) * qsc, __uint_as_float(qv[i][1] << 16) * qsc, __uint_as_float(qv[i][1] & 0xffff0000u) * qsc);
    }
    {
      float4 vf4 = make_float4(__uint_as_float(vv[0] << 16), __uint_as_float(vv[0] & 0xffff0000u), __uint_as_float(vv[1] << 16), __uint_as_float(vv[1] & 0xffff0000u));
      *(float4*)(vs + t4 * 16 + p4 * 4) = vf4;
    }
    __syncthreads();
    if (seg + 1 < SEQ / 64) {
      const size_t rn = rowb + 64;
      rcv = *(const float4*)(rc + (rn + t4) * 16 + p4 * 4);
#pragma unroll
      for (int i = 0; i < 3; ++i) { const int c = tid + 256 * i; const int tk = c / 12, pt = c % 12; qv[i] = *(const u32x2*)(hc + (rn + tk) * 1152 + h * 48 + pt * 4); kv[i] = *(const u32x2*)(hc + (rn + tk) * 1152 + 192 + h * 48 + pt * 4); }
      vv = *(const u32x2*)(hc + (rn + t4) * 1152 + 384 + h * 96 + vg * 16 + p4 * 4);
    }
    __builtin_amdgcn_sched_barrier(0);
    if (tid < 192) {
#pragma unroll 4
      for (int tt = 0; tt < 16; ++tt) {
        const int tl = stg * 16 + tt;
        const float4* r4 = (const float4*)(rcs + tl * 16);
        float z = ba;
#pragma unroll
        for (int j4 = 0; j4 < 4; ++j4) { const float4 rv = r4[j4]; z += rv.x * wcol[4 * j4] + rv.y * wcol[4 * j4 + 1] + rv.z * wcol[4 * j4 + 2] + rv.w * wcol[4 * j4 + 3]; }
        const float a = ex2(-0.0625f * __builtin_amdgcn_logf(1.f + ex2(-z * LOG2E)));
        a_s[tl * 48 + sd] = a;
      }
    }
    __syncthreads();
#pragma unroll 1
    for (int tb = 0; tb < 64; tb += 16) {
      float okeep = 0.f;
#pragma unroll
      for (int tt = 0; tt < 16; ++tt) {
        const int tl = tb + tt;
        const int o3 = tl * 48 + kg * 3;
        const float a0 = a_s[o3], a1 = a_s[o3 + 1], a2 = a_s[o3 + 2];
        const float k0_ = k_s[o3], k1_ = k_s[o3 + 1], k2_ = k_s[o3 + 2];
        const float q0_ = q_s[o3], q1_ = q_s[o3 + 1], q2_ = q_s[o3 + 2];
        const float v = vs[tl * 16 + w * 4 + vl];
        S0 = a0 * S0 + k0_ * v; S1 = a1 * S1 + k1_ * v; S2 = a2 * S2 + k2_ * v;
        float o = q0_ * S0 + q1_ * S1 + q2_ * S2;
        o = row16_allsum(o);
        okeep = (kg == tt) ? o : okeep;
      }
      os[(tb + kg) * 16 + w * 4 + vl] = okeep;
    }
    __syncthreads();
    {
      const float4 ov = *(const float4*)(os + t4 * 16 + p4 * 4);
      *(float4*)(go + (rowb + t4) * 384 + h * 96 + vg * 16 + p4 * 4) = ov;
    }
  }
  __syncthreads();
}

DI int perm16(int t) { return (t & ~12) | ((t & 4) << 1) | ((t & 8) >> 1); }
DI void gla_mfma_item(const Params& p, int L, int b, int h, char* smem) {
  const int tid = ltid(), lane = tid & 63, w = tid >> 6, l32 = lane & 31, hh = lane >> 5;
  char* wsl_ = lws(p);
  char* u = wsl_ + OFF_UNION;
  const u16* hc = (const u16*)(u + U_HC);
  const float* rc = (const float*)(wsl_ + OFF_RC);
  float* go = (float*)(u + U_GLAO);
  u16* Qb = (u16*)smem;
  u16* QbP = Qb + 32 * 56;
  u16* Kb = QbP + 32 * 56;
  u16* KlT = Kb + 32 * 56;
  u16* Vt = KlT + 64 * 40;
  float* ebl = (float*)(Vt + 96 * 40);
  float* tot = ebl + 64;
  float* rcs = tot + 4 * 48;
  const int sd = tid % 48, stg = tid / 48;
  float wcol[16]; float ba = 0.f;
#pragma unroll
  for (int j = 0; j < 16; ++j) wcol[j] = (tid < 192) ? p.gla_wa2[(size_t)L * 16 * 192 + j * 192 + h * 48 + sd] : 0.f;
  if (tid < 192) ba = p.gla_ba[L * 192 + h * 48 + sd];
  for (int i = tid; i < 16 * 40; i += NTHR) KlT[48 * 40 + i] = 0;
  if (tid < 64) ebl[tid] = 0.f;
  f32x16 S0, S1;
#pragma unroll
  for (int i = 0; i < 16; ++i) { S0[i] = 0.f; S1[i] = 0.f; }
  const float qsc = 0.14433756729740643f;
  const int sdc = sd < 48 ? sd : 0;
  u16 rq[8], rk[8], rvv[12]; float rr[2];
  const size_t row00 = (size_t)b * SEQ;
  const unsigned oqk = (unsigned)((stg & 3) * 8) * 1152u + (unsigned)(h * 48 + sdc);
#define GL_LOAD(rowb) { const u16* hcb_ = hc + (rowb) * 1152; const float* rcb_ = rc + (rowb) * 16; \
    _Pragma("unroll") for (int tt = 0; tt < 8; ++tt) { rq[tt] = hcb_[oqk + (unsigned)tt * 1152u]; rk[tt] = hcb_[oqk + (unsigned)tt * 1152u + 192u]; } \
    _Pragma("unroll") for (int i = 0; i < 12; ++i) { const unsigned e_ = (unsigned)(tid + 256 * i); rvv[i] = hcb_[(e_ / 96u) * 1152u + 384u + (unsigned)(h * 96) + e_ % 96u]; } \
    _Pragma("unroll") for (int i = 0; i < 2; ++i) rr[i] = rcb_[tid + 256 * i]; }
  GL_LOAD(row00)
  for (int ch = 0; ch < SEQ / 32; ++ch) {
    const size_t rowb = row00 + ch * 32;
    rcs[tid] = rr[0]; rcs[tid + 256] = rr[1];
#pragma unroll
    for (int i = 0; i < 12; ++i) { const int e_ = tid + 256 * i; Vt[(e_ % 96) * 40 + perm16(e_ / 96)] = rvv[i]; }
    __syncthreads();
    float c2[8]; float run = 0.f;
    if (tid < 192) {
#pragma unroll
      for (int tt = 0; tt < 8; ++tt) {
        const float4* r4 = (const float4*)(rcs + (stg * 8 + tt) * 16);
        float z = ba;
#pragma unroll
        for (int j4 = 0; j4 < 4; ++j4) { const float4 rv = r4[j4]; z += rv.x * wcol[4 * j4] + rv.y * wcol[4 * j4 + 1] + rv.z * wcol[4 * j4 + 2] + rv.w * wcol[4 * j4 + 3]; }
        run += -0.0625f * __builtin_amdgcn_logf(1.f + ex2(-z * LOG2E));
        c2[tt] = run;
      }
      tot[stg * 48 + sd] = run;
    } else {
#pragma unroll
      for (int tt = 0; tt < 8; ++tt) c2[tt] = 0.f;
    }
    __syncthreads();
    if (tid < 192) {
      const float t0 = tot[sd], t1 = tot[48 + sd], t2 = tot[96 + sd], t3 = tot[144 + sd];
      const float pre = (stg > 0 ? t0 : 0.f) + (stg > 1 ? t1 : 0.f) + (stg > 2 ? t2 : 0.f);
      const float blast = (t0 + t1) + (t2 + t3);
      if (stg == 0) ebl[sd] = ex2(blast);
#pragma unroll
      for (int tt = 0; tt < 8; ++tt) {
        const int t = stg * 8 + tt; const float b2 = pre + c2[tt];
        const float q = bf2f(rq[tt]) * qsc, k = bf2f(rk[tt]);
        const u16 qb = f2bf(q * ex2(b2));
        Qb[t * 56 + sd] = qb; QbP[t * 56 + perm16(sd)] = qb;
        Kb[t * 56 + sd] = f2bf(k * ex2(-b2));
        KlT[sd * 40 + perm16(t)] = f2bf(k * ex2(blast - b2));
      }
    }
    __syncthreads();
    {
      const size_t rn = row00 + (ch + 1 < SEQ / 32 ? ch + 1 : ch) * 32;
      GL_LOAD(rn)
    }
    __builtin_amdgcn_sched_barrier(0);
    if (w < 3) {
      f32x16 AT;
#pragma unroll
      for (int i = 0; i < 16; ++i) AT[i] = 0.f;
#pragma unroll
      for (int s3 = 0; s3 < 3; ++s3) AT = MFMA32(ld8(Kb + l32 * 56 + s3 * 16 + hh * 8), ld8(Qb + l32 * 56 + s3 * 16 + hh * 8), AT);
#pragma unroll
      for (int i = 0; i < 16; ++i) AT[i] = (crow(i, hh) <= l32) ? AT[i] : 0.f;
      const bf16x8 pA0 = pack8(AT[0], AT[1], AT[2], AT[3], AT[4], AT[5], AT[6], AT[7]);
      const bf16x8 pA1 = pack8(AT[8], AT[9], AT[10], AT[11], AT[12], AT[13], AT[14], AT[15]);
      const bf16x8 vf0 = ld8(Vt + (32 * w + l32) * 40 + hh * 8), vf1 = ld8(Vt + (32 * w + l32) * 40 + 16 + hh * 8);
      f32x16 OT;
#pragma unroll
      for (int i = 0; i < 16; ++i) OT[i] = 0.f;
      OT = MFMA32(vf0, pA0, OT);
      OT = MFMA32(vf1, pA1, OT);
      const bf16x8 sa0 = pack8(S0[0], S0[1], S0[2], S0[3], S0[4], S0[5], S0[6], S0[7]);
      const bf16x8 sa1 = pack8(S0[8], S0[9], S0[10], S0[11], S0[12], S0[13], S0[14], S0[15]);
      const bf16x8 sa2 = pack8(S1[0], S1[1], S1[2], S1[3], S1[4], S1[5], S1[6], S1[7]);
      OT = MFMA32(sa0, ld8(QbP + l32 * 56 + hh * 8), OT);
      OT = MFMA32(sa1, ld8(QbP + l32 * 56 + 16 + hh * 8), OT);
      OT = MFMA32(sa2, ld8(QbP + l32 * 56 + 32 + hh * 8), OT);
      float* od = go + (rowb + l32) * 384 + h * 96 + 32 * w + 4 * hh;
#pragma unroll
      for (int g = 0; g < 4; ++g) *(float4*)(od + 8 * g) = make_float4(OT[4 * g], OT[4 * g + 1], OT[4 * g + 2], OT[4 * g + 3]);
#pragma unroll
      for (int i = 0; i < 16; ++i) { S0[i] *= ebl[crow(i, hh)]; S1[i] *= ebl[32 + crow(i, hh)]; }
      S0 = MFMA32(ld8(KlT + l32 * 40 + hh * 8), vf0, S0);
      S0 = MFMA32(ld8(KlT + l32 * 40 + 16 + hh * 8), vf1, S0);
      S1 = MFMA32(ld8(KlT + (32 + l32) * 40 + hh * 8), vf0, S1);
      S1 = MFMA32(ld8(KlT + (32 + l32) * 40 + 16 + hh * 8), vf1, S1);
    }
    __syncthreads();
  }
#undef GL_LOAD
}

DI void xattn_block(const Params& p, int L, int b, int h, int qb64, char* smem) {
  const int tid = ltid(), lane = tid & 63, w = tid >> 6, l32 = lane & 31, hh = lane >> 5;
  char* wsl_ = lws(p);
  const int qt2 = w >> 1, dvh = w & 1;
  char* u = wsl_ + OFF_UNION;
  const u16* Qg = (const u16*)(u + U_QXA) + (size_t)(b * SEQ + qb64 * 64) * 1024 + h * 256;
  const u16* Kg = (const u16*)(wsl_ + OFF_KXA) + (size_t)L * 2048 * 1024 + (size_t)(b * 256) * 1024 + h * 256;
  const u16* Vg = (const u16*)(wsl_ + OFF_VXAT) + (size_t)L * 2048 * 1024 + (size_t)(b * 1024 + h * 256) * 256;
  u16* Qs = (u16*)smem; u16* Ks = Qs + 64 * 264; u16* Vs = Ks + 32 * 264;
  {
    u32x4 t8[8];
#pragma unroll
    for (int i = 0; i < 8; ++i) { const int c = tid + 256 * i; t8[i] = *(const u32x4*)(Qg + (size_t)(c >> 5) * 1024 + (c & 31) * 8); }
#pragma unroll
    for (int i = 0; i < 8; ++i) { const int c = tid + 256 * i; *(u32x4*)(Qs + (c >> 5) * 264 + (c & 31) * 8) = t8[i]; }
  }
  u32x4 rk[4], rk2[4], rv[4];
#pragma unroll
  for (int i = 0; i < 4; ++i) {
    const int c = tid + 256 * i;
    rk[i] = *(const u32x4*)(Kg + (size_t)(c >> 5) * 1024 + (c & 31) * 8);
    rv[i] = *(const u32x4*)(Vg + (size_t)(c >> 2) * 256 + (c & 3) * 8);
    rk2[i] = *(const u32x4*)(Kg + (size_t)(32 + (c >> 5)) * 1024 + (c & 31) * 8);
  }
  f32x16 O[4];
#pragma unroll
  for (int a = 0; a < 4; ++a)
#pragma unroll
    for (int i = 0; i < 16; ++i) O[a][i] = 0.f;
  float mrun = -1e30f, lrun = 0.f;
  const float sc = 0.0625f * LOG2E;
#pragma unroll 1
  for (int kt = 0; kt < 8; ++kt) {
#pragma unroll
    for (int i = 0; i < 4; ++i) {
      const int c = tid + 256 * i;
      *(u32x4*)(Ks + (c >> 5) * 264 + (c & 31) * 8) = rk[i];
      vperm_store(Vs + (c >> 2) * 40, c & 3, rv[i]);
    }
    __syncthreads();
    {
      const int k1 = (kt < 7 ? kt + 1 : 7) * 32, k2 = (kt < 6 ? kt + 2 : 7) * 32;
#pragma unroll
      for (int i = 0; i < 4; ++i) {
        const int c = tid + 256 * i;
        rk[i] = rk2[i];
        rk2[i] = *(const u32x4*)(Kg + (size_t)(k2 + (c >> 5)) * 1024 + (c & 31) * 8);
        rv[i] = *(const u32x4*)(Vg + (size_t)(c >> 2) * 256 + k1 + (c & 3) * 8);
      }
    }
    __builtin_amdgcn_sched_barrier(0);
    f32x16 S;
#pragma unroll
    for (int i = 0; i < 16; ++i) S[i] = 0.f;
#pragma unroll
    for (int s = 0; s < 16; ++s) S = MFMA32(ld8(Ks + l32 * 264 + s * 16 + hh * 8), ld8(Qs + (qt2 * 32 + l32) * 264 + s * 16 + hh * 8), S);
#pragma unroll
    for (int i = 0; i < 16; ++i) S[i] *= sc;
    float corr; bf16x8 pf0, pf1;
    softmax_tile(S, mrun, lrun, corr, pf0, pf1);
#pragma unroll
    for (int mt = 0; mt < 4; ++mt) {
#pragma unroll
      for (int i = 0; i < 16; ++i) O[mt][i] *= corr;
      O[mt] = MFMA32(ld8(Vs + (dvh * 128 + mt * 32 + l32) * 40 + hh * 8), pf0, O[mt]);
      O[mt] = MFMA32(ld8(Vs + (dvh * 128 + mt * 32 + l32) * 40 + 16 + hh * 8), pf1, O[mt]);
    }
    __syncthreads();
  }
  const float lt = lrun + __shfl_xor(lrun, 32);
  const float inv = 1.f / lt;
  u16* od = (u16*)(u + U_OMIX) + (size_t)(b * SEQ + qb64 * 64 + qt2 * 32 + l32) * 1024 + h * 256 + dvh * 128;
#pragma unroll
  for (int mt = 0; mt < 4; ++mt)
#pragma unroll
    for (int g = 0; g < 4; ++g) store4bf(od + mt * 32 + 8 * g + 4 * hh, O[mt][4 * g] * inv, O[mt][4 * g + 1] * inv, O[mt][4 * g + 2] * inv, O[mt][4 * g + 3] * inv);
}

DI void ln_row(float4 (&v)[4], const float4 (&gv)[4], const float4 (&bv)[4], float& mean_o, float& rstd_o) {
  float s = 0.f, q = 0.f;
#pragma unroll
  for (int j = 0; j < 4; ++j) { s += v[j].x + v[j].y + v[j].z + v[j].w; q += v[j].x * v[j].x + v[j].y * v[j].y + v[j].z * v[j].z + v[j].w * v[j].w; }
#pragma unroll
  for (int o = 32; o > 0; o >>= 1) { s += __shfl_xor(s, o); q += __shfl_xor(q, o); }
  const float mean = s * (1.f / 1024.f);
  const float var = fmaxf(q * (1.f / 1024.f) - mean * mean, 0.f);
  const float rstd = rsqrtf(var + LN_EPS);
  mean_o = mean; rstd_o = rstd;
#pragma unroll
  for (int j = 0; j < 4; ++j) {
    v[j].x = (v[j].x - mean) * rstd * gv[j].x + bv[j].x; v[j].y = (v[j].y - mean) * rstd * gv[j].y + bv[j].y;
    v[j].z = (v[j].z - mean) * rstd * gv[j].z + bv[j].z; v[j].w = (v[j].w - mean) * rstd * gv[j].w + bv[j].w;
  }
}
#define LN_LOAD_GB(g, bb) float4 gv[4], bv[4]; _Pragma("unroll") for (int j = 0; j < 4; ++j) { gv[j] = *(const float4*)((g) + j * 256 + lane * 4); bv[j] = *(const float4*)((bb) + j * 256 + lane * 4); }
#define LN_LOAD_ROW(dst, row) { _Pragma("unroll") for (int j = 0; j < 4; ++j) dst[j] = *(const float4*)(y + (size_t)(row) * 1024 + j * 256 + lane * 4); }
#define LN_STORE_ROW(v, row) { _Pragma("unroll") for (int j = 0; j < 4; ++j) { \
    u32x2 o_ = {pack2(v[j].x, v[j].y), pack2(v[j].z, v[j].w)}; *(u32x2*)(xbf + (size_t)(row) * 1024 + j * 256 + lane * 4) = o_; } \
    if (lane == 0) *(float2*)(lnstats + (size_t)(row) * 2) = make_float2(mean_, rstd_); }

DI unsigned bar_ld(unsigned* q) { return __hip_atomic_load(q, __ATOMIC_RELAXED, __HIP_MEMORY_SCOPE_AGENT); }
DI unsigned bar_add(unsigned* q, unsigned v) { return __hip_atomic_fetch_add(q, v, __ATOMIC_RELAXED, __HIP_MEMORY_SCOPE_AGENT); }
template <class P_> DI void gbar(const P_& p, unsigned round) {
  asm volatile("s_waitcnt vmcnt(0)" ::: "memory");
  __syncthreads();
  if (threadIdx.x == 0) {
    unsigned* bar = (unsigned*)(lws(p) + OFF_BAR);
    __builtin_amdgcn_fence(__ATOMIC_RELEASE, "agent");
    asm volatile("s_waitcnt vmcnt(0)" ::: "memory");
    const unsigned g = blockIdx.x & 7u, nloc = gridDim.x >> 3;
    const unsigned old = bar_add(bar + 64 * g, 1u);
    if (old + 1u == round * nloc) {
      const unsigned o2 = bar_add(bar + 64 * 8, 1u);
      if (o2 + 1u == round * 8u) {
#pragma unroll
        for (int j = 0; j < 8; ++j) bar_add(bar + 64 * (9 + j), 1u);
      }
    }
    while (bar_ld(bar + 64 * (9 + g)) < round) __builtin_amdgcn_s_sleep(1);
    __builtin_amdgcn_fence(__ATOMIC_ACQUIRE, "agent");
    asm volatile("s_waitcnt vmcnt(0)" ::: "memory");
  }
  __syncthreads();
}

DI bool st_tile(int i, int xcd, int nM, int nN, int NB, int& mt, int& nt) {
  const int T = 8 * NB; const int sl = i / T, within = i % T; const int st = sl * 8 + xcd;
  const int SM = nM >> 3; const int S = SM * (nN / NB);
  if (st >= S) return false;
  const int sm = st % SM, sn = st / SM;
  mt = sm * 8 + (within & 7); nt = sn * NB + (within >> 3);
  return true;
}

__global__ void __launch_bounds__(NTHR, 2) mega(Params p) {
  cg::grid_group grid = cg::this_grid();
  __shared__ __attribute__((aligned(16))) char smem[SMEM_BYTES];
  __shared__ int s_item;
  __shared__ int s_cnt[8];
  __shared__ int s_base[8];
  const int nblk = gridDim.x, blk = blockIdx.x;
  const int nwave = nblk * 4;

#ifdef PROBE_SYNCS
  for (int q_ = 0; q_ < PROBE_SYNCS; ++q_) grid.sync();
#endif
  for (int rep_ = 0; rep_ < REP(0); ++rep_) {
    PH_IDS
    {
      Job jb; int lt; float v[16];
      int t = blk;
      get_job(p, t < TR_TILES ? t : TR_TILES - 1, jb, lt);
      tr_load(jb, lt, v);
      while (t < TR_TILES) {
        const int t2 = t + nblk;
        Job jb2; int lt2; float v2[16];
        get_job(p, t2 < TR_TILES ? t2 : TR_TILES - 1, jb2, lt2);
        tr_load(jb2, lt2, v2);
        __builtin_amdgcn_sched_barrier(0);
        tr_store(jb, lt, v, (float*)smem);
        jb = jb2; lt = lt2;
#pragma unroll
        for (int i = 0; i < 16; ++i) v[i] = v2[i];
        t = t2;
      }
    }
    const size_t gt = (size_t)blk * NTHR + tid, gn = (size_t)nblk * NTHR;
    for (size_t i = gt; i < (size_t)MTOK * 1024 / 4; i += gn) {
      const float4 v = ((const float4*)p.x)[i]; u32x2 o = {pack2(v.x, v.y), pack2(v.z, v.w)}; ((u32x2*)xbf)[i] = o;
    }
    u16* membf = (u16*)(ws + OFF_MEMBF);
    for (size_t i = gt; i < (size_t)2048 * 1024 / 4; i += gn) {
      const float4 v = ((const float4*)p.mem)[i]; u32x2 o = {pack2(v.x, v.y), pack2(v.z, v.w)}; ((u32x2*)membf)[i] = o;
    }
    float* rope = (float*)(ws + OFF_ROPE);
    for (size_t i = gt; i < (size_t)MTOK * 12; i += gn) {
      const int tok = (int)(i / 12), f = (int)(i % 12);
      const float ps = (float)p.pos[tok];
      const float ang = ps * (f < 4 ? p.invfA[f] : p.invfB[f - 4]);
      float c, s; sincos_acc(ang, c, s);
      if (f < 4) { rope[tok * 24 + f] = c; rope[tok * 24 + 4 + f] = s; }
      else { rope[tok * 24 + 8 + (f - 4)] = c; rope[tok * 24 + 16 + (f - 4)] = s; }
    }
    if (blk == 0 && tid < 64) ctr[tid] = 0;
    if (blk == 0) { unsigned* bw = (unsigned*)(ws + OFF_BAR); for (int i = tid; i < 2048; i += NTHR) bw[i] = 0u; }
    if (rep_ + 1 < REP(0)) grid.sync();
  }
  grid.sync();
  unsigned bar_round = 0;
#ifdef PROBE_GBAR
  for (int q_ = 0; q_ < PROBE_GBAR; ++q_) gbar(p, ++bar_round);
#endif

  for (int L = 0; L < 2; ++L) {
    for (int rep_ = 0; rep_ < REP(1); ++rep_) {
      PH_IDS
      const int nin = 128 * 25; const int ntot = nin + (L == 0 ? 512 : 0);
      EpiIn ein{u, (const float*)(ws + OFF_ROPE), (float*)(ws + OFF_RC)};
      (void)nin; (void)ntot;
      const int xcd = blk & 7, jb = blk >> 3, nb8 = nblk >> 3;
      for (int i = jb; ; i += nb8) {
        int mt, nt;
        if (i < 400) {
          if (!st_tile(i, xcd, 128, 25, 5, mt, nt)) break;
          gemm_tile(RowPlain{xbf, 1024}, (const u16*)(ws + OFF_WT_IN) + (size_t)L * INP * 1024, 1024, 1024, mt * 128, nt * 128, (u16*)smem, ein);
        } else {
          if (i >= 416) break;
          const int l2 = L;
          if (!st_tile(i - 400, xcd, 16, 8, 1, mt, nt)) break;
          EpiKV ekv{(u16*)(ws + OFF_KXA) + (size_t)l2 * 2048 * 1024, (u16*)(ws + OFF_VXAT) + (size_t)l2 * 2048 * 1024};
          gemm_tile256(RowPlain{(const u16*)(ws + OFF_MEMBF), 1024}, (const u16*)(ws + OFF_WT_KV) + (size_t)l2 * 2048 * 1024, 1024, 1024, mt * 128, nt * 256, (u16*)smem, ekv);
        }
      }
      if (rep_ + 1 < REP(1)) gbar(p, ++bar_round);
    }
    gbar(p, ++bar_round);
    for (int rep_ = 0; rep_ < REP(2); ++rep_) {
      PH_IDS
      float lam;
      {
        float a1 = 0.f, a2 = 0.f;
        for (int i = 0; i < 32; ++i) { a1 += p.lam_q1[L * 32 + i] * p.lam_k1[L * 32 + i]; a2 += p.lam_q2[L * 32 + i] * p.lam_k2[L * 32 + i]; }
        lam = expf(a1) - expf(a2) + p.lam_init[L];
      }
      const int total = 32 + 512 + 2304;
      while (true) {
        if (tid == 0) s_item = atomicAdd(&ctr[L + 2 * rep_], 1);
        __syncthreads();
        const int item = s_item;
        __syncthreads();
        if (item >= total) break;
#ifdef PROBE_SUB
        if (rep_ == 1) { const int kind = item < 32 ? 1 : (item < 544 ? 2 : 3); if (kind != PROBE_SUB) continue; }
#endif
        if (item < 32) {
          __builtin_amdgcn_s_setprio(3);
          gla_mfma_item(p, L, item >> 2, item & 3, smem);
          __builtin_amdgcn_s_setprio(0);
        } else if (item < 544) {
          const int a = item - 32; const int qblk = 15 - (a >> 5), bh = a & 31;
          mixA_block(p, L, bh >> 2, bh & 3, qblk, lam, p.lam_init[L], smem);
        } else {
          const int bi = item - 544; const int g = bi / 768, rem = bi % 768; const int bh = rem >> 4, sb = rem & 15;
          mixB_block(p, bh / 6, bh % 6, g, sb, smem);
        }
      }
      if (rep_ + 1 < REP(2)) gbar(p, ++bar_round);
    }
    gbar(p, ++bar_round);
    for (int rep_ = 0; rep_ < REP(3); ++rep_) {
      PH_IDS
      const float* lse = (const float*)(ws + OFF_LSE);
      const u16* pbo = (const u16*)(u + U_PBO); const float* go = (const float*)(u + U_GLAO); const u16* hc = (const u16*)(u + U_HC);
      u16* om = (u16*)(u + U_OMIX);
      const float* gg = p.gla_g + L * 96;
      for (int tok0 = gwave; tok0 < MTOK; tok0 += nwave) {
        int tok = tok0; asm volatile("" : "+v"(tok));
#pragma unroll
        for (int hd = 0; hd < 6; ++hd) {
          const float l0 = lse[(size_t)tok * 8 + hd], l1 = lse[(size_t)MTOK * 8 + (size_t)tok * 8 + hd], l2 = lse[(size_t)2 * MTOK * 8 + (size_t)tok * 8 + hd];
          const float mx = fmaxf(l0, fmaxf(l1, l2));
          const float w0 = __expf(l0 - mx), w1 = __expf(l1 - mx), w2 = __expf(l2 - mx);
          const float inv = 1.f / (w0 + w1 + w2);
          const size_t o = (size_t)tok * 384 + hd * 64 + lane;
          const float v = (w0 * bf2f(pbo[o]) + w1 * bf2f(pbo[(size_t)MTOK * 384 + o]) + w2 * bf2f(pbo[(size_t)2 * MTOK * 384 + o])) * inv;
          om[(size_t)tok * 1024 + 256 + hd * 64 + lane] = f2bf(v);
        }
#pragma unroll
        for (int hd = 0; hd < 4; ++hd) {
          const float o0 = go[(size_t)tok * 384 + hd * 96 + lane];
          const float o1 = lane < 32 ? go[(size_t)tok * 384 + hd * 96 + 64 + lane] : 0.f;
          const float ssq = wave_sum(o0 * o0 + o1 * o1);
          const float rs = rsqrtf(ssq * (1.f / 96.f) + LN_EPS);
          const float g0 = bf2f(hc[(size_t)tok * 1152 + 768 + hd * 96 + lane]);
          om[(size_t)tok * 1024 + 640 + hd * 96 + lane] = f2bf(o0 * rs * gg[lane] * (g0 / (1.f + __expf(-g0))));
          if (lane < 32) {
            const float g1 = bf2f(hc[(size_t)tok * 1152 + 768 + hd * 96 + 64 + lane]);
            om[(size_t)tok * 1024 + 640 + hd * 96 + 64 + lane] = f2bf(o1 * rs * gg[64 + lane] * (g1 / (1.f + __expf(-g1))));
          }
        }
      }
      if (rep_ + 1 < REP(3)) gbar(p, ++bar_round);
    }
    gbar(p, ++bar_round);
    for (int rep_ = 0; rep_ < REP(4); ++rep_) {
      PH_IDS
      EpiResidT er{L == 0 ? p.x : (const float*)y, lnstats, p.ln_ffn_g, p.ln_ffn_b, y, L};
      for (int i = blk >> 3; ; i += nblk >> 3) {
        int mt, nt; if (!st_tile(i, blk & 7, 128, 8, 8, mt, nt)) break;
        gemm_tile_sw(RowPlain{(const u16*)(u + U_OMIX), 1024}, (const u16*)(ws + OFF_WT_OUT) + (size_t)L * 1024 * 1024, 1024, 1024, mt * 128, nt * 128, (u16*)smem, er);
      }
      if (rep_ + 1 < REP(4)) gbar(p, ++bar_round);
    }
    gbar(p, ++bar_round);
    for (int rep_ = 0; rep_ < REP(5); ++rep_) {
      PH_IDS
      const float* g = p.ln_mix_g + L * 1024; const float* bb = p.ln_mix_b + L * 1024;
      LN_LOAD_GB(g, bb)
      float4 v[4], nx[4];
      int row = gwave;
      LN_LOAD_ROW(v, (row < MTOK ? row : MTOK - 1))
      while (row < MTOK) {
        const int r2 = row + nwave;
        LN_LOAD_ROW(nx, (r2 < MTOK ? r2 : MTOK - 1))
        __builtin_amdgcn_sched_barrier(0);
        float mean_, rstd_; ln_row(v, gv, bv, mean_, rstd_);
        LN_STORE_ROW(v, row)
#pragma unroll
        for (int j = 0; j < 4; ++j) v[j] = nx[j];
        row = r2;
      }
      if (rep_ + 1 < REP(5)) gbar(p, ++bar_round);
    }
    gbar(p, ++bar_round);
    for (int rep_ = 0; rep_ < REP(6); ++rep_) {
      PH_IDS
      EpiBfT eq{(u16*)(u + U_QXA), 1024};
      for (int i = blk >> 3; ; i += nblk >> 3) {
        int mt, hd; if (!st_tile(i, blk & 7, 128, 4, 4, mt, hd)) break;
        gemm_tile_sw(RowPlain{xbf, 1024}, (const u16*)(ws + OFF_WT_Q) + (size_t)L * 1024 * 1024, 1024, 1024, mt * 128, hd * 256, (u16*)smem, eq);
        gemm_tile_sw(RowPlain{xbf, 1024}, (const u16*)(ws + OFF_WT_Q) + (size_t)L * 1024 * 1024, 1024, 1024, mt * 128, hd * 256 + 128, (u16*)smem, eq);
        asm volatile("s_waitcnt vmcnt(0)" ::: "memory");
        __syncthreads();
        xattn_block(p, L, mt >> 4, hd, (mt & 15) * 2, smem);
        xattn_block(p, L, mt >> 4, hd, (mt & 15) * 2 + 1, smem);
      }
      if (rep_ + 1 < REP(6)) gbar(p, ++bar_round);
    }
    gbar(p, ++bar_round);
    for (int rep_ = 0; rep_ < REP(8); ++rep_) {
      PH_IDS
      EpiResidT er{y, lnstats, p.ln_mix_g + L * 1024, p.ln_mix_b + L * 1024, y, 1};
      for (int i = blk >> 3; ; i += nblk >> 3) {
        int mt, nt; if (!st_tile(i, blk & 7, 128, 8, 8, mt, nt)) break;
        gemm_tile_sw(RowPlain{(const u16*)(u + U_OMIX), 1024}, (const u16*)(ws + OFF_WT_O) + (size_t)L * 1024 * 1024, 1024, 1024, mt * 128, nt * 128, (u16*)smem, er);
      }
      if (rep_ + 1 < REP(8)) gbar(p, ++bar_round);
    }
    gbar(p, ++bar_round);
    for (int rep_ = 0; rep_ < REP(9); ++rep_) {
      PH_IDS
      const float* g = p.ln_xa_g + L * 1024; const float* bb = p.ln_xa_b + L * 1024;
      const int rpb = (MTOK + nblk - 1) / nblk;
      const int r0 = blk * rpb, r1 = (r0 + rpb < MTOK) ? r0 + rpb : MTOK;
      float* rt = (float*)smem;
      int* ent = (int*)(smem + 32768);
      if (L == 1) {
        for (int i = tid; i < 8192; i += NTHR) { const int e = i & 7, c = i >> 3; rt[e * 1024 + c] = p.moe_router[i]; }
        if (tid < 8) s_cnt[tid] = 0;
        __syncthreads();
      }
      LN_LOAD_GB(g, bb)
      float4 v[4], nx[4];
      int row = r0 + w;
      LN_LOAD_ROW(v, (row < MTOK ? row : MTOK - 1))
      for (; row < r1; row += 4) {
        LN_LOAD_ROW(nx, (row + 4 < MTOK ? row + 4 : MTOK - 1))
        __builtin_amdgcn_sched_barrier(0);
        float mean_, rstd_; ln_row(v, gv, bv, mean_, rstd_);
        LN_STORE_ROW(v, row)
        if (L == 1) {
          float lg[8];
#pragma unroll
          for (int e = 0; e < 8; ++e) {
            float a = 0.f;
#pragma unroll
            for (int j = 0; j < 4; ++j) { const float4 rv = *(const float4*)(rt + e * 1024 + j * 256 + lane * 4); a += v[j].x * rv.x + v[j].y * rv.y + v[j].z * rv.z + v[j].w * rv.w; }
            lg[e] = wave_sum(a);
          }
          if (lane == 0) {
            int e1 = 0; float v1 = lg[0];
#pragma unroll
            for (int e = 1; e < 8; ++e) if (lg[e] > v1) { v1 = lg[e]; e1 = e; }
            int e2 = -1; float v2 = -3.0e38f;
#pragma unroll
            for (int e = 0; e < 8; ++e) if (e != e1 && lg[e] > v2) { v2 = lg[e]; e2 = e; }
            const float ee = expf(v2 - v1); const float w1 = 1.f / (1.f + ee), w2 = ee / (1.f + ee);
            const int li = (row - r0) * 2;
            const int s1 = atomicAdd(&s_cnt[e1], 1); const int s2 = atomicAdd(&s_cnt[e2], 1);
            ent[li * 4 + 0] = row * 2; ent[li * 4 + 1] = e1; ent[li * 4 + 2] = s1; ent[li * 4 + 3] = __float_as_int(w1);
            ent[li * 4 + 4] = row * 2 + 1; ent[li * 4 + 5] = e2; ent[li * 4 + 6] = s2; ent[li * 4 + 7] = __float_as_int(w2);
          }
        }
#pragma unroll
        for (int j = 0; j < 4; ++j) v[j] = nx[j];
      }
      if (L == 1) {
        __syncthreads();
        if (tid < 8) s_base[tid] = atomicAdd(&ctr[8 + tid], s_cnt[tid]);
        __syncthreads();
        int* list = (int*)(ws + OFF_LIST); float* gl = (float*)(ws + OFF_GLIST);
        const int ne = (r1 - r0) * 2;
        for (int i = tid; i < ne; i += NTHR) {
          const int e = ent[i * 4 + 1]; const int pos = s_base[e] + ent[i * 4 + 2];
          list[e * MTOK + pos] = ent[i * 4 + 0]; gl[e * MTOK + pos] = __int_as_float(ent[i * 4 + 3]);
        }
        __syncthreads();
      }
      if (rep_ + 1 < REP(9)) gbar(p, ++bar_round);
    }
    gbar(p, ++bar_round);
    if (L == 0) {
      for (int rep_ = 0; rep_ < REP(10); ++rep_) {
        PH_IDS
        EpiSwiglu es{(u16*)u, FD, 0};
        {
          const int nb8 = nblk >> 3, jb = blk >> 3, tot = 352; const int full = (tot / nb8) * nb8;
          for (int i = jb; i < full; i += nb8) {
            int mt, nt; st_tile(i, blk & 7, 128, 22, 2, mt, nt);
            gemm_tile256(RowPlain{xbf, 1024}, (const u16*)(ws + OFF_WT_F13), 1024, 1024, mt * 128, nt * 256, (u16*)smem, es);
          }
          for (int hq = jb; hq < 2 * (tot - full); hq += nb8) {
            int mt, nt; st_tile(full + (hq >> 1), blk & 7, 128, 22, 2, mt, nt);
            gemm_tile(RowPlain{xbf, 1024}, (const u16*)(ws + OFF_WT_F13), 1024, 1024, mt * 128, nt * 256 + (hq & 1) * 128, (u16*)smem, es);
          }
        }
        if (rep_ + 1 < REP(10)) gbar(p, ++bar_round);
      }
      gbar(p, ++bar_round);
      for (int rep_ = 0; rep_ < REP(11); ++rep_) {
        PH_IDS
        EpiResidT er{y, lnstats, p.ln_xa_g, p.ln_xa_b, y, 1};
        for (int i = blk >> 3; ; i += nblk >> 3) {
          int mt, nt; if (!st_tile(i, blk & 7, 128, 8, 8, mt, nt)) break;
          gemm_tile_sw(RowPlain{(const u16*)u, FD}, (const u16*)(ws + OFF_WT_F2), FD, FD, mt * 128, nt * 128, (u16*)smem, er);
        }
        if (rep_ + 1 < REP(11)) gbar(p, ++bar_round);
      }
      gbar(p, ++bar_round);
      for (int rep_ = 0; rep_ < REP(12); ++rep_) {
        PH_IDS
        const float* g = p.ln_ffn_g; const float* bb = p.ln_ffn_b;
        LN_LOAD_GB(g, bb)
        float4 v[4], nx[4];
        int row = gwave;
        LN_LOAD_ROW(v, (row < MTOK ? row : MTOK - 1))
        while (row < MTOK) {
          const int r2 = row + nwave;
          LN_LOAD_ROW(nx, (r2 < MTOK ? r2 : MTOK - 1))
        __builtin_amdgcn_sched_barrier(0);
          float mean_, rstd_; ln_row(v, gv, bv, mean_, rstd_);
          LN_STORE_ROW(v, row)
#pragma unroll
          for (int j = 0; j < 4; ++j) v[j] = nx[j];
          row = r2;
        }
        if (rep_ + 1 < REP(12)) gbar(p, ++bar_round);
      }
      gbar(p, ++bar_round);
    } else {
      char* ws0 = lws(p); const int* ctr0 = (const int*)(ws0 + OFF_CTR);
      int cnt[8], mts[8], offp[8]; int tot_mt = 0;
#pragma unroll
      for (int e = 0; e < 8; ++e) { cnt[e] = ctr0[8 + e]; mts[e] = (cnt[e] + 127) >> 7; offp[e] = tot_mt * 128; tot_mt += mts[e]; }
      for (int rep_ = 0; rep_ < REP(13); ++rep_) {
        PH_IDS
        const int* list = (const int*)(ws + OFF_LIST); const float* gl = (const float*)(ws + OFF_GLIST); (void)gl;
        const int e = blk & 7;
        int ce = 0, me = 0, oe = 0;
#pragma unroll
        for (int q = 0; q < 8; ++q) if (e == q) { ce = cnt[q]; me = mts[q]; oe = offp[q]; }
        EpiSwiglu es{(u16*)u, FM, oe};
        if (me > 0) {
          const int nb8 = nblk >> 3, jb = blk >> 3, tot = me * 28, grp = me * 4; const int full = (tot / nb8) * nb8;
          const u16* wB = (const u16*)(ws + OFF_WT_M13) + (size_t)e * 2 * FM * 1024;
          for (int v = jb; v < full; v += nb8) {
            const int sn = v / grp, r = v % grp; const int mt = r >> 2, nt = sn * 4 + (r & 3);
            gemm_tile256(RowGather{xbf, list + (size_t)e * MTOK, ce}, wB, 1024, 1024, mt * 128, nt * 256, (u16*)smem, es);
          }
          for (int hq = jb; hq < 2 * (tot - full); hq += nb8) {
            const int v = full + (hq >> 1); const int sn = v / grp, r = v % grp; const int mt = r >> 2, nt = sn * 4 + (r & 3);
            gemm_tile(RowGather{xbf, list + (size_t)e * MTOK, ce}, wB, 1024, 1024, mt * 128, nt * 256 + (hq & 1) * 128, (u16*)smem, es);
          }
        }
        if (rep_ + 1 < REP(13)) gbar(p, ++bar_round);
      }
      gbar(p, ++bar_round);
      for (int rep_ = 0; rep_ < REP(14); ++rep_) {
        PH_IDS
        const int* list = (const int*)(ws + OFF_LIST); const float* gl = (const float*)(ws + OFF_GLIST); (void)gl;
        const int e = blk & 7;
        int ce = 0, me = 0, oe = 0;
#pragma unroll
        for (int q = 0; q < 8; ++q) if (e == q) { ce = cnt[q]; me = mts[q]; oe = offp[q]; }
        EpiMoe2T em{(u16*)(ws + OFF_MOEOUT), list + (size_t)e * MTOK, gl + (size_t)e * MTOK, ce};
        for (int i = blk >> 3; i < ((me + 7) >> 3) * 64; i += nblk >> 3) {
          const int sl = i >> 6, within = i & 63;
          const int mt = sl * 8 + (within & 7), nt = within >> 3;
          if (mt >= me) continue;
          gemm_tile_sw(RowPlain{(const u16*)u + (size_t)oe * FM, FM}, (const u16*)(ws + OFF_WT_M2) + (size_t)e * 1024 * FM, FM, FM, mt * 128, nt * 128, (u16*)smem, em);
        }
        if (rep_ + 1 < REP(14)) gbar(p, ++bar_round);
      }
      gbar(p, ++bar_round);
      for (int rep_ = 0; rep_ < REP(15); ++rep_) {
        PH_IDS
        const float* g = p.ln_ffn_g + 1024; const float* bb = p.ln_ffn_b + 1024;
        const u16* mo = (const u16*)(ws + OFF_MOEOUT);
        LN_LOAD_GB(g, bb)
        float4 xv[4], nxv[4]; u32x2 ma[4], mc[4], nma[4], nmc[4];
#define FIN_LOAD(XV, MA, MC, row) { _Pragma("unroll") for (int j = 0; j < 4; ++j) { XV[j] = *(const float4*)(y + (size_t)(row) * 1024 + j * 256 + lane * 4); \
          MA[j] = *(const u32x2*)(mo + (size_t)(2 * (row)) * 1024 + j * 256 + lane * 4); MC[j] = *(const u32x2*)(mo + (size_t)(2 * (row) + 1) * 1024 + j * 256 + lane * 4); } }
        int row = gwave;
        FIN_LOAD(xv, ma, mc, (row < MTOK ? row : MTOK - 1))
        while (row < MTOK) {
          const int r2 = row + nwave;
          FIN_LOAD(nxv, nma, nmc, (r2 < MTOK ? r2 : MTOK - 1))
          __builtin_amdgcn_sched_barrier(0);
          float4 v[4];
          const float2 st_ = *(const float2*)(lnstats + (size_t)row * 2);
#pragma unroll
          for (int j = 0; j < 4; ++j) {
            const u32x2 a = ma[j], c = mc[j];
            const float4 gx = *(const float4*)(p.ln_xa_g + 1024 + j * 256 + lane * 4), bx = *(const float4*)(p.ln_xa_b + 1024 + j * 256 + lane * 4);
            const float x0 = (xv[j].x - st_.x) * st_.y * gx.x + bx.x, x1 = (xv[j].y - st_.x) * st_.y * gx.y + bx.y;
            const float x2 = (xv[j].z - st_.x) * st_.y * gx.z + bx.z, x3 = (xv[j].w - st_.x) * st_.y * gx.w + bx.w;
            v[j].x = ALPHA * x0 + (__uint_as_float(a[0] << 16) + __uint_as_float(c[0] << 16));
            v[j].y = ALPHA * x1 + (__uint_as_float(a[0] & 0xffff0000u) + __uint_as_float(c[0] & 0xffff0000u));
            v[j].z = ALPHA * x2 + (__uint_as_float(a[1] << 16) + __uint_as_float(c[1] << 16));
            v[j].w = ALPHA * x3 + (__uint_as_float(a[1] & 0xffff0000u) + __uint_as_float(c[1] & 0xffff0000u));
          }
          float mean_, rstd_; ln_row(v, gv, bv, mean_, rstd_);
#pragma unroll
          for (int j = 0; j < 4; ++j) *(float4*)(p.out + (size_t)row * 1024 + j * 256 + lane * 4) = v[j];
#pragma unroll
          for (int j = 0; j < 4; ++j) { xv[j] = nxv[j]; ma[j] = nma[j]; mc[j] = nmc[j]; }
          row = r2;
        }
#undef FIN_LOAD
        if (rep_ + 1 < REP(15)) gbar(p, ++bar_round);
      }
    }
  }
}

extern "C" void kernel_launch(void* const* d_in, const int* in_sizes, int n_in, void* d_out, int out_size, void* d_ws, size_t ws_size, hipStream_t stream) {
  static int grid_blocks = 0;
  if (!grid_blocks) {
    int dev = 0, cus = 0, per_cu = 0;
    hipGetDevice(&dev);
    hipDeviceGetAttribute(&cus, hipDeviceAttributeMultiprocessorCount, dev);
    hipOccupancyMaxActiveBlocksPerMultiprocessor(&per_cu, mega, NTHR, 0);
    if (per_cu > 2) per_cu = 2;
    if (per_cu < 1) per_cu = 1;
    grid_blocks = cus * per_cu;
  }
  if (ws_size < WS_NEED) { fprintf(stderr, "workspace too small: %zu < %zu\n", ws_size, (size_t)WS_NEED); return; }
  Params p;
  memset(&p, 0, sizeof(p));
  p.x = (const float*)d_in[0]; p.mem = (const float*)d_in[1]; p.pos = (const int*)d_in[2];
  p.w_in = (const float*)d_in[3]; p.lam_q1 = (const float*)d_in[4]; p.lam_k1 = (const float*)d_in[5]; p.lam_q2 = (const float*)d_in[6]; p.lam_k2 = (const float*)d_in[7];
  p.diff_g = (const float*)d_in[8]; p.gla_wa2 = (const float*)d_in[9]; p.gla_ba = (const float*)d_in[10]; p.gla_g = (const float*)d_in[11];
  p.w_out = (const float*)d_in[12]; p.ln_mix_g = (const float*)d_in[13]; p.ln_mix_b = (const float*)d_in[14];
  p.xa_wq = (const float*)d_in[15]; p.xa_wkv = (const float*)d_in[16]; p.xa_wo = (const float*)d_in[17]; p.ln_xa_g = (const float*)d_in[18]; p.ln_xa_b = (const float*)d_in[19];
  p.ffd_w13 = (const float*)d_in[20]; p.ffd_w2 = (const float*)d_in[21]; p.moe_router = (const float*)d_in[22]; p.moe_w13 = (const float*)d_in[23]; p.moe_w2 = (const float*)d_in[24];
  p.ln_ffn_g = (const float*)d_in[25]; p.ln_ffn_b = (const float*)d_in[26];
  p.out = (float*)d_out; p.ws = (char*)d_ws;
  for (int i = 0; i < 4; ++i) p.invfA[i] = (float)pow(500000.0, -(double)(2 * i) / 8.0);
  for (int i = 0; i < 8; ++i) p.invfB[i] = (float)pow(500000.0, -(double)(2 * i) / 16.0);
  for (int l = 0; l < 2; ++l) p.lam_init[l] = (float)(0.8 - 0.6 * exp(-0.3 * l));
  void* args[] = {&p};
  hipError_t e = hipLaunchCooperativeKernel((void*)mega, dim3(grid_blocks), dim3(NTHR), args, 0, stream);
  if (e != hipSuccess) fprintf(stderr, "cooperative launch failed: %s (grid %d)\n", hipGetErrorString(e), grid_blocks);
}
```
